# Optimizing an MI355X kernel written in HIP

```python
import math
import jax, jax.numpy as jnp
from jax import lax
import numpy as np

D_MODEL = 4096
BATCH = 4
SEQ = 4096
DEPTH = 1

ATT_HEADS = 16
ATT_KV_HEADS = 4
HEAD_DIM = 128
IDX_HEADS = 16
IDX_DIM = 64
TOPK_MAX = 256
Q_BLOCK = 128
ROPE_THETA = 10000.0
GDN_HEADS = 16
GDN_DK = 128
GDN_DV = 128
CONV_WIDTH = 4
CHUNK = 64
N_GROUPS = 4
EXPERTS_PER_GROUP = 8
N_EXPERTS = N_GROUPS * EXPERTS_PER_GROUP
TOP_K_EXPERTS = 2
EXPERT_FF = 512
EPS = 1e-6

ATT_Q_WIDTH = ATT_HEADS * HEAD_DIM
ATT_KV_WIDTH = ATT_KV_HEADS * HEAD_DIM
IDX_Q_WIDTH = IDX_HEADS * IDX_DIM
GDN_QK_WIDTH = GDN_HEADS * GDN_DK
GDN_V_WIDTH = GDN_HEADS * GDN_DV
IN_SPLIT_SIZES = (ATT_Q_WIDTH, ATT_KV_WIDTH, ATT_KV_WIDTH, IDX_Q_WIDTH, IDX_DIM, IDX_HEADS,
                  GDN_QK_WIDTH, GDN_QK_WIDTH, GDN_V_WIDTH, GDN_V_WIDTH, GDN_HEADS, GDN_HEADS,
                  D_MODEL, D_MODEL)
IN_WIDTH = sum(IN_SPLIT_SIZES)

kernel_name = 'hybrid_dsa_gdn_hmoe_block'


def rms_norm(x, w):
    xf = x.astype(jnp.float32)
    y = xf * lax.rsqrt(jnp.mean(xf * xf, axis=-1, keepdims=True) + EPS)
    return (y * w.astype(jnp.float32)).astype(x.dtype)


def l2_norm(x):
    xf = x.astype(jnp.float32)
    return xf * lax.rsqrt(jnp.sum(xf * xf, axis=-1, keepdims=True) + EPS)


def rope(x, positions):
    d = x.shape[-1]
    inv_freq = ROPE_THETA ** (-jnp.arange(0, d, 2, dtype=jnp.float32) / d)
    ang = positions.astype(jnp.float32)[..., None] * inv_freq
    if x.ndim == 4:
        ang = ang[:, :, None, :]
    cos, sin = jnp.cos(ang), jnp.sin(ang)
    xf = x.astype(jnp.float32)
    x1, x2 = xf[..., : d // 2], xf[..., d // 2:]
    return jnp.concatenate([x1 * cos - x2 * sin, x2 * cos + x1 * sin], axis=-1).astype(x.dtype)


def dsa_sparse_attention(q, k, v, q_idx, k_idx, w_idx):
    B, S = q.shape[:2]
    n_sel = min(TOPK_MAX, S // 4)
    nb = S // Q_BLOCK
    grp = ATT_HEADS // ATT_KV_HEADS
    k_idx32 = k_idx.astype(jnp.float32)
    key_pos = jnp.arange(S, dtype=jnp.int32)

    def to_blocks(a):
        return jnp.moveaxis(a.reshape((B, nb, Q_BLOCK) + a.shape[2:]), 1, 0)

    def block(args):
        start, qb, qib, wb = args
        q_pos = start + jnp.arange(Q_BLOCK, dtype=jnp.int32)
        causal = key_pos[None, :] <= q_pos[:, None]
        dots = jnp.einsum('bqhd,bsd->bqhs', qib.astype(jnp.float32), k_idx32) * (IDX_DIM ** -0.5)
        score = jnp.einsum('bqh,bqhs->bqs', wb.astype(jnp.float32), jax.nn.relu(dots))
        score = jnp.where(causal[None], score, -jnp.inf)
        _, sel = lax.top_k(score, n_sel)
        valid = sel <= q_pos[None, :, None]
        kg = jax.vmap(lambda kk, ii: kk[ii])(k, sel)
        vg = jax.vmap(lambda vv, ii: vv[ii])(v, sel)
        qg = qb.reshape(B, Q_BLOCK, ATT_KV_HEADS, grp, HEAD_DIM)
        s = jnp.einsum('bqhgd,bqkhd->bqhgk', qg.astype(jnp.float32), kg.astype(jnp.float32)) * (HEAD_DIM ** -0.5)
        s = jnp.where(valid[:, :, None, None, :], s, -jnp.inf)
        p = jax.nn.softmax(s, axis=-1).astype(v.dtype)
        o = jnp.einsum('bqhgk,bqkhd->bqhgd', p, vg)
        return o.reshape(B, Q_BLOCK, ATT_Q_WIDTH)

    starts = jnp.arange(nb, dtype=jnp.int32) * Q_BLOCK
    out = lax.map(block, (starts, to_blocks(q), to_blocks(q_idx), to_blocks(w_idx)))
    return jnp.moveaxis(out, 0, 1).reshape(B, S, ATT_Q_WIDTH)


def causal_conv_silu(x, w):
    S = x.shape[1]
    xp = jnp.pad(x, ((0, 0), (CONV_WIDTH - 1, 0), (0, 0)))
    y = w[0] * xp[:, 0:S]
    for j in range(1, CONV_WIDTH):
        y = y + w[j] * xp[:, j:j + S]
    return jax.nn.silu(y)


def gated_delta_rule(q, k, v, g, beta):
    B, S, H, DK = q.shape
    DV = v.shape[-1]
    n = S // CHUNK

    def chunks(a):
        a = jnp.moveaxis(a, 2, 1)
        return a.reshape((B, H, n, CHUNK) + a.shape[3:])

    q, k, v, g, beta = (chunks(a) for a in (q, k, v, g, beta))
    gc = jnp.cumsum(g, axis=-1)
    tril = jnp.tril(jnp.ones((CHUNK, CHUNK), dtype=bool))
    strict = jnp.tril(jnp.ones((CHUNK, CHUNK), dtype=bool), -1)
    decay = jnp.exp(jnp.where(tril, gc[..., :, None] - gc[..., None, :], -jnp.inf))
    k_beta = k * beta[..., None]
    v_beta = v * beta[..., None]
    lower = jnp.where(strict, jnp.einsum('bhnid,bhnjd->bhnij', k_beta, k) * decay, 0.0)
    rhs = jnp.concatenate([v_beta, k_beta * jnp.exp(gc)[..., None]], axis=-1)
    sol = lax.linalg.triangular_solve(lower, rhs, left_side=True, lower=True, unit_diagonal=True)
    u, w = sol[..., :DV], sol[..., DV:]
    intra = jnp.einsum('bhnid,bhnjd->bhnij', q, k) * decay
    q_dec = q * jnp.exp(gc)[..., None]
    g_last = gc[..., -1]
    k_dec = k * jnp.exp(g_last[..., None] - gc)[..., None]

    def step(state, xs):
        q_d, k_d, u_c, w_c, intra_c, gl = xs
        v_new = u_c - jnp.einsum('bhck,bhkv->bhcv', w_c, state)
        o = jnp.einsum('bhck,bhkv->bhcv', q_d, state) + jnp.einsum('bhij,bhjv->bhiv', intra_c, v_new)
        state = state * jnp.exp(gl)[..., None, None] + jnp.einsum('bhck,bhcv->bhkv', k_d, v_new)
        return state, o

    xs = tuple(jnp.moveaxis(a, 2, 0) for a in (q_dec, k_dec, u, w, intra, g_last))
    state0 = jnp.zeros((B, H, DK, DV), jnp.float32)
    _, o = lax.scan(step, state0, xs)
    o = jnp.moveaxis(o, 0, 2).reshape(B, H, S, DV)
    return jnp.moveaxis(o, 1, 2)


def gated_deltanet(q, k, v, z, a, b, conv_w, a_log, dt_bias, norm_w):
    B, S, _ = q.shape
    qkv = causal_conv_silu(jnp.concatenate([q, k, v], axis=-1), conv_w)
    q, k, v = jnp.split(qkv, [GDN_QK_WIDTH, 2 * GDN_QK_WIDTH], axis=-1)
    q = l2_norm(q.reshape(B, S, GDN_HEADS, GDN_DK)) * (GDN_DK ** -0.5)
    k = l2_norm(k.reshape(B, S, GDN_HEADS, GDN_DK))
    v = v.reshape(B, S, GDN_HEADS, GDN_DV).astype(jnp.float32)
    beta = jax.nn.sigmoid(b.astype(jnp.float32))
    g = -jnp.exp(a_log.astype(jnp.float32)) * jax.nn.softplus(a.astype(jnp.float32) + dt_bias.astype(jnp.float32))
    o = gated_delta_rule(q, k, v, g, beta)
    o = rms_norm(o, norm_w) * jax.nn.silu(z.reshape(B, S, GDN_HEADS, GDN_DV).astype(jnp.float32))
    return o.reshape(B, S, GDN_V_WIDTH).astype(z.dtype)


def hierarchical_moe(h, w_rg, b_rg, w_re, b_re, w_gate, w_up, w_down):
    B, S, D = h.shape
    T = B * S
    t = h.reshape(T, D)
    grp_prob = jax.nn.softmax(jnp.matmul(t, w_rg).astype(jnp.float32) + b_rg.astype(jnp.float32), axis=-1)
    p_grp, grp = lax.top_k(grp_prob, 1)
    exp_logits = jnp.einsum('td,gde->tge', t, w_re).astype(jnp.float32) + b_re.astype(jnp.float32)
    exp_logits = exp_logits[jnp.arange(T), grp[:, 0]]
    p_exp, sel = lax.top_k(jax.nn.softmax(exp_logits, axis=-1), TOP_K_EXPERTS)
    weights = p_grp * p_exp / jnp.sum(p_exp, axis=-1, keepdims=True)
    eid = grp * EXPERTS_PER_GROUP + sel
    combine = jnp.sum(jax.nn.one_hot(eid, N_EXPERTS, dtype=jnp.float32) * weights[..., None], axis=1)
    y = jnp.zeros((T, D), jnp.float32)
    for e in range(N_EXPERTS):
        he = jax.nn.silu(t @ w_gate[e]) * (t @ w_up[e])
        y = y + combine[:, e:e + 1] * (he @ w_down[e]).astype(jnp.float32)
    return y.astype(h.dtype).reshape(B, S, D)


def setup_inputs(seed: int = 0) -> dict:
    key = jax.random.key(seed)
    ks = jax.random.split(key, 24)
    f32 = jnp.float32

    def nrm(k, shape, scale):
        return jax.random.normal(k, shape, f32) * scale

    def gain(k, shape):
        return 1.0 + 0.02 * jax.random.normal(k, shape, f32)

    L = DEPTH
    x = nrm(ks[0], (BATCH, SEQ, D_MODEL), 1.0)
    offs = jax.random.randint(ks[1], (BATCH, 1), 0, 1024, dtype=jnp.int32)
    positions = offs + jnp.arange(SEQ, dtype=jnp.int32)[None, :]
    dt = jnp.exp(jax.random.uniform(ks[9], (L, GDN_HEADS), f32) * (math.log(0.1) - math.log(1e-3)) + math.log(1e-3))
    return {
        'x': x,
        'positions': positions,
        'mix_norm_w': gain(ks[2], (L, D_MODEL)),
        'w_in': nrm(ks[3], (L, D_MODEL, IN_WIDTH), D_MODEL ** -0.5),
        'q_norm_w': gain(ks[4], (L, HEAD_DIM)),
        'k_norm_w': gain(ks[5], (L, HEAD_DIM)),
        'idx_k_norm_w': gain(ks[6], (L, IDX_DIM)),
        'conv_w': nrm(ks[7], (L, CONV_WIDTH, 2 * GDN_QK_WIDTH + GDN_V_WIDTH), 0.5),
        'a_log': jnp.log(jax.random.uniform(ks[8], (L, GDN_HEADS), f32, 1.0, 16.0)),
        'dt_bias': dt + jnp.log(-jnp.expm1(-dt)),
        'gdn_norm_w': gain(ks[10], (L, GDN_DV)),
        'w_proj_attn': nrm(ks[11], (L, ATT_Q_WIDTH, D_MODEL), ATT_Q_WIDTH ** -0.5),
        'w_proj_gdn': nrm(ks[12], (L, GDN_V_WIDTH, D_MODEL), GDN_V_WIDTH ** -0.5),
        'w_out': nrm(ks[13], (L, D_MODEL, D_MODEL), D_MODEL ** -0.5),
        'ffn_norm_w': gain(ks[14], (L, D_MODEL)),
        'w_router_group': nrm(ks[15], (L, D_MODEL, N_GROUPS), D_MODEL ** -0.5),
        'b_router_group': nrm(ks[16], (L, N_GROUPS), 0.01),
        'w_router_expert': nrm(ks[17], (L, N_GROUPS, D_MODEL, EXPERTS_PER_GROUP), D_MODEL ** -0.5),
        'b_router_expert': nrm(ks[18], (L, N_GROUPS, EXPERTS_PER_GROUP), 0.01),
        'w_gate': nrm(ks[19], (L, N_EXPERTS, D_MODEL, EXPERT_FF), D_MODEL ** -0.5),
        'w_up': nrm(ks[20], (L, N_EXPERTS, D_MODEL, EXPERT_FF), D_MODEL ** -0.5),
        'w_down': nrm(ks[21], (L, N_EXPERTS, EXPERT_FF, D_MODEL), EXPERT_FF ** -0.5),
    }


def reference(x, positions, mix_norm_w, w_in, q_norm_w, k_norm_w, idx_k_norm_w, conv_w, a_log, dt_bias,
              gdn_norm_w, w_proj_attn, w_proj_gdn, w_out, ffn_norm_w, w_router_group, b_router_group,
              w_router_expert, b_router_expert, w_gate, w_up, w_down):
    B, S, _ = x.shape
    split_idx = np.cumsum(IN_SPLIT_SIZES)[:-1].tolist()
    for l in range(DEPTH):
        h = rms_norm(x, mix_norm_w[l])
        proj = h @ w_in[l]
        (aq, ak, av, iq, ik, iw, gq, gk, gv, gz, ga, gb, gate_attn, gate_gdn) = jnp.split(proj, split_idx, axis=-1)
        aq = rope(rms_norm(aq.reshape(B, S, ATT_HEADS, HEAD_DIM), q_norm_w[l]), positions)
        ak = rope(rms_norm(ak.reshape(B, S, ATT_KV_HEADS, HEAD_DIM), k_norm_w[l]), positions)
        av = av.reshape(B, S, ATT_KV_HEADS, HEAD_DIM)
        iq = rope(iq.reshape(B, S, IDX_HEADS, IDX_DIM), positions)
        ik = rope(rms_norm(ik, idx_k_norm_w[l]), positions)
        iw = iw * (IDX_HEADS ** -0.5)
        y_attn = dsa_sparse_attention(aq, ak, av, iq, ik, iw)
        y_gdn = gated_deltanet(gq, gk, gv, gz, ga, gb, conv_w[l], a_log[l], dt_bias[l], gdn_norm_w[l])
        mixed = (jax.nn.sigmoid(gate_attn) * (y_attn @ w_proj_attn[l])
                 + jax.nn.sigmoid(gate_gdn) * (y_gdn @ w_proj_gdn[l]))
        x = x + mixed @ w_out[l]
        h2 = rms_norm(x, ffn_norm_w[l])
        x = x + hierarchical_moe(h2, w_router_group[l], b_router_group[l], w_router_expert[l],
                                 b_router_expert[l], w_gate[l], w_up[l], w_down[l])
    return x
```

```cpp
#include <hip/hip_runtime.h>
#include <cstdio>
#include <cstdint>

#ifndef ONE_LAUNCH
#define ONE_LAUNCH 1
#endif

#define GAS __attribute__((address_space(1)))
#define LAS __attribute__((address_space(3)))
typedef unsigned short bf16;
typedef short bf16x8 __attribute__((ext_vector_type(8)));
typedef short bf16x4 __attribute__((ext_vector_type(4)));
typedef float f32x2 __attribute__((ext_vector_type(2)));
typedef float f32x4 __attribute__((ext_vector_type(4)));
typedef float f32x16 __attribute__((ext_vector_type(16)));
typedef unsigned u32x2 __attribute__((ext_vector_type(2)));
typedef unsigned u32x4 __attribute__((ext_vector_type(4)));

constexpr int NB = 4, SEQ = 4096, T = NB * SEQ, DM = 4096;
constexpr int NIN = 20592, NPAD = 20736, LDP = 20480, LDSM = 256;
constexpr int C_AQ = 0, C_AK = 2048, C_AV = 2560, C_IQ = 3072, C_GQ = 4096, C_GK = 6144, C_GV = 8192, C_GZ = 10240, C_GTA = 12288, C_GTG = 16384;
constexpr int SMALL_PN = 80;
constexpr int SM_IK = 0, SM_IW = 64, SM_GA = 80, SM_GB = 96;
constexpr float EPS = 1e-6f;
constexpr int NPH = 13;

constexpr size_t MiB = 1u << 20;
constexpr size_t WS_CTL = 0, CTL_BYTES = 1 * MiB;
constexpr size_t WS_WPA = 1 * MiB, WS_WPG = 17 * MiB, WS_WOUT = 33 * MiB, WS_WGU = 65 * MiB, WS_WD = 321 * MiB;
constexpr size_t WS_WIN8 = 449 * MiB;
constexpr size_t WS_XN8 = 1395 * MiB;
constexpr size_t WS_GQ = 449 * MiB, WS_GO = 513 * MiB, WS_KB = 577 * MiB, WS_IKF = 593 * MiB, WS_MASK = 595 * MiB;
constexpr size_t WS_MIX = 449 * MiB;
constexpr size_t WS_HE = 449 * MiB;
constexpr size_t WS_XN = 611 * MiB;
constexpr size_t WS_QB = 611 * MiB, WS_YA = 675 * MiB;
constexpr size_t WS_YA8 = 611 * MiB;
constexpr size_t WS_MIX8 = 675 * MiB;
constexpr size_t WS_H2 = 611 * MiB;
constexpr size_t WS_PROJ = 739 * MiB; constexpr size_t WS_DPART = WS_PROJ, WS_X1B = WS_PROJ + ((size_t)128 << 20);
constexpr size_t WS_SMALL = 1379 * MiB;
constexpr size_t WS_OSC = 1395 * MiB;
constexpr size_t WS_LIST = 1395 * MiB, WS_LWT = 1399 * MiB;
constexpr size_t WS_R128C = 1459 * MiB, WS_R128S = 1463 * MiB, WS_R64C = 1467 * MiB, WS_R64S = 1469 * MiB;
constexpr size_t WS_WRF = 1471 * MiB;
constexpr size_t WS_RSTD = 1472 * MiB, WS_GG = WS_RSTD + 65536, WS_SA = WS_GG + 65536;
constexpr size_t WS_END = 1472 * MiB + 196608;
constexpr int CW_BAR = 4096;
constexpr int CW_CNT = 16384;
constexpr int CW_SPLIT = 36864;
constexpr int CW_AMAX = 32768;

constexpr int RING_BYTES = 131072, LDSCTL_OFF = 131072, LDS_BYTES = 147456;
constexpr int LT_SEGC = LDSCTL_OFF + 256;
constexpr int LT_SEGT = LT_SEGC + 256;
constexpr int LT_RTSEG = LT_SEGT + 320;
constexpr int LT_RK = LT_RTSEG + 1024;
constexpr int LT_NRK = LT_RK + 1280;

#define LDS_WAIT() asm volatile("s_waitcnt lgkmcnt(0)" ::: "memory")
#define LDS_BARRIER() do { asm volatile("s_waitcnt lgkmcnt(0)" ::: "memory"); __builtin_amdgcn_s_barrier(); asm volatile("" ::: "memory"); } while (0)
#define VM_WAIT() asm volatile("s_waitcnt vmcnt(0)" ::: "memory")

typedef __bf16 bf16x2_t __attribute__((ext_vector_type(2)));
__device__ __forceinline__ unsigned cvt_pk_bf16(float lo, float hi) { const f32x2 f = {lo, hi}; return __builtin_bit_cast(unsigned, __builtin_convertvector(f, bf16x2_t)); }
__device__ __forceinline__ unsigned cvt2_fp8(float a, float b, unsigned old, bool hi) { a = __builtin_amdgcn_fmed3f(a, -440.f, 440.f); b = __builtin_amdgcn_fmed3f(b, -440.f, 440.f); return hi ? __builtin_amdgcn_cvt_pk_fp8_f32(a, b, old, true) : __builtin_amdgcn_cvt_pk_fp8_f32(a, b, old, false); }
__device__ __forceinline__ unsigned q4_i8(float a, float b, float c, float d, float inv) {
    const float M = 12582912.f;
    const unsigned ua = __float_as_uint(__builtin_amdgcn_fmed3f(a * inv, -127.f, 127.f) + M), ub = __float_as_uint(__builtin_amdgcn_fmed3f(b * inv, -127.f, 127.f) + M);
    const unsigned uc = __float_as_uint(__builtin_amdgcn_fmed3f(c * inv, -127.f, 127.f) + M), ud = __float_as_uint(__builtin_amdgcn_fmed3f(d * inv, -127.f, 127.f) + M);
    return __builtin_amdgcn_perm(ub, ua, 0x0c0c0400) | __builtin_amdgcn_perm(ud, uc, 0x04000c0c);
}
__device__ __forceinline__ float bf2f(unsigned short b) { return __uint_as_float(((unsigned)b) << 16); }
__device__ __forceinline__ float bflo(unsigned w) { return __uint_as_float(w << 16); }
__device__ __forceinline__ float bfhi(unsigned w) { return __uint_as_float(w & 0xffff0000u); }
__device__ __forceinline__ unsigned short f2bf(float f) { return (unsigned short)(cvt_pk_bf16(f, 0.f) & 0xffffu); }
__device__ __forceinline__ float sigmoidf_(float x) { return __builtin_amdgcn_rcpf(1.f + __expf(-x)); }
__device__ __forceinline__ float wave_sum(float v) {
#pragma unroll
    for (int o = 1; o < 64; o <<= 1) v += __shfl_xor(v, o);
    return v;
}
__device__ __forceinline__ int opaque(int v) { int r; asm volatile("v_mov_b32 %0, %1" : "=v"(r) : "v"(v)); return r; }
__device__ __forceinline__ int crow(int r, int hi) { return (r & 3) + 8 * (r >> 2) + 4 * hi; }

__device__ __forceinline__ const char* uniform_ptr(const char* p) { const unsigned long long v = (unsigned long long)p; const unsigned lo = __builtin_amdgcn_readfirstlane((unsigned)v), hi = __builtin_amdgcn_readfirstlane((unsigned)(v >> 32)); return (const char*)(((unsigned long long)hi << 32) | lo); }
namespace pg8 {
typedef int v4i_t __attribute__((ext_vector_type(4)));
typedef int v8i_t __attribute__((ext_vector_type(8)));
constexpr int BM = 256, BK = 64, HALF = 128, HTB = HALF * BK * 2, STAGE_BYTES = 8 * HTB, NXCD = 8, WGM = 8;
__host__ __device__ __forceinline__ int lds_byte(int r, int c) { const int st = (r >> 4) * 2 + (c >> 5), rr = r & 15, cc = c & 31, ob = rr * 64 + cc * 2; return st * 1024 + (ob ^ (((ob >> 9) & 1) << 5)); }
__host__ __device__ __forceinline__ void stage_rc(int b, int& R, int& C) { const int st = b / 1024, sb = b % 1024, swz = sb ^ (((sb >> 9) & 1) << 5); R = (st >> 1) * 16 + swz / 64; C = (st & 1) * 32 + (swz % 64) / 2; }
__host__ __device__ __forceinline__ int perm32(int rho) { const int n = rho >> 4, i = rho & 15; return 8 * (i >> 2) + 4 * n + (i & 3); }

struct Unit { int pm, pn; const char* A; const char* B; const int* rows; int nrows; int aux0, aux1; };

struct StaticOrder {
    int nM, nN, nwg, G, c; const char* A; const char* Bt; size_t tstep;
    __device__ void init(const void* A_, const void* Bt_, int M, int N, int K, int G_, int c_) { nM = M / BM; nN = N / BM; nwg = nM * nN; G = G_; c = c_; A = (const char*)A_; Bt = (const char*)Bt_; tstep = (size_t)BM * K * 2; }
    __device__ __forceinline__ bool next(int i, Unit& u) const { return at((long)i * G + c, u); }
    __device__ __forceinline__ bool at(long L, Unit& u) const {
        if (L < 0 || L >= nwg) return false;
        int wgid = (int)L; { const int q = nwg / NXCD, r = nwg % NXCD, xcd = wgid % NXCD, off = wgid / NXCD; wgid = (xcd < r ? xcd * (q + 1) : r * (q + 1) + (xcd - r) * q) + off; }
        const int nig = WGM * nN, gid = wgid / nig, fm = gid * WGM, gsz = (nM - fm) < WGM ? (nM - fm) : WGM;
        u.pm = fm + ((wgid % nig) % gsz); u.pn = (wgid % nig) / gsz; u.A = A + (size_t)u.pm * tstep; u.B = Bt + (size_t)u.pn * tstep; u.rows = nullptr; u.nrows = 256; u.aux0 = 0; u.aux1 = 0; return true;
    }
};

struct StaggerOrder : StaticOrder {
    __device__ __forceinline__ bool next(int i, Unit& u) const {
        if (G != 256 || nwg != 5184) return at((long)i * G + c, u);
        if (i < 20) return at((long)i * 256 + c, u);
        if (i == 20 && (c & 7) < 2) return at(5120 + (c >> 3) * 2 + (c & 7), u);
        return false;
    }
};
struct SkewOrder : StaticOrder {
    __device__ __forceinline__ bool next(int i, Unit& u) const {
        if (G != 256 || nwg != 2816) return at((long)i * G + c, u);
        if (i < 9) return at((long)i * 256 + c, u);
        if (c < 64) return false;
        const int j = c - 64;
        if (i == 9) return at(2304 + j, u);
        if (j < 128) { if (i == 10) return at(2304 + 192 + j, u); if (i == 11) return at(2304 + 192 + 128 + j, u); return false; }
        if (i == 10) return at(2304 + 192 + 256 + (j - 128), u);
        return false;
    }
};
template <class Epi, class Sched, bool ALIGN_EPI, bool GATHER, int MODE = 0, int RELAX = 0>
__device__ __forceinline__ void gemm_phase(LAS unsigned char* lds, const int tid, const int K, const Sched& S, const Epi& E, const int sw = 0x79797979, const int sa = 0x7f7f7f7f) {
    const int wid = __builtin_amdgcn_readfirstlane(tid >> 6), lane = tid & 63, wr = wid >> 2, wc = wid & 3, fr = lane & 15, fq = lane >> 4;
    constexpr bool FP8 = MODE == 1, I8 = MODE == 2;
    const int nt = K / BK;
    unsigned vA[2][2], voffB[2];
    const size_t hstep = (size_t)HALF * K * 2;
#pragma unroll
    for (int i = 0; i < 2; ++i) { int R, C; stage_rc(tid * 16 + i * 8192, R, C); const int Rb = (R & ~31) + perm32(R & 31);
        vA[0][i] = (unsigned)(R * K + C) * 2u; vA[1][i] = 0u; voffB[i] = (unsigned)(Rb * K + C) * 2u; }
    const unsigned ldsw = (unsigned)wid * 1024u;
    const int aoff = lds_byte(wr * 64 + fr, fq * 8), boff = lds_byte(wc * 32 + fr, fq * 8);
#define PG8_SA(b, h) (((b) * 2 + (h)) * HTB)
#define PG8_SB(b, h) ((4 + (b) * 2 + (h)) * HTB)
#define PG8_STAGEV(bufoff, rs, soff, o0, o1) do { \
        __builtin_amdgcn_raw_ptr_buffer_load_lds(rs, (LAS void*)(lds + (bufoff) + ldsw), 16, (int)(o0), (int)(soff), 0, 0); \
        __builtin_amdgcn_raw_ptr_buffer_load_lds(rs, (LAS void*)(lds + (bufoff) + ldsw + 8192), 16, (int)(o1), (int)(soff), 0, 0); } while (0)
#define PG8_STAGEB(bufoff, rs, soff) PG8_STAGEV(bufoff, rs, soff, voffB[0], voffB[1])
#define PG8_STAGEA(bufoff, rs, soff, h) do { if constexpr (GATHER) PG8_STAGEV(bufoff, rs, soff, vA[h][0], vA[h][1]); else PG8_STAGEV(bufoff, rs, (soff) + (h) * (int)hstep, vA[0][0], vA[0][1]); } while (0)
#define PG8_RSRC(p) __builtin_amdgcn_make_buffer_rsrc((void*)uniform_ptr(p), 0, 0xffffffffu, 0x00020000)
#define PG8_LDA(dst, b, h) do { _Pragma("unroll") for (int m = 0; m < 4; ++m) _Pragma("unroll") for (int k = 0; k < 2; ++k) dst[m][k] = *(const LAS bf16x8*)(lds + PG8_SA(b, h) + aoff + m * 2048 + k * 1024); } while (0)
#define PG8_LDB(dst, b, h) do { _Pragma("unroll") for (int n = 0; n < 2; ++n) _Pragma("unroll") for (int k = 0; k < 2; ++k) dst[n][k] = *(const LAS bf16x8*)(lds + PG8_SB(b, h) + boff + n * 2048 + k * 1024); } while (0)
#define PG8_MMA(ai, bj, At, Bt) do { __builtin_amdgcn_s_setprio(1); _Pragma("unroll") for (int m = 0; m < 4; ++m) _Pragma("unroll") for (int n = 0; n < 2; ++n) _Pragma("unroll") for (int k = 0; k < 2; ++k) \
        acc[ai][bj][m][n] = __builtin_amdgcn_mfma_f32_16x16x32_bf16(Bt[n][k], At[m][k], acc[ai][bj][m][n], 0, 0, 0); __builtin_amdgcn_s_setprio(0); } while (0)
#define PG8_LDA8(dst, b, h) do { _Pragma("unroll") for (int m = 0; m < 4; ++m) { dst[m].lo = *(const LAS v4i_t*)(lds + PG8_SA(b, h) + aoff + m * 2048); dst[m].hi = *(const LAS v4i_t*)(lds + PG8_SA(b, h) + aoff + m * 2048 + 1024); } } while (0)
#define PG8_LDB8(dst, b, h) do { _Pragma("unroll") for (int n = 0; n < 2; ++n) { dst[n].lo = *(const LAS v4i_t*)(lds + PG8_SB(b, h) + boff + n * 2048); dst[n].hi = *(const LAS v4i_t*)(lds + PG8_SB(b, h) + boff + n * 2048 + 1024); } } while (0)
#define PG8_MMA8(ai, bj, At, Bt) do { __builtin_amdgcn_s_setprio(1); _Pragma("unroll") for (int m = 0; m < 4; ++m) _Pragma("unroll") for (int n = 0; n < 2; ++n) \
        acc[ai][bj][m][n] = __builtin_amdgcn_mfma_scale_f32_16x16x128_f8f6f4(Bt[n], At[m], acc[ai][bj][m][n], 0, 0, 0, sw, 0, sa); __builtin_amdgcn_s_setprio(0); } while (0)
#define PG8_MMAI(ai, bj, At, Bt) do { __builtin_amdgcn_s_setprio(1); _Pragma("unroll") for (int m = 0; m < 4; ++m) _Pragma("unroll") for (int n = 0; n < 2; ++n) _Pragma("unroll") for (int k = 0; k < 2; ++k) \
        acci[ai][bj][m][n] = __builtin_amdgcn_mfma_i32_16x16x64_i8(__builtin_bit_cast(v4i_t, Bt[n][k]), __builtin_bit_cast(v4i_t, At[m][k]), acci[ai][bj][m][n], 0, 0, 0); __builtin_amdgcn_s_setprio(0); } while (0)
#define PG8_WAIT_V(n) asm volatile("s_waitcnt vmcnt(" #n ")" ::: "memory")
#define PG8_WAIT_VN(n) do { __builtin_amdgcn_s_waitcnt(((n) & 15) | (((n) >> 4) << 14) | 0x0f70); asm volatile("" ::: "memory"); } while (0)
#define PG8_WAIT_L(n) asm volatile("s_waitcnt lgkmcnt(" #n ")" ::: "memory")
#define PG8_BAR __builtin_amdgcn_s_barrier()
#define PG8_SCHED __builtin_amdgcn_sched_barrier(0)
    Unit cur, nxt; int ui = 0; bool fresh = false;
    if (!S.next(0, cur)) return;
    if constexpr (GATHER) {
#pragma unroll
        for (int h = 0; h < 2; ++h)
#pragma unroll
            for (int i = 0; i < 2; ++i) { int R, C; stage_rc(tid * 16 + i * 8192, R, C); const int lr = h * HALF + R; const int tok = lr < cur.nrows ? cur.rows[lr] : 0; vA[h][i] = (unsigned)tok * (unsigned)(K * 2) + (unsigned)(C * 2); }
    }
    f32x4 acc[2][2][4][2];
#pragma unroll
    for (int a = 0; a < 2; ++a)
#pragma unroll
        for (int b = 0; b < 2; ++b)
#pragma unroll
            for (int m = 0; m < 4; ++m)
#pragma unroll
                for (int n = 0; n < 2; ++n) acc[a][b][m][n] = (f32x4){0.f, 0.f, 0.f, 0.f};
    v4i_t acci[2][2][4][2];
#pragma unroll
    for (int a = 0; a < 2; ++a)
#pragma unroll
        for (int b = 0; b < 2; ++b)
#pragma unroll
            for (int m = 0; m < 4; ++m)
#pragma unroll
                for (int n = 0; n < 2; ++n) acci[a][b][m][n] = (v4i_t){0, 0, 0, 0};
    bf16x8 At[4][2], B0[2][2], B1[2][2]; v8i_t A8[4], B08[2], B18[2];
    auto rA = PG8_RSRC(cur.A), rB = PG8_RSRC(cur.B);
    const int ks = BK * 2, hs = (int)hstep;
    PG8_STAGEB(PG8_SB(0, 0), rB, 0); PG8_STAGEB(PG8_SB(0, 1), rB, hs); PG8_STAGEA(PG8_SA(0, 0), rA, 0, 0); PG8_STAGEA(PG8_SA(0, 1), rA, 0, 1);
    if (wr == 1) PG8_BAR;
    PG8_WAIT_V(2); PG8_BAR;
    PG8_STAGEB(PG8_SB(1, 0), rB, ks); PG8_STAGEA(PG8_SA(1, 0), rA, ks, 0); PG8_STAGEB(PG8_SB(1, 1), rB, hs + ks);
    PG8_WAIT_V(6); PG8_BAR;
    for (;;) {
        const bool has_next = S.next(ui + 1, nxt);
        auto rAn = rA, rBn = rB; if (has_next) { rAn = PG8_RSRC(nxt.A); rBn = PG8_RSRC(nxt.B); }
#pragma clang loop unroll(disable)
        for (int t = 0; t < nt; t += 2) {
            const bool last = (t == nt - 2); const bool fr0 = RELAX > 0 && fresh && t == 0;
            const int o1 = (t + 1) * ks, o2 = last ? 0 : (t + 2) * ks, o3 = o2 + ks;
            const auto rA2 = last ? rAn : rA; const auto rB2 = last ? rBn : rB;
            if constexpr (FP8) {
            PG8_LDB8(B08, 0, 0); PG8_LDB8(B18, 0, 1); PG8_SCHED; PG8_LDA8(A8, 0, 0); if (!fr0) PG8_STAGEA(PG8_SA(1, 1), rA, o1, 1);
            if (fr0) PG8_WAIT_VN(RELAX); else PG8_WAIT_V(8);
            PG8_WAIT_L(0); PG8_BAR; PG8_MMA8(0, 0, A8, B08); PG8_MMA8(0, 1, A8, B18); PG8_BAR; PG8_SCHED;
            if constexpr (GATHER) { if (last && has_next) {
#pragma unroll
                for (int h = 0; h < 2; ++h)
#pragma unroll
                    for (int i = 0; i < 2; ++i) { int R, C; stage_rc(tid * 16 + i * 8192, R, C); const int lr = h * HALF + R; const int tok = lr < nxt.nrows ? nxt.rows[lr] : 0; vA[h][i] = (unsigned)tok * (unsigned)(K * 2) + (unsigned)(C * 2); } } }
            PG8_LDA8(A8, 0, 1); PG8_STAGEB(PG8_SB(0, 0), rB2, o2); PG8_STAGEB(PG8_SB(0, 1), rB2, o2 + hs); PG8_STAGEA(PG8_SA(0, 0), rA2, o2, 0);
            if (fr0) PG8_WAIT_VN(RELAX + 6); else PG8_WAIT_V(8);
            PG8_WAIT_L(0); PG8_BAR; PG8_MMA8(1, 0, A8, B08); PG8_MMA8(1, 1, A8, B18); PG8_BAR; PG8_SCHED;
            PG8_LDB8(B08, 1, 0); PG8_LDB8(B18, 1, 1); PG8_SCHED; PG8_LDA8(A8, 1, 0); PG8_STAGEA(PG8_SA(0, 1), rA2, o2, 1);
            if (fr0) PG8_WAIT_VN(RELAX + 8); else PG8_WAIT_V(8);
            PG8_WAIT_L(0); PG8_BAR; PG8_MMA8(0, 0, A8, B08); PG8_MMA8(0, 1, A8, B18); PG8_BAR; PG8_SCHED;
            PG8_LDA8(A8, 1, 1); PG8_STAGEB(PG8_SB(1, 0), rB2, o3); PG8_STAGEB(PG8_SB(1, 1), rB2, o3 + hs); PG8_STAGEA(PG8_SA(1, 0), rA2, o3, 0);
            PG8_WAIT_V(8); PG8_WAIT_L(0); PG8_BAR; PG8_MMA8(1, 0, A8, B08); PG8_MMA8(1, 1, A8, B18); PG8_BAR; PG8_SCHED;
            } else {
            PG8_LDB(B0, 0, 0); PG8_LDB(B1, 0, 1); PG8_SCHED; PG8_LDA(At, 0, 0); if (!fr0) PG8_STAGEA(PG8_SA(1, 1), rA, o1, 1);
            if (fr0) PG8_WAIT_VN(RELAX); else PG8_WAIT_V(8);
            PG8_WAIT_L(0); PG8_BAR; if constexpr (I8) { PG8_MMAI(0, 0, At, B0); PG8_MMAI(0, 1, At, B1); } else { PG8_MMA(0, 0, At, B0); PG8_MMA(0, 1, At, B1); } PG8_BAR; PG8_SCHED;
            if constexpr (GATHER) { if (last && has_next) {
#pragma unroll
                for (int h = 0; h < 2; ++h)
#pragma unroll
                    for (int i = 0; i < 2; ++i) { int R, C; stage_rc(tid * 16 + i * 8192, R, C); const int lr = h * HALF + R; const int tok = lr < nxt.nrows ? nxt.rows[lr] : 0; vA[h][i] = (unsigned)tok * (unsigned)(K * 2) + (unsigned)(C * 2); } } }
            PG8_LDA(At, 0, 1); PG8_STAGEB(PG8_SB(0, 0), rB2, o2); PG8_STAGEB(PG8_SB(0, 1), rB2, o2 + hs); PG8_STAGEA(PG8_SA(0, 0), rA2, o2, 0);
            if (fr0) PG8_WAIT_VN(RELAX + 6); else PG8_WAIT_V(8);
            PG8_WAIT_L(0); PG8_BAR; if constexpr (I8) { PG8_MMAI(1, 0, At, B0); PG8_MMAI(1, 1, At, B1); } else { PG8_MMA(1, 0, At, B0); PG8_MMA(1, 1, At, B1); } PG8_BAR; PG8_SCHED;
            PG8_LDB(B0, 1, 0); PG8_LDB(B1, 1, 1); PG8_SCHED; PG8_LDA(At, 1, 0); PG8_STAGEA(PG8_SA(0, 1), rA2, o2, 1);
            if (fr0) PG8_WAIT_VN(RELAX + 8); else PG8_WAIT_V(8);
            PG8_WAIT_L(0); PG8_BAR; if constexpr (I8) { PG8_MMAI(0, 0, At, B0); PG8_MMAI(0, 1, At, B1); } else { PG8_MMA(0, 0, At, B0); PG8_MMA(0, 1, At, B1); } PG8_BAR; PG8_SCHED;
            PG8_LDA(At, 1, 1); PG8_STAGEB(PG8_SB(1, 0), rB2, o3); PG8_STAGEB(PG8_SB(1, 1), rB2, o3 + hs); PG8_STAGEA(PG8_SA(1, 0), rA2, o3, 0);
            PG8_WAIT_V(8); PG8_WAIT_L(0); PG8_BAR; if constexpr (I8) { PG8_MMAI(1, 0, At, B0); PG8_MMAI(1, 1, At, B1); } else { PG8_MMA(1, 0, At, B0); PG8_MMA(1, 1, At, B1); } PG8_BAR; PG8_SCHED;
            }
        }
        if constexpr (ALIGN_EPI) { if (wr == 0) PG8_BAR; }
        if constexpr (RELAX > 0) { static_assert(ALIGN_EPI && !GATHER, "RELAX needs aligned epilogues and plain rows"); if (has_next) PG8_STAGEA(PG8_SA(1, 1), rAn, ks, 1); }
        if constexpr (I8) {
#pragma unroll
            for (int a = 0; a < 2; ++a)
#pragma unroll
                for (int b = 0; b < 2; ++b)
#pragma unroll
                    for (int m = 0; m < 4; ++m)
#pragma unroll
                        for (int n = 0; n < 2; ++n) { const v4i_t q = acci[a][b][m][n]; acc[a][b][m][n] = (f32x4){(float)q[0], (float)q[1], (float)q[2], (float)q[3]}; acci[a][b][m][n] = (v4i_t){0, 0, 0, 0}; } }
        E(acc, cur, wr, wc, fr, fq);
        if (!has_next) break;
#pragma unroll
        for (int a = 0; a < 2; ++a)
#pragma unroll
            for (int b = 0; b < 2; ++b)
#pragma unroll
                for (int m = 0; m < 4; ++m)
#pragma unroll
                    for (int n = 0; n < 2; ++n) acc[a][b][m][n] = (f32x4){0.f, 0.f, 0.f, 0.f};
        cur = nxt; rA = rAn; rB = rBn; ++ui; fresh = true;
        if constexpr (ALIGN_EPI) { if (wr == 1) PG8_BAR; }
    }
    PG8_WAIT_V(0);
    if constexpr (!ALIGN_EPI) { if (wr == 0) PG8_BAR; }
    PG8_BAR;
#undef PG8_SA
#undef PG8_SB
#undef PG8_STAGEV
#undef PG8_STAGEB
#undef PG8_STAGEA
#undef PG8_RSRC
#undef PG8_LDA
#undef PG8_LDB
#undef PG8_MMA
#undef PG8_LDA8
#undef PG8_LDB8
#undef PG8_MMA8
#undef PG8_MMAI
#undef PG8_WAIT_V
#undef PG8_WAIT_VN
#undef PG8_WAIT_L
#undef PG8_BAR
#undef PG8_SCHED
}
}

#define XB_TMO      128
#define XB_XCNT(j)  (256  + 64 * (j))
#define XB_XSUB(j)  (1280 + 64 * (j))
#define XB_XGEN(j)  (2304 + 64 * (j))
#define XB_TOP      3328
#define XB_TOPGEN   3392
#define XCD_BAR_WORDS 3456
#define XB_SPIN_CAP (1u << 20)
__device__ __forceinline__ unsigned xb_ld(unsigned* p)              { return __hip_atomic_load(p, __ATOMIC_RELAXED, __HIP_MEMORY_SCOPE_AGENT); }
__device__ __forceinline__ unsigned xb_add(unsigned* p, unsigned v) { return __hip_atomic_fetch_add(p, v, __ATOMIC_RELAXED, __HIP_MEMORY_SCOPE_AGENT); }
__device__ __forceinline__ unsigned xb_xcc_id() { return (unsigned)__builtin_amdgcn_s_getreg((3 << 11) | 20) & 0xFu; }
#define XB_SPIN(cond, bar) do { unsigned _sp = 0; while (cond) { __builtin_amdgcn_s_sleep(1); \
    if ((++_sp & 255u) == 0u) { if (xb_ld(&(bar)[XB_TMO])) break; if (_sp > XB_SPIN_CAP) { atomicAdd(&(bar)[XB_TMO], 1u); break; } } } } while (0)
struct XcdBarrier { unsigned* bar; unsigned x; volatile LAS unsigned* st; };
__device__ __forceinline__ XcdBarrier xcd_barrier_post(unsigned* bar, volatile LAS unsigned* st, int tid) {
    XcdBarrier b; b.bar = bar; b.x = xb_xcc_id(); b.st = st;
    if (tid == 0) (void)xb_add(&bar[XB_XCNT(b.x)], 1u);
    return b;
}
__device__ __forceinline__ void xcd_barrier_complete(unsigned* bar, unsigned x, unsigned& nloc, unsigned& nx) {
    const unsigned G = gridDim.x * gridDim.y * gridDim.z;
    unsigned sum, cnt, mine, sp = 0u;
    for (;;) {
        sum = 0u; cnt = 0u; mine = 0u;
#pragma unroll
        for (unsigned j = 0; j < 16; ++j) { const unsigned c = xb_ld(&bar[XB_XCNT(j)]); sum += c; cnt += (c > 0u) ? 1u : 0u; mine = (j == x) ? c : mine; }
        if (sum == G) break;
        __builtin_amdgcn_s_sleep(1);
        if ((++sp & 255u) == 0u) { if (xb_ld(&bar[XB_TMO])) break; if (sp > XB_SPIN_CAP) { atomicAdd(&bar[XB_TMO], 1u); break; } }
    }
    nloc = mine > 0u ? mine : 1u; nx = cnt > 0u ? cnt : 1u;
}
__device__ __forceinline__ void xcd_barrier(const XcdBarrier& b, int tid) {
    asm volatile("s_waitcnt vmcnt(0)" ::: "memory");
    __syncthreads();
    if (tid == 0) {
        unsigned* bar = b.bar;
        __builtin_amdgcn_s_waitcnt(0);
        unsigned nloc = b.st[0], nx = b.st[1];
        if (nloc == 0u) { xcd_barrier_complete(bar, b.x, nloc, nx); b.st[0] = nloc; b.st[1] = nx; }
        const unsigned old = xb_add(&bar[XB_XSUB(b.x)], 1u);
        const unsigned gen = old / nloc;
        if (old + 1u == (gen + 1u) * nloc) {
            __builtin_amdgcn_fence(__ATOMIC_RELEASE, "agent");
            asm volatile("s_waitcnt vmcnt(0)" ::: "memory");
            const unsigned og = xb_add(&bar[XB_TOP], 1u);
            const unsigned tg = og / nx;
            if (og + 1u == (tg + 1u) * nx) xb_add(&bar[XB_TOPGEN], 1u);
            else XB_SPIN(xb_ld(&bar[XB_TOPGEN]) == tg, bar);
            __builtin_amdgcn_fence(__ATOMIC_ACQUIRE, "agent");
            xb_add(&bar[XB_XGEN(b.x)], 1u);
            asm volatile("s_waitcnt vmcnt(0)" ::: "memory");
        } else {
            XB_SPIN(xb_ld(&bar[XB_XGEN(b.x)]) == gen, bar);
            __builtin_amdgcn_fence(__ATOMIC_ACQUIRE, "agent");
            asm volatile("s_waitcnt vmcnt(0)" ::: "memory");
        }
    }
    __syncthreads();
}

__device__ __forceinline__ void split_arrive(unsigned* ctr, int tid) {
    asm volatile("s_waitcnt vmcnt(0)" ::: "memory");
    __syncthreads();
    if (tid == 0) { __builtin_amdgcn_fence(__ATOMIC_RELEASE, "agent"); asm volatile("s_waitcnt vmcnt(0)" ::: "memory"); (void)xb_add(ctr, 1u); }
}
__device__ __forceinline__ void split_wait(unsigned* ctr, unsigned* bar, unsigned G, int tid) {
    asm volatile("s_waitcnt vmcnt(0)" ::: "memory");
    __syncthreads();
    if (tid == 0) { XB_SPIN(xb_ld(ctr) < G, bar); __builtin_amdgcn_fence(__ATOMIC_ACQUIRE, "agent"); asm volatile("s_waitcnt vmcnt(0)" ::: "memory"); }
    __syncthreads();
}

struct Frame {
    LAS unsigned char* lds;
    int tid, lane, wave, G, gw, NGW;
    unsigned char* ws; float* out; unsigned* ctl;
    const __attribute__((address_space(4))) void* const* kin;
    __device__ __forceinline__ const float* x() const { return (const float*)kin[0]; }
    __device__ __forceinline__ const int* pos() const { return (const int*)kin[1]; }
    __device__ __forceinline__ const float* mixw() const { return (const float*)kin[2]; }
    __device__ __forceinline__ const float* w_in() const { return (const float*)kin[3]; }
    __device__ __forceinline__ const float* qnw() const { return (const float*)kin[4]; }
    __device__ __forceinline__ const float* knw() const { return (const float*)kin[5]; }
    __device__ __forceinline__ const float* iknw() const { return (const float*)kin[6]; }
    __device__ __forceinline__ const float* convw() const { return (const float*)kin[7]; }
    __device__ __forceinline__ const float* alog() const { return (const float*)kin[8]; }
    __device__ __forceinline__ const float* dtb() const { return (const float*)kin[9]; }
    __device__ __forceinline__ const float* gnw() const { return (const float*)kin[10]; }
    __device__ __forceinline__ const float* wpa() const { return (const float*)kin[11]; }
    __device__ __forceinline__ const float* wpg() const { return (const float*)kin[12]; }
    __device__ __forceinline__ const float* wout() const { return (const float*)kin[13]; }
    __device__ __forceinline__ const float* ffnw() const { return (const float*)kin[14]; }
    __device__ __forceinline__ const float* wrg() const { return (const float*)kin[15]; }
    __device__ __forceinline__ const float* brg() const { return (const float*)kin[16]; }
    __device__ __forceinline__ const float* wre() const { return (const float*)kin[17]; }
    __device__ __forceinline__ const float* bre() const { return (const float*)kin[18]; }
    __device__ __forceinline__ const float* wg() const { return (const float*)kin[19]; }
    __device__ __forceinline__ const float* wu() const { return (const float*)kin[20]; }
    __device__ __forceinline__ const float* wd() const { return (const float*)kin[21]; }
};
#define WSP(type, off) ((type*)(F.ws + (off)))

struct RmIn { __device__ __forceinline__ int operator()(int n) const {
    if (n < 4096) return n;
    if (n < 4160) return 20480 + (n - 4096);
    if (n < 4176) return 20544 + (n - 4160);
    if (n < 12368) return 4096 + (n - 4176);
    if (n < 12384) return 20560 + (n - 12368);
    if (n < 12400) return 20576 + (n - 12384);
    return 12288 + (n - 12400); } };
struct TDesc { const float* W; bf16* WT; unsigned char* W8; int K, N, kind, off, k0, n0; float ws8; };
__device__ __forceinline__ int t_row(const TDesc& d, int n) { return d.kind == 0 ? ~RmIn{}(n) : d.kind == 1 ? ~n : d.kind == 2 ? ~(d.off + 256 * (n >> 7) + (n & 127)) : d.off + n; }
__device__ __forceinline__ void t_load(const TDesc& d, f32x4 (&raw)[8], int lane) {
    const int nn = d.n0 + 4 * (lane & 7);
#pragma unroll
    for (int j = 0; j < 8; ++j) { const float* p = d.W + (size_t)(d.k0 + (lane >> 3) + 8 * j) * d.N + nn;
        if (nn + 3 < d.N) raw[j] = *(const f32x4*)p; else { raw[j] = (f32x4){0.f, 0.f, 0.f, 0.f}; if (nn < d.N) raw[j].x = p[0]; if (nn + 1 < d.N) raw[j].y = p[1]; if (nn + 2 < d.N) raw[j].z = p[2]; } }
}
__device__ __forceinline__ void t_store(const TDesc& d, LAS float* scr, int lane) {
    const int c = lane & 7;
#pragma unroll
    for (int j = 0; j < 4; ++j) { const int n = (lane >> 3) + 8 * j; const LAS float* s = scr + (8 * c) * 33 + n;
        if (d.n0 + n < d.N) { const int row = t_row(d, d.n0 + n);
            if (row >= 0) { u32x4 o; o.x = cvt_pk_bf16(s[0 * 33], s[1 * 33]); o.y = cvt_pk_bf16(s[2 * 33], s[3 * 33]); o.z = cvt_pk_bf16(s[4 * 33], s[5 * 33]); o.w = cvt_pk_bf16(s[6 * 33], s[7 * 33]);
                *(u32x4*)(d.WT + (size_t)row * d.K + d.k0 + 8 * c) = o; }
            else if (d.kind == 0) { const float ws8 = d.ws8; *(u32x2*)(d.W8 + (size_t)(~row) * d.K + d.k0 + 8 * c) = (u32x2){q4_i8(s[0 * 33], s[1 * 33], s[2 * 33], s[3 * 33], ws8), q4_i8(s[4 * 33], s[5 * 33], s[6 * 33], s[7 * 33], ws8)}; }
            else { unsigned lo = 0u, hi = 0u; const float ws8 = d.ws8;
                lo = cvt2_fp8(s[0 * 33] * ws8, s[1 * 33] * ws8, lo, false); lo = cvt2_fp8(s[2 * 33] * ws8, s[3 * 33] * ws8, lo, true);
                hi = cvt2_fp8(s[4 * 33] * ws8, s[5 * 33] * ws8, hi, false); hi = cvt2_fp8(s[6 * 33] * ws8, s[7 * 33] * ws8, hi, true);
                *(u32x2*)(d.W8 + (size_t)(~row) * d.K + d.k0 + 8 * c) = (u32x2){lo, hi}; } } }
}
__device__ __forceinline__ void p_amax(Frame& F) {
    const f32x4* w = (const f32x4*)F.w_in(); const size_t n4 = (size_t)4096 * NIN / 4; float am = 0.f;
    for (size_t i = (size_t)F.gw * 64 + F.lane; i < n4; i += (size_t)F.NGW * 64) { const f32x4 v = w[n4 - 1 - i];
        am = fmaxf(am, fmaxf(fmaxf(fabsf(v.x), fabsf(v.y)), fmaxf(fabsf(v.z), fabsf(v.w)))); }
#pragma unroll
    for (int o = 1; o < 64; o <<= 1) am = fmaxf(am, __shfl_xor(am, o));
    if (F.lane == 0) __hip_atomic_fetch_max(F.ctl + CW_AMAX, __float_as_uint(am), __ATOMIC_RELAXED, __HIP_MEMORY_SCOPE_AGENT);
}
constexpr int CV_I_IN = 64 * 644, CV_I_PA = 32 * 128, CV_I_OUT = 64 * 128, CV_I_G = 64 * 16, CV_I_D = 8 * 128;
constexpr int CV_NITEMS = CV_I_IN + 2 * CV_I_PA + CV_I_OUT + 32 * (2 * CV_I_G + CV_I_D);
constexpr int CV_MID = 18432;
constexpr int CV_LATE = 36864;
__device__ __forceinline__ void convert_items(Frame& F, int first, int last, int w, int nw) {
    LAS float* scr = (LAS float*)(F.lds + F.wave * 16384);
    const int lane = opaque(F.lane);
    unsigned char* WIN8 = WSP(unsigned char, WS_WIN8); bf16* WPA = WSP(bf16, WS_WPA); bf16* WPG = WSP(bf16, WS_WPG); bf16* WOUT = WSP(bf16, WS_WOUT); bf16* WGU = WSP(bf16, WS_WGU); bf16* WD = WSP(bf16, WS_WD);
    constexpr int I_IN = CV_I_IN, I_PA = CV_I_PA, I_OUT = CV_I_OUT, I_G = CV_I_G, I_D = CV_I_D;
    const float winv = 127.f / fmaxf(__uint_as_float(__hip_atomic_load(F.ctl + CW_AMAX, __ATOMIC_RELAXED, __HIP_MEMORY_SCOPE_AGENT)), 1e-30f);
    auto decode = [&](int it) -> TDesc { TDesc d; int r = it; d.WT = nullptr; d.W8 = nullptr; d.off = 0; d.ws8 = 64.f;
        if (r < I_IN) { d.W = F.w_in(); d.K = 4096; d.N = NIN; d.kind = 0; d.W8 = WIN8; d.ws8 = winv; }
        else if ((r -= I_IN) < I_PA) { d.W = F.wpa(); d.K = 2048; d.N = 4096; d.kind = 1; d.W8 = (unsigned char*)WPA; d.ws8 = 32.f; }
        else if ((r -= I_PA) < I_PA) { d.W = F.wpg(); d.K = 2048; d.N = 4096; d.kind = 1; d.W8 = (unsigned char*)WPG; d.ws8 = 32.f; }
        else if ((r -= I_PA) < I_OUT) { d.W = F.wout(); d.K = 4096; d.N = 4096; d.kind = 1; d.W8 = (unsigned char*)WOUT; }
        else { r -= I_OUT; const int e = r / (2 * I_G + I_D); r -= e * (2 * I_G + I_D);
            if (r < I_G) { d.W = F.wg() + (size_t)e * 4096 * 512; d.K = 4096; d.N = 512; d.kind = 2; d.off = e * 1024; d.W8 = (unsigned char*)WGU; }
            else if ((r -= I_G) < I_G) { d.W = F.wu() + (size_t)e * 4096 * 512; d.K = 4096; d.N = 512; d.kind = 2; d.off = e * 1024 + 128; d.W8 = (unsigned char*)WGU; }
            else { r -= I_G; d.W = F.wd() + (size_t)e * 512 * 4096; d.K = 512; d.N = 4096; d.kind = 3; d.off = e * 4096; d.WT = WD; } }
        const int nblk = (d.N + 31) / 32; d.k0 = 64 * (r / nblk); d.n0 = 32 * (r % nblk); return d; };
    {
        const int it0 = first + w;
        f32x4 raw[8]; TDesc cur = decode(it0 < last ? it0 : first);
        if (it0 < last) t_load(cur, raw, lane);
        for (int it = it0; it < last; it += nw) {
#pragma unroll
            for (int j = 0; j < 8; ++j) { LAS float* q = scr + ((lane >> 3) + 8 * j) * 33 + 4 * (lane & 7); q[0] = raw[j].x; q[1] = raw[j].y; q[2] = raw[j].z; q[3] = raw[j].w; }
            TDesc nxt = cur; const bool more = it + nw < last;
            if (more) { nxt = decode(it + nw); t_load(nxt, raw, lane); }
            LDS_WAIT(); asm volatile("" ::: "memory");
            t_store(cur, scr, lane);
            LDS_WAIT(); asm volatile("" ::: "memory");
            cur = nxt;
        }
    }
}
__device__ __forceinline__ void p0_prologue(Frame& F) {
    const int gw = F.gw, NGW = F.NGW, lane = opaque(F.lane);
    unsigned char* WIN8 = WSP(unsigned char, WS_WIN8);
    convert_items(F, 0, CV_NITEMS - CV_LATE - (F.G == 256 ? CV_MID : 0), gw, NGW);
    for (int i = gw * 64 + lane; i < 144 * 256; i += NGW * 64) *((u32x4*)(WIN8 + (size_t)NIN * 4096) + i) = (u32x4){0u, 0u, 0u, 0u};
    for (int m = gw; m < T; m += NGW) {
        const f32x4* xr = (const f32x4*)(F.x() + (size_t)m * DM) + lane; f32x4 v[16]; float s = 0.f;
#pragma unroll
        for (int j = 0; j < 16; ++j) { v[j] = xr[64 * j]; s += (v[j].x * v[j].x + v[j].y * v[j].y) + (v[j].z * v[j].z + v[j].w * v[j].w); }
        const float rs = rsqrtf(wave_sum(s) * (1.f / DM) + EPS); float am = 0.f;
#pragma unroll
        for (int j = 0; j < 16; ++j) { const f32x4 w = ((const f32x4*)F.mixw())[64 * j + lane]; v[j].x *= rs * w.x; v[j].y *= rs * w.y; v[j].z *= rs * w.z; v[j].w *= rs * w.w;
            am = fmaxf(am, fmaxf(fmaxf(fabsf(v[j].x), fabsf(v[j].y)), fmaxf(fabsf(v[j].z), fabsf(v[j].w)))); }
#pragma unroll
        for (int o = 1; o < 64; o <<= 1) am = fmaxf(am, __shfl_xor(am, o));
        am = fmaxf(am, 1e-30f); const float inv = 127.f / am;
        if (lane == 0) WSP(float, WS_SA)[m] = am * (1.f / 127.f);
        unsigned* q8 = (unsigned*)(WSP(unsigned char, WS_XN8) + (size_t)m * DM) + lane;
#pragma unroll
        for (int j = 0; j < 16; ++j) q8[64 * j] = q4_i8(v[j].x, v[j].y, v[j].z, v[j].w, inv);
    }
    { float* c128 = WSP(float, WS_R128C); float* s128 = WSP(float, WS_R128S); float* c64 = WSP(float, WS_R64C); float* s64 = WSP(float, WS_R64S);
      for (int i = gw * 64 + lane; i < T * 96; i += NGW * 64) { const int t = i / 96, j = i % 96; const bool big = j < 64; const int jj = big ? j : j - 64; const float d = big ? 128.f : 64.f;
          const float inv = exp2f(-(2.f * (float)jj / d) * 13.287712379549449f);
          const float ang = (float)F.pos()[t] * inv;
          const double rev = (double)ang * 0.15915494309189535; const float fr = (float)(rev - floor(rev));
          const float cs = __builtin_amdgcn_cosf(fr), sn = __builtin_amdgcn_sinf(fr);
          if (big) { c128[t * 64 + jj] = cs; s128[t * 64 + jj] = sn; } else { c64[t * 32 + jj] = cs; s64[t * 32 + jj] = sn; } } }
    { bf16* WRF = WSP(bf16, WS_WRF);
      for (int i = gw * 64 + lane; i < 2 * 256 * 64; i += NGW * 64) { const int ln = i & 63, s = (i >> 6) & 255, ct = i >> 14; const int col = ln & 31, hh = ln >> 5;
          float v[8];
#pragma unroll
          for (int j = 0; j < 8; ++j) { const int k = 16 * s + 8 * hh + j; float w = 0.f; if (ct == 0) w = F.wre()[((size_t)(col >> 3) * 4096 + k) * 8 + (col & 7)]; else if (col < 4) w = F.wrg()[(size_t)k * 4 + col]; v[j] = w * F.ffnw()[k]; }
          unsigned hi[4], lo[4];
#pragma unroll
          for (int j = 0; j < 4; ++j) { hi[j] = cvt_pk_bf16(v[2 * j], v[2 * j + 1]); lo[j] = cvt_pk_bf16(v[2 * j] - bflo(hi[j]), v[2 * j + 1] - bfhi(hi[j])); }
          *(u32x4*)(WRF + ((size_t)((ct * 2 + 0) * 256 + s) * 64 + ln) * 8) = (u32x4){hi[0], hi[1], hi[2], hi[3]};
          *(u32x4*)(WRF + ((size_t)((ct * 2 + 1) * 256 + s) * 64 + ln) * 8) = (u32x4){lo[0], lo[1], lo[2], lo[3]}; } }
}

struct EpiProj {
    bf16* P; float* Sm; const float* SA; float sw;
    __device__ __forceinline__ void operator()(const f32x4 (&acc)[2][2][4][2], const pg8::Unit& u, int wr, int wc, int fr, int fq) const {
        int zz; asm volatile("v_mov_b32 %0, 0" : "=v"(zz)); const int row0 = u.pm * 256 + wr * 64 + fr + zz;
        float sc[2][4];
#pragma unroll
        for (int ai = 0; ai < 2; ++ai)
#pragma unroll
            for (int m = 0; m < 4; ++m) sc[ai][m] = SA[row0 + ai * 128 + m * 16] * sw;
        if (u.pn != SMALL_PN) {
            const int col0 = u.pn * 256 + wc * 32 + 8 * fq;
#pragma unroll
            for (int ai = 0; ai < 2; ++ai)
#pragma unroll
                for (int m = 0; m < 4; ++m) { const int row = row0 + ai * 128 + m * 16; bf16* rowp = P + (size_t)row * LDP + col0;
#pragma unroll
                    for (int bj = 0; bj < 2; ++bj) { const f32x4 v0 = acc[ai][bj][m][0] * sc[ai][m], v1 = acc[ai][bj][m][1] * sc[ai][m];
                        u32x4 w; w.x = cvt_pk_bf16(v0[0], v0[1]); w.y = cvt_pk_bf16(v0[2], v0[3]); w.z = cvt_pk_bf16(v1[0], v1[1]); w.w = cvt_pk_bf16(v1[2], v1[3]);
                        *(u32x4*)(rowp + bj * 128) = w; } }
        } else {
            const int col0 = wc * 32 + 8 * fq;
#pragma unroll
            for (int ai = 0; ai < 2; ++ai)
#pragma unroll
                for (int m = 0; m < 4; ++m) { const int row = row0 + ai * 128 + m * 16; float* rowp = Sm + (size_t)row * LDSM + col0;
#pragma unroll
                    for (int bj = 0; bj < 2; ++bj) { *(f32x4*)(rowp + bj * 128) = acc[ai][bj][m][0] * sc[ai][m]; *(f32x4*)(rowp + bj * 128 + 4) = acc[ai][bj][m][1] * sc[ai][m]; } }
        }
    }
};
template <bool ADD> struct EpiGate {
    bf16* O; const bf16* P; int gcol; unsigned char* O8;
    __device__ __forceinline__ void operator()(const f32x4 (&acc)[2][2][4][2], const pg8::Unit& u, int wr, int wc, int fr, int fq) const {
        int zz; asm volatile("v_mov_b32 %0, 0" : "=v"(zz)); const int row0 = u.pm * 256 + wr * 64 + fr + zz, col0 = u.pn * 256 + wc * 32 + 8 * fq;
#pragma unroll
        for (int hq = 0; hq < 4; ++hq) { const int ai = hq >> 1, mb = (hq & 1) * 2;
            u32x4 g[2][2], pv[2][2];
#pragma unroll
            for (int mm = 0; mm < 2; ++mm)
#pragma unroll
                for (int bj = 0; bj < 2; ++bj) { const size_t row = (size_t)(row0 + ai * 128 + (mb + mm) * 16); g[mm][bj] = *(const u32x4*)(P + row * LDP + gcol + col0 + bj * 128);
                    if constexpr (ADD) pv[mm][bj] = *(const u32x4*)(O + row * DM + col0 + bj * 128); }
#pragma unroll
            for (int mm = 0; mm < 2; ++mm) { const int m = mb + mm; const size_t row = (size_t)(row0 + ai * 128 + m * 16);
#pragma unroll
                for (int bj = 0; bj < 2; ++bj) { const u32x4 gg = g[mm][bj];
                    const f32x4 v0 = acc[ai][bj][m][0], v1 = acc[ai][bj][m][1];
                    float r[8] = {v0[0] * sigmoidf_(bflo(gg.x)), v0[1] * sigmoidf_(bfhi(gg.x)), v0[2] * sigmoidf_(bflo(gg.y)), v0[3] * sigmoidf_(bfhi(gg.y)),
                                  v1[0] * sigmoidf_(bflo(gg.z)), v1[1] * sigmoidf_(bfhi(gg.z)), v1[2] * sigmoidf_(bflo(gg.w)), v1[3] * sigmoidf_(bfhi(gg.w))};
                    if constexpr (ADD) { const u32x4 p = pv[mm][bj]; r[0] += bflo(p.x); r[1] += bfhi(p.x); r[2] += bflo(p.y); r[3] += bfhi(p.y); r[4] += bflo(p.z); r[5] += bfhi(p.z); r[6] += bflo(p.w); r[7] += bfhi(p.w);
                        unsigned w0 = 0u, w1 = 0u;
                        w0 = cvt2_fp8(r[0] * 32.f, r[1] * 32.f, w0, false); w0 = cvt2_fp8(r[2] * 32.f, r[3] * 32.f, w0, true);
                        w1 = cvt2_fp8(r[4] * 32.f, r[5] * 32.f, w1, false); w1 = cvt2_fp8(r[6] * 32.f, r[7] * 32.f, w1, true);
                        *(u32x2*)(O8 + row * DM + col0 + bj * 128) = (u32x2){w0, w1}; }
                    else { u32x4 w; w.x = cvt_pk_bf16(r[0], r[1]); w.y = cvt_pk_bf16(r[2], r[3]); w.z = cvt_pk_bf16(r[4], r[5]); w.w = cvt_pk_bf16(r[6], r[7]);
                        *(u32x4*)(O + row * DM + col0 + bj * 128) = w; } } }
        }
    }
};
struct EpiRes {
    bf16* O; const float* R;
    __device__ __forceinline__ void operator()(const f32x4 (&acc)[2][2][4][2], const pg8::Unit& u, int wr, int wc, int fr, int fq) const {
        int zz; asm volatile("v_mov_b32 %0, 0" : "=v"(zz)); const int row0 = u.pm * 256 + wr * 64 + fr + zz, col0 = u.pn * 256 + wc * 32 + 8 * fq;
#pragma unroll
        for (int ai = 0; ai < 2; ++ai) {
            f32x4 rv[4][2][2];
#pragma unroll
            for (int m = 0; m < 4; ++m)
#pragma unroll
                for (int bj = 0; bj < 2; ++bj) { const size_t off = (size_t)(row0 + ai * 128 + m * 16) * DM + col0 + bj * 128; rv[m][bj][0] = *(const f32x4*)(R + off); rv[m][bj][1] = *(const f32x4*)(R + off + 4); }
#pragma unroll
            for (int m = 0; m < 4; ++m)
#pragma unroll
                for (int bj = 0; bj < 2; ++bj) { const size_t off = (size_t)(row0 + ai * 128 + m * 16) * DM + col0 + bj * 128;
                    const f32x4 v0 = rv[m][bj][0] + acc[ai][bj][m][0], v1 = rv[m][bj][1] + acc[ai][bj][m][1];
                    *(u32x4*)(O + off) = (u32x4){cvt_pk_bf16(v0[0], v0[1]), cvt_pk_bf16(v0[2], v0[3]), cvt_pk_bf16(v1[0], v1[1]), cvt_pk_bf16(v1[2], v1[3])}; }
        }
    }
};

template <int K>
__device__ __forceinline__ f32x16 mma32(f32x16 acc, const LAS bf16* A, int lda, const LAS bf16* Bt, int ldb, int r, int hh) {
    const LAS bf16* ap = A + r * lda + 8 * hh; const LAS bf16* bp = Bt + r * ldb + 8 * hh;
#pragma unroll
    for (int k0 = 0; k0 < K; k0 += 16) { const bf16x8 a = *(const LAS bf16x8*)(ap + k0); const bf16x8 b = *(const LAS bf16x8*)(bp + k0); acc = __builtin_amdgcn_mfma_f32_32x32x16_bf16(a, b, acc, 0, 0, 0); }
    return acc;
}
__device__ __forceinline__ u32x4 pack8(const f32x16& a, int b0) { u32x4 w; w.x = cvt_pk_bf16(a[b0 + 0], a[b0 + 1]); w.y = cvt_pk_bf16(a[b0 + 2], a[b0 + 3]); w.z = cvt_pk_bf16(a[b0 + 4], a[b0 + 5]); w.w = cvt_pk_bf16(a[b0 + 6], a[b0 + 7]); return w; }
__device__ __forceinline__ void unpack8(f32x16& a, int b0, const u32x4 w) { a[b0 + 0] = bflo(w.x); a[b0 + 1] = bfhi(w.x); a[b0 + 2] = bflo(w.y); a[b0 + 3] = bfhi(w.y); a[b0 + 4] = bflo(w.z); a[b0 + 5] = bfhi(w.z); a[b0 + 6] = bflo(w.w); a[b0 + 7] = bfhi(w.w); }

__device__ __forceinline__ void p2_post_token(Frame& F, int tok) {
    const int lane = opaque(F.lane); const int b = tok / SEQ, s = tok % SEQ;
    const bf16* P = WSP(bf16, WS_PROJ) + (size_t)tok * LDP;
    const float* rc = WSP(float, WS_R128C) + (size_t)tok * 64; const float* rs = WSP(float, WS_R128S) + (size_t)tok * 64;
#pragma unroll
    for (int pass = 0; pass < 2; ++pass) {
        if (pass == 1 && lane >= 16) break;
        const int head = lane >> 2, sub = lane & 3;
        const bf16* src = P + (pass ? C_AK : C_AQ) + head * 128 + 16 * sub;
        const float* nw = pass ? F.knw() : F.qnw();
        const u32x4 a0 = *(const u32x4*)src, a1 = *(const u32x4*)(src + 8), b0 = *(const u32x4*)(src + 64), b1 = *(const u32x4*)(src + 72);
        float x1[16], x2[16];
        { const unsigned wa[8] = {a0.x, a0.y, a0.z, a0.w, a1.x, a1.y, a1.z, a1.w}, wb[8] = {b0.x, b0.y, b0.z, b0.w, b1.x, b1.y, b1.z, b1.w};
#pragma unroll
          for (int j = 0; j < 8; ++j) { x1[2 * j] = bflo(wa[j]); x1[2 * j + 1] = bfhi(wa[j]); x2[2 * j] = bflo(wb[j]); x2[2 * j + 1] = bfhi(wb[j]); } }
        float ss = 0.f;
#pragma unroll
        for (int e = 0; e < 16; ++e) ss += x1[e] * x1[e] + x2[e] * x2[e];
        ss += __shfl_xor(ss, 1); ss += __shfl_xor(ss, 2);
        const float rinv = rsqrtf(ss * (1.f / 128.f) + EPS);
        unsigned o1[8], o2[8];
#pragma unroll
        for (int e = 0; e < 16; e += 2) {
            float r1[2], r2[2];
#pragma unroll
            for (int q = 0; q < 2; ++q) { const int d = 16 * sub + e + q; const float c = rc[d], sn = rs[d]; const float y1 = x1[e + q] * rinv * nw[d], y2 = x2[e + q] * rinv * nw[d + 64];
                r1[q] = y1 * c - y2 * sn; r2[q] = y2 * c + y1 * sn; }
            o1[e >> 1] = cvt_pk_bf16(r1[0], r1[1]); o2[e >> 1] = cvt_pk_bf16(r2[0], r2[1]);
        }
        bf16* dst = pass ? (WSP(bf16, WS_KB) + ((size_t)(b * 4 + head) * SEQ + s) * 128 + 16 * sub) : (WSP(bf16, WS_QB) + ((size_t)(b * 16 + head) * SEQ + s) * 128 + 16 * sub);
        *(u32x4*)dst = (u32x4){o1[0], o1[1], o1[2], o1[3]}; *(u32x4*)(dst + 8) = (u32x4){o1[4], o1[5], o1[6], o1[7]};
        *(u32x4*)(dst + 64) = (u32x4){o2[0], o2[1], o2[2], o2[3]}; *(u32x4*)(dst + 72) = (u32x4){o2[4], o2[5], o2[6], o2[7]};
    }
    if (lane < 8) {
        const float* sm = WSP(float, WS_SMALL) + (size_t)tok * LDSM + SM_IK;
        const f32x4 a = *(const f32x4*)(sm + 4 * lane), c = *(const f32x4*)(sm + 32 + 4 * lane);
        float ss = (a.x * a.x + a.y * a.y) + (a.z * a.z + a.w * a.w) + (c.x * c.x + c.y * c.y) + (c.z * c.z + c.w * c.w);
        ss += __shfl_xor(ss, 1); ss += __shfl_xor(ss, 2); ss += __shfl_xor(ss, 4);
        const float rinv = rsqrtf(ss * (1.f / 64.f) + EPS);
        const float* r64c = WSP(float, WS_R64C) + (size_t)tok * 32 + 4 * lane; const float* r64s = WSP(float, WS_R64S) + (size_t)tok * 32 + 4 * lane;
        float r1[4], r2[4];
#pragma unroll
        for (int e = 0; e < 4; ++e) { const float y1 = a[e] * rinv * F.iknw()[4 * lane + e], y2 = c[e] * rinv * F.iknw()[32 + 4 * lane + e]; const float cs = r64c[e], sn = r64s[e]; r1[e] = y1 * cs - y2 * sn; r2[e] = y2 * cs + y1 * sn; }
        const int tile = s >> 5, cc = s & 31, p = lane >> 1;
        bf16* base = WSP(bf16, WS_IKF);
        { const int ks = p >> 1, hf = p & 1; *(u32x2*)(base + ((size_t)((b * 128 + tile) * 4 + ks) * 64 + hf * 32 + cc) * 8 + 4 * (lane & 1)) = (u32x2){cvt_pk_bf16(r1[0], r1[1]), cvt_pk_bf16(r1[2], r1[3])}; }
        { const int ks = (p >> 1) + 2, hf = p & 1; *(u32x2*)(base + ((size_t)((b * 128 + tile) * 4 + ks) * 64 + hf * 32 + cc) * 8 + 4 * (lane & 1)) = (u32x2){cvt_pk_bf16(r2[0], r2[1]), cvt_pk_bf16(r2[2], r2[3])}; }
    }
}

constexpr int G_QH = 0, G_KH = 17408, G_VBT = 35840, G_KBT = 54272, G_KDT = 72704, G_L = 91136, G_TM = 109568, G_IN = 118784, G_SM = 128000;
constexpr int G_WT = G_KH, G_UT = G_L;
constexpr int G_CW = 135168;
__device__ __forceinline__ void gdn_chunk(Frame& F, int cid, const int gm = 9) {
    const int lane = opaque(F.lane), wid = F.wave, tid = wid * 64 + lane, r = lane & 31, hh = lane >> 5;
    const int b = cid >> 10, h = (cid >> 6) & 15, n = cid & 63, t0 = n * 64, row0 = b * SEQ + t0;
    LAS bf16* Qh = (LAS bf16*)(F.lds + G_QH); LAS bf16* Kh = (LAS bf16*)(F.lds + G_KH); LAS bf16* VbT = (LAS bf16*)(F.lds + G_VBT); LAS bf16* KbT = (LAS bf16*)(F.lds + G_KBT);
    LAS bf16* KdT = (LAS bf16*)(F.lds + G_KDT); LAS float* Lf = (LAS float*)(F.lds + G_L); LAS bf16* Tm = (LAS bf16*)(F.lds + G_TM); LAS bf16* In = (LAS bf16*)(F.lds + G_IN);
    LAS bf16* WT = (LAS bf16*)(F.lds + G_WT); LAS bf16* UT = (LAS bf16*)(F.lds + G_UT);
    LAS bf16* Vh = (LAS bf16*)(F.lds + G_L);
    LAS bf16* T11t = (LAS bf16*)(F.lds + G_KH); LAS bf16* Xt = T11t + 32 * 40;
    LAS float* sm_gc = (LAS float*)(F.lds + G_SM); LAS float* sm_beta = sm_gc + 64; LAS float* sm_eg = sm_gc + 128; LAS float* sm_ed = sm_gc + 192;
    const bf16* PROJ = WSP(bf16, WS_PROJ); const float* SMALL = WSP(float, WS_SMALL);
    const int rr = tid >> 3, c0 = 16 * (tid & 7);
    u32x4 raw[3][4][2];
#pragma unroll
    for (int tz = 0; tz < 3; ++tz)
#pragma unroll
        for (int m = 0; m < 4; ++m) { const int trow = t0 + rr - 3 + m; const int tr = trow < 0 ? 0 : trow;
            const bf16* src = PROJ + (size_t)(b * SEQ + tr) * LDP + (tz == 0 ? C_GQ : tz == 1 ? C_GK : C_GV) + h * 128 + c0;
            raw[tz][m][0] = *(const u32x4*)src; raw[tz][m][1] = *(const u32x4*)(src + 8); }
    if (wid == 0) {
        const float a = SMALL[(size_t)(row0 + lane) * LDSM + SM_GA + h], bb = SMALL[(size_t)(row0 + lane) * LDSM + SM_GB + h];
        const float xx = a + F.dtb()[h]; const float sp = xx > 20.f ? xx : log1pf(__expf(xx));
        float gc = -__expf(F.alog()[h]) * sp;
#pragma unroll
        for (int o = 1; o < 64; o <<= 1) { const float v = __shfl_up(gc, o); if (lane >= o) gc += v; }
        const float Gl = __shfl(gc, 63);
        sm_gc[lane] = gc; sm_beta[lane] = sigmoidf_(bb); sm_eg[lane] = __expf(gc); sm_ed[lane] = __expf(Gl - gc);
        if (lane == 0) WSP(float, WS_GG)[cid] = __expf(Gl);
    }
    __syncthreads();
    {
        const LAS float* CW = (const LAS float*)(F.lds + G_CW);
#pragma unroll
        for (int tz = 0; tz < 3; ++tz) {
            float y[16];
#pragma unroll
            for (int e = 0; e < 16; ++e) y[e] = 0.f;
#pragma unroll
            for (int m = 0; m < 4; ++m) {
                const float on = (t0 + rr - 3 + m) >= 0 ? 1.f : 0.f;
                const LAS float* cw = CW + (tz * 4 + m) * 128 + c0;
                const f32x4 w0 = *(const LAS f32x4*)cw * on, w1 = *(const LAS f32x4*)(cw + 4) * on, w2 = *(const LAS f32x4*)(cw + 8) * on, w3 = *(const LAS f32x4*)(cw + 12) * on;
                const u32x4 a0 = raw[tz][m][0], a1 = raw[tz][m][1];
                y[0] += w0.x * bflo(a0.x); y[1] += w0.y * bfhi(a0.x); y[2] += w0.z * bflo(a0.y); y[3] += w0.w * bfhi(a0.y);
                y[4] += w1.x * bflo(a0.z); y[5] += w1.y * bfhi(a0.z); y[6] += w1.z * bflo(a0.w); y[7] += w1.w * bfhi(a0.w);
                y[8] += w2.x * bflo(a1.x); y[9] += w2.y * bfhi(a1.x); y[10] += w2.z * bflo(a1.y); y[11] += w2.w * bfhi(a1.y);
                y[12] += w3.x * bflo(a1.z); y[13] += w3.y * bfhi(a1.z); y[14] += w3.z * bflo(a1.w); y[15] += w3.w * bfhi(a1.w);
            }
            float ss = 0.f;
#pragma unroll
            for (int e = 0; e < 16; ++e) { y[e] = y[e] * sigmoidf_(y[e]); ss += y[e] * y[e]; }
            if (tz < 2) { ss += __shfl_xor(ss, 1); ss += __shfl_xor(ss, 2); ss += __shfl_xor(ss, 4); const float rinv = rsqrtf(ss + EPS) * (tz == 0 ? 0.08838834764831845f : 1.f);
#pragma unroll
                for (int e = 0; e < 16; ++e) y[e] *= rinv; }
            LAS bf16* d = (tz == 0 ? Qh : tz == 1 ? Kh : Vh) + rr * 136 + c0;
            *(LAS u32x4*)d = (u32x4){cvt_pk_bf16(y[0], y[1]), cvt_pk_bf16(y[2], y[3]), cvt_pk_bf16(y[4], y[5]), cvt_pk_bf16(y[6], y[7])};
            *(LAS u32x4*)(d + 8) = (u32x4){cvt_pk_bf16(y[8], y[9]), cvt_pk_bf16(y[10], y[11]), cvt_pk_bf16(y[12], y[13]), cvt_pk_bf16(y[14], y[15])};
        }
    }
    __syncthreads();
    if (gm == 1) return;
    {
        const int i = lane, c0 = 16 * wid; const float beta = sm_beta[i], eg = sm_eg[i], ed = sm_ed[i];
        const u32x4 k0 = *(const LAS u32x4*)(Kh + i * 136 + c0), k1 = *(const LAS u32x4*)(Kh + i * 136 + c0 + 8), v0 = *(const LAS u32x4*)(Vh + i * 136 + c0), v1 = *(const LAS u32x4*)(Vh + i * 136 + c0 + 8);
        const unsigned kw[8] = {k0.x, k0.y, k0.z, k0.w, k1.x, k1.y, k1.z, k1.w}, vw[8] = {v0.x, v0.y, v0.z, v0.w, v1.x, v1.y, v1.z, v1.w};
#pragma unroll
        for (int q = 0; q < 8; ++q) { const float ka = bflo(kw[q]), kb = bfhi(kw[q]), va = bflo(vw[q]), vb = bfhi(vw[q]);
            KbT[(c0 + 2 * q) * 72 + i] = f2bf(ka * beta * eg); KbT[(c0 + 2 * q + 1) * 72 + i] = f2bf(kb * beta * eg);
            KdT[(c0 + 2 * q) * 72 + i] = f2bf(ka * ed); KdT[(c0 + 2 * q + 1) * 72 + i] = f2bf(kb * ed);
            VbT[(c0 + 2 * q) * 72 + i] = f2bf(va * beta); VbT[(c0 + 2 * q + 1) * 72 + i] = f2bf(vb * beta); }
    }
    __syncthreads();
    if (gm == 2) return;
    if (wid < 6) {
        const int which = wid / 3, ti = wid % 3, a = ti ? 1 : 0, bt = ti == 2 ? 1 : 0;
        f32x16 acc = {};
        acc = mma32<128>(acc, (which ? Qh : Kh) + 32 * a * 136, 136, Kh + 32 * bt * 136, 136, r, hh);
        const int j = 32 * bt + r; const float gcj = sm_gc[j];
#pragma unroll
        for (int i = 0; i < 16; ++i) { const int ii = 32 * a + crow(i, hh); const float dec = __expf(sm_gc[ii] - gcj);
            if (which == 0) Lf[ii * 72 + j] = (ii > j) ? sm_beta[ii] * acc[i] * dec : 0.f;
            else In[ii * 72 + j] = f2bf((ii >= j) ? acc[i] * dec : 0.f); }
    } else if (wid == 6) {
#pragma unroll
        for (int i = 0; i < 16; ++i) In[(2 * i + hh) * 72 + 32 + r] = 0;
    }
    __syncthreads();
    if (gm == 3) return;
    if (wid == 0) {
        const int hb = lane >> 5, cc = lane & 31;
        int zoff; asm volatile("v_mov_b32 %0, 0" : "=v"(zoff));
        const LAS float* Ld = Lf + (32 * hb) * 72 + 32 * hb + zoff;
        float x[32];
#pragma unroll
        for (int i = 0; i < 32; ++i) {
            float v = (i == cc) ? 1.f : 0.f;
#pragma unroll
            for (int j4 = 0; j4 < i; j4 += 4) { const f32x4 l4 = *(const LAS f32x4*)(Ld + i * 72 + j4);
                v -= l4.x * x[j4]; if (j4 + 1 < i) v -= l4.y * x[j4 + 1]; if (j4 + 2 < i) v -= l4.z * x[j4 + 2]; if (j4 + 3 < i) v -= l4.w * x[j4 + 3]; }
            x[i] = v; Tm[(32 * hb + i) * 72 + 32 * hb + cc] = f2bf(v);
            if (hb == 0) Tm[i * 72 + 32 + cc] = 0;
        }
        if (hb == 0) {
#pragma unroll
            for (int q = 0; q < 4; ++q) *(LAS u32x4*)(T11t + cc * 40 + 8 * q) = (u32x4){cvt_pk_bf16(x[8 * q], x[8 * q + 1]), cvt_pk_bf16(x[8 * q + 2], x[8 * q + 3]), cvt_pk_bf16(x[8 * q + 4], x[8 * q + 5]), cvt_pk_bf16(x[8 * q + 6], x[8 * q + 7])}; }
        f32x16 X = {};
#pragma unroll
        for (int ks = 0; ks < 2; ++ks) { const LAS float* lp = Lf + (32 + r) * 72 + 16 * ks + 8 * hh; const f32x4 l0 = *(const LAS f32x4*)lp, l1 = *(const LAS f32x4*)(lp + 4);
            const u32x4 aw = {cvt_pk_bf16(l0.x, l0.y), cvt_pk_bf16(l0.z, l0.w), cvt_pk_bf16(l1.x, l1.y), cvt_pk_bf16(l1.z, l1.w)};
            const bf16x8 bb = *(const LAS bf16x8*)(T11t + r * 40 + 16 * ks + 8 * hh);
            X = __builtin_amdgcn_mfma_f32_32x32x16_bf16(*(const bf16x8*)&aw, bb, X, 0, 0, 0); }
#pragma unroll
        for (int g = 0; g < 4; ++g) *(LAS u32x2*)(Xt + r * 40 + 8 * g + 4 * hh) = (u32x2){cvt_pk_bf16(X[4 * g], X[4 * g + 1]), cvt_pk_bf16(X[4 * g + 2], X[4 * g + 3])};
        f32x16 Y = {};
#pragma unroll
        for (int ks = 0; ks < 2; ++ks) { const bf16x8 aa = *(const LAS bf16x8*)(Tm + (32 + r) * 72 + 32 + 16 * ks + 8 * hh); const bf16x8 bb = *(const LAS bf16x8*)(Xt + r * 40 + 16 * ks + 8 * hh);
            Y = __builtin_amdgcn_mfma_f32_32x32x16_bf16(aa, bb, Y, 0, 0, 0); }
#pragma unroll
        for (int i = 0; i < 16; ++i) Tm[(32 + crow(i, hh)) * 72 + r] = f2bf(-Y[i]);
    }
    __syncthreads();
    if (gm == 4) return;
#ifdef DBG_G1
    {
        u32x4* GQd = WSP(u32x4, WS_GQ) + (size_t)cid * 1024; u32x4* GOd = WSP(u32x4, WS_GO) + (size_t)cid * 1024;
        const int row = tid >> 3, c8 = (tid & 7) * 8;
        GQd[tid] = *(const LAS u32x4*)((LAS bf16*)(F.lds + DBG_G1_A) + row * 72 + c8); GOd[tid] = *(const LAS u32x4*)((LAS bf16*)(F.lds + DBG_G1_B) + row * 72 + c8);
        GQd[512 + tid] = (u32x4){0u, 0u, 0u, 0u}; GOd[512 + tid] = (u32x4){0u, 0u, 0u, 0u};
        __syncthreads(); return;
    }
#endif
#pragma unroll
    for (int q = 0; q < 2; ++q) { const int idx = 2 * wid + q, which = idx >> 3, a = (idx >> 2) & 1, bt = idx & 3;
        f32x16 acc = {};
        acc = mma32<64>(acc, Tm + 32 * a * 72, 72, (which ? KbT : VbT) + 32 * bt * 72, 72, r, hh);
        LAS bf16* dst = (which ? WT : UT) + (32 * bt + r) * 72 + 32 * a + 4 * hh;
#pragma unroll
        for (int g = 0; g < 4; ++g) *(LAS u32x2*)(dst + 8 * g) = (u32x2){cvt_pk_bf16(acc[4 * g], acc[4 * g + 1]), cvt_pk_bf16(acc[4 * g + 2], acc[4 * g + 3])};
    }
    __syncthreads();
    if (gm == 5) return;
    {
        u32x4* GP = (u32x4*)F.out + (size_t)cid * 2048;
        u32x4* GB = (u32x4*)((unsigned char*)F.out + 128 * MiB) + (size_t)cid * 2048;
        u32x4* GQ = WSP(u32x4, WS_GQ) + (size_t)cid * 1024;
        u32x4* GO = WSP(u32x4, WS_GO) + (size_t)cid * 1024;
#pragma unroll
        for (int q = 0; q < 2; ++q) { const int idx = 2 * wid + q, a = idx >> 2, bt = idx & 3;
            { f32x16 acc = {}; acc = mma32<64>(acc, WT + 32 * a * 72, 72, KdT + 32 * bt * 72, 72, r, hh);
#pragma unroll
              for (int i = 0; i < 16; ++i) acc[i] = -acc[i];
              GP[(bt * 8 + 2 * a) * 64 + lane] = pack8(acc, 0); GP[(bt * 8 + 2 * a + 1) * 64 + lane] = pack8(acc, 8); }
            { f32x16 acc = {}; acc = mma32<64>(acc, KdT + 32 * a * 72, 72, UT + 32 * bt * 72, 72, r, hh);
              GB[((bt * 4 + a) * 2) * 64 + lane] = pack8(acc, 0); GB[((bt * 4 + a) * 2 + 1) * 64 + lane] = pack8(acc, 8); }
        }
        { const int a = wid >> 1, bt = wid & 1;
          f32x16 acc = {}; acc = mma32<64>(acc, WT + 32 * a * 72, 72, In + 32 * bt * 72, 72, r, hh);
          const int ii = 32 * bt + r; const float eg = sm_eg[ii];
#pragma unroll
          for (int g = 0; g < 4; ++g) { const u32x2 qv = *(const LAS u32x2*)(Qh + ii * 136 + 32 * a + 8 * g + 4 * hh);
              acc[4 * g] = bflo(qv.x) * eg - acc[4 * g]; acc[4 * g + 1] = bfhi(qv.x) * eg - acc[4 * g + 1]; acc[4 * g + 2] = bflo(qv.y) * eg - acc[4 * g + 2]; acc[4 * g + 3] = bfhi(qv.y) * eg - acc[4 * g + 3]; }
          GQ[(bt * 8 + 2 * a) * 64 + lane] = pack8(acc, 0); GQ[(bt * 8 + 2 * a + 1) * 64 + lane] = pack8(acc, 8); }
        { const int a = wid >> 2, bt = wid & 3;
          f32x16 acc = {}; acc = mma32<64>(acc, In + 32 * a * 72, 72, UT + 32 * bt * 72, 72, r, hh);
          GO[((bt * 2 + a) * 2) * 64 + lane] = pack8(acc, 0); GO[((bt * 2 + a) * 2 + 1) * 64 + lane] = pack8(acc, 8); }
    }
    LDS_BARRIER();
}

__device__ __forceinline__ void gdn_scan_wg(Frame& F, int bh, int half) {
    const int lane = opaque(F.lane), wid = F.wave, r = lane & 31, hh = lane >> 5, grp = wid >> 2, a = wid & 3, slice = 2 * half + grp; const int b = bh >> 4, h = bh & 15;
    LAS u32x4* SB = (LAS u32x4*)F.lds + grp * 1024;
    const float* GG = WSP(float, WS_GG); bf16* OSC = WSP(bf16, WS_OSC);
    const u32x4* GPb = (const u32x4*)F.out + (size_t)bh * 64 * 2048 + (a * 8) * 64 + lane;
    const u32x4* GBb = (const u32x4*)((unsigned char*)F.out + 128 * MiB) + (size_t)bh * 64 * 2048 + slice * 512 + (a * 2) * 64 + lane;
    const u32x4* GQb = WSP(u32x4, WS_GQ) + (size_t)bh * 64 * 1024 + ((a & 1) * 8) * 64 + lane;
    const u32x4* GOb = WSP(u32x4, WS_GO) + (size_t)bh * 64 * 1024 + slice * 256 + ((a & 1) * 2) * 64 + lane;
    f32x16 S = {};
    u32x4 Pv[8], Bv[2], Qv[8], Ov[2]; float gam;
#pragma unroll
    for (int s = 0; s < 8; ++s) Pv[s] = GPb[s * 64];
    Bv[0] = GBb[0]; Bv[1] = GBb[64]; gam = GG[bh * 64];
    if (a < 2) {
#pragma unroll
        for (int s = 0; s < 8; ++s) Qv[s] = GQb[s * 64];
        Ov[0] = GOb[0]; Ov[1] = GOb[64]; }
    for (int n = 0; n < 64; ++n) {
        LAS u32x4* sb = SB + (n & 1) * 512;
        sb[(2 * a) * 64 + lane] = pack8(S, 0); sb[(2 * a + 1) * 64 + lane] = pack8(S, 8);
        asm volatile("s_waitcnt lgkmcnt(0)" ::: "memory"); __builtin_amdgcn_s_barrier(); asm volatile("" ::: "memory");
        u32x4 sf[8];
#pragma unroll
        for (int s = 0; s < 8; ++s) sf[s] = sb[s * 64 + lane];
        f32x16 c; unpack8(c, 0, Bv[0]); unpack8(c, 8, Bv[1]);
#pragma unroll
        for (int i = 0; i < 16; ++i) c[i] += gam * S[i];
#pragma unroll
        for (int s = 0; s < 8; ++s) c = __builtin_amdgcn_mfma_f32_32x32x16_bf16(*(const bf16x8*)&Pv[s], *(const bf16x8*)&sf[s], c, 0, 0, 0);
        S = c;
        if (n + 1 < 64) { const size_t o1 = (size_t)(n + 1) * 2048;
#pragma unroll
            for (int s = 0; s < 8; ++s) Pv[s] = GPb[o1 + s * 64];
            Bv[0] = GBb[o1]; Bv[1] = GBb[o1 + 64]; gam = GG[bh * 64 + n + 1]; }
        if (a < 2) {
            f32x16 o; unpack8(o, 0, Ov[0]); unpack8(o, 8, Ov[1]);
#pragma unroll
            for (int s = 0; s < 8; ++s) o = __builtin_amdgcn_mfma_f32_32x32x16_bf16(*(const bf16x8*)&Qv[s], *(const bf16x8*)&sf[s], o, 0, 0, 0);
            if (n + 1 < 64) { const size_t o2 = (size_t)(n + 1) * 1024;
#pragma unroll
                for (int s = 0; s < 8; ++s) Qv[s] = GQb[o2 + s * 64];
                Ov[0] = GOb[o2]; Ov[1] = GOb[o2 + 64]; }
            bf16* op = OSC + (size_t)(b * SEQ + n * 64 + 32 * a) * 2048 + h * 128 + 32 * slice + r;
#pragma unroll
            for (int i = 0; i < 16; ++i) op[(size_t)crow(i, hh) * 2048] = f2bf(o[i]);
        }
    }
    __syncthreads();
}

__device__ __forceinline__ void ya_to_fp8_token(Frame& F, int tok) {
    const int lane = opaque(F.lane);
    const bf16* src = WSP(bf16, WS_YA) + (size_t)tok * 2048 + 32 * lane;
    unsigned char* dst = WSP(unsigned char, WS_YA8) + (size_t)tok * 2048 + 32 * lane;
    unsigned o[8];
#pragma unroll
    for (int q = 0; q < 4; ++q) { const u32x4 a = *(const u32x4*)(src + 8 * q);
        unsigned w0 = 0u, w1 = 0u;
        w0 = cvt2_fp8(bflo(a.x) * 32.f, bfhi(a.x) * 32.f, w0, false); w0 = cvt2_fp8(bflo(a.y) * 32.f, bfhi(a.y) * 32.f, w0, true);
        w1 = cvt2_fp8(bflo(a.z) * 32.f, bfhi(a.z) * 32.f, w1, false); w1 = cvt2_fp8(bflo(a.w) * 32.f, bfhi(a.w) * 32.f, w1, true);
        o[2 * q] = w0; o[2 * q + 1] = w1; }
    *(u32x4*)dst = (u32x4){o[0], o[1], o[2], o[3]}; *(u32x4*)(dst + 16) = (u32x4){o[4], o[5], o[6], o[7]};
}
__device__ __forceinline__ void gdn_norm_token(Frame& F, int tok) {
    const int lane = opaque(F.lane), head = lane >> 2, sub = lane & 3;
    bf16* o = WSP(bf16, WS_OSC) + (size_t)tok * 2048 + head * 128 + 32 * sub;
    const bf16* z = WSP(bf16, WS_PROJ) + (size_t)tok * LDP + C_GZ + head * 128 + 32 * sub;
    float v[32], zz[32]; float ss = 0.f;
#pragma unroll
    for (int q = 0; q < 4; ++q) { const u32x4 a = *(const u32x4*)(o + 8 * q), c = *(const u32x4*)(z + 8 * q); const unsigned wa[4] = {a.x, a.y, a.z, a.w}, wc[4] = {c.x, c.y, c.z, c.w};
#pragma unroll
        for (int j = 0; j < 4; ++j) { v[8 * q + 2 * j] = bflo(wa[j]); v[8 * q + 2 * j + 1] = bfhi(wa[j]); zz[8 * q + 2 * j] = bflo(wc[j]); zz[8 * q + 2 * j + 1] = bfhi(wc[j]); } }
#pragma unroll
    for (int e = 0; e < 32; ++e) ss += v[e] * v[e];
    ss += __shfl_xor(ss, 1); ss += __shfl_xor(ss, 2);
    const float rinv = rsqrtf(ss * (1.f / 128.f) + EPS);
#pragma unroll
    for (int q = 0; q < 4; ++q) { unsigned w[4];
#pragma unroll
        for (int j = 0; j < 4; ++j) { const int e = 8 * q + 2 * j; const float y0 = v[e] * rinv * F.gnw()[32 * sub + e] * (zz[e] * sigmoidf_(zz[e])), y1 = v[e + 1] * rinv * F.gnw()[32 * sub + e + 1] * (zz[e + 1] * sigmoidf_(zz[e + 1])); w[j] = cvt2_fp8(y0 * 8.f, y1 * 8.f, 0u, false) & 0xffffu; }
        *(u32x2*)((unsigned char*)F.out + (size_t)tok * 2048 + head * 128 + 32 * sub + 8 * q) = (u32x2){w[0] | (w[1] << 16), w[2] | (w[3] << 16)}; }
}

__device__ __forceinline__ unsigned lt1(unsigned cand, unsigned key) { unsigned d; asm("v_sub_u32 %0, %1, %2 clamp\n\tv_min_u32 %0, 1, %0" : "=v"(d) : "v"(cand), "v"(key)); return d; }
__device__ __forceinline__ float relu1(float x) { const int b = __float_as_int(x); return __int_as_float(b > 0 ? b : 0); }
__device__ __forceinline__ unsigned lt1pk(unsigned cand2, unsigned key2, unsigned one2) { unsigned d; asm("v_pk_sub_u16 %0, %1, %2 clamp\n\tv_pk_min_u16 %0, %0, %3" : "=&v"(d) : "v"(cand2), "v"(key2), "v"(one2)); return d; }
__device__ __forceinline__ int wave_sum_dpp(int v) {
    v += __builtin_amdgcn_update_dpp(0, v, 0x111, 0xf, 0xf, true);
    v += __builtin_amdgcn_update_dpp(0, v, 0x112, 0xf, 0xf, true);
    v += __builtin_amdgcn_update_dpp(0, v, 0x114, 0xf, 0xf, true);
    v += __builtin_amdgcn_update_dpp(0, v, 0x118, 0xf, 0xf, true);
    v += __builtin_amdgcn_update_dpp(0, v, 0x142, 0xa, 0xf, true);
    v += __builtin_amdgcn_update_dpp(0, v, 0x143, 0xc, 0xf, true);
    return __builtin_amdgcn_readlane(v, 63);
}
__device__ __forceinline__ unsigned mono_key(float f) { const unsigned u = __float_as_uint(f); return (u & 0x80000000u) ? ~u : (u | 0x80000000u); }
__device__ __forceinline__ void idx_unit(Frame& F, int b, int t0, const int mode = 3) {
    const int lane = opaque(F.lane), wid = F.wave, r = lane & 31, hh = lane >> 5;
    LAS unsigned* SC = (LAS unsigned*)F.lds;
    const bf16* PROJ = WSP(bf16, WS_PROJ); const float* SMALL = WSP(float, WS_SMALL);
    bf16x8 af[4][4]; float w[4][16];
#pragma unroll
    for (int rt = 0; rt < 4; ++rt) {
        const int tq = t0 + 2 * rt + ((r >> 2) & 1), head = (r & 3) + 4 * (r >> 3); const size_t tok = (size_t)b * SEQ + tq;
        const bf16* src = PROJ + tok * LDP + C_IQ + head * 64 + 8 * hh;
        u32x4 raw[4];
#pragma unroll
        for (int ks = 0; ks < 4; ++ks) raw[ks] = *(const u32x4*)(src + 16 * ks);
        const float* rc = WSP(float, WS_R64C) + tok * 32 + 8 * hh; const float* rs = WSP(float, WS_R64S) + tok * 32 + 8 * hh;
#pragma unroll
        for (int ks = 0; ks < 2; ++ks) {
            const f32x4 c0 = *(const f32x4*)(rc + 16 * ks), c1 = *(const f32x4*)(rc + 16 * ks + 4), s0 = *(const f32x4*)(rs + 16 * ks), s1 = *(const f32x4*)(rs + 16 * ks + 4);
            const float cs[8] = {c0.x, c0.y, c0.z, c0.w, c1.x, c1.y, c1.z, c1.w}, sn[8] = {s0.x, s0.y, s0.z, s0.w, s1.x, s1.y, s1.z, s1.w};
            const unsigned wa[4] = {raw[ks].x, raw[ks].y, raw[ks].z, raw[ks].w}, wb[4] = {raw[ks + 2].x, raw[ks + 2].y, raw[ks + 2].z, raw[ks + 2].w};
            unsigned o1[4], o2[4];
#pragma unroll
            for (int j = 0; j < 4; ++j) { const float x1a = bflo(wa[j]), x1b = bfhi(wa[j]), x2a = bflo(wb[j]), x2b = bfhi(wb[j]);
                o1[j] = cvt_pk_bf16(x1a * cs[2 * j] - x2a * sn[2 * j], x1b * cs[2 * j + 1] - x2b * sn[2 * j + 1]);
                o2[j] = cvt_pk_bf16(x2a * cs[2 * j] + x1a * sn[2 * j], x2b * cs[2 * j + 1] + x1b * sn[2 * j + 1]); }
            const u32x4 v1 = {o1[0], o1[1], o1[2], o1[3]}, v2 = {o2[0], o2[1], o2[2], o2[3]};
            af[rt][ks] = *(const bf16x8*)&v1; af[rt][ks + 2] = *(const bf16x8*)&v2;
        }
        const float* wp = SMALL + ((size_t)b * SEQ + t0 + 2 * rt + hh) * LDSM + SM_IW;
#pragma unroll
        for (int q = 0; q < 4; ++q) { const f32x4 v = *(const f32x4*)(wp + 4 * q); w[rt][4 * q] = v.x * 0.03125f; w[rt][4 * q + 1] = v.y * 0.03125f; w[rt][4 * q + 2] = v.z * 0.03125f; w[rt][4 * q + 3] = v.w * 0.03125f; }
    }
    const int ntiles = (t0 + 8 + 31) >> 5;
    if (mode & 1) {
    const u32x4* IKF = WSP(u32x4, WS_IKF) + (size_t)b * 128 * 4 * 64;
    if (wid < ntiles) {
        u32x4 bfr[4], bnx[4];
#pragma unroll
        for (int ks = 0; ks < 4; ++ks) bfr[ks] = IKF[(size_t)(wid * 4 + ks) * 64 + lane];
        auto mm = [&](const u32x4 (&bf)[4], int rt) { f32x16 acc = {};
#pragma unroll
            for (int ks = 0; ks < 4; ++ks) acc = __builtin_amdgcn_mfma_f32_32x32x16_bf16(af[rt][ks], *(const bf16x8*)&bf[ks], acc, 0, 0, 0);
            return acc; };
        auto fin = [&](int rt, const f32x16& acc, int skey) {
            float s0 = 0.f, s1 = 0.f, s2 = 0.f, s3 = 0.f;
#pragma unroll
            for (int i = 0; i < 16; i += 4) { s0 += w[rt][i] * relu1(acc[i]); s1 += w[rt][i + 1] * relu1(acc[i + 1]); s2 += w[rt][i + 2] * relu1(acc[i + 2]); s3 += w[rt][i + 3] * relu1(acc[i + 3]); }
            const float sc = (s0 + s1) + (s2 + s3);
            const int ql = 2 * rt + hh;
            SC[ql * 4096 + ((skey & ~63) | ((skey + 4 * (skey >> 6)) & 63))] = (skey <= t0 + ql) ? mono_key(sc) : 0u; };
        f32x16 a0 = mm(bfr, 0), a1;
        for (int j = wid; j < ntiles; j += 8) {
            const bool more = j + 8 < ntiles;
            if (more) {
#pragma unroll
                for (int ks = 0; ks < 4; ++ks) bnx[ks] = IKF[(size_t)((j + 8) * 4 + ks) * 64 + lane]; }
            const int skey = 32 * j + r;
            a1 = mm(bfr, 1); fin(0, a0, skey);
            a0 = mm(bfr, 2); fin(1, a1, skey);
            a1 = mm(bfr, 3); fin(2, a0, skey);
            if (more) {
#pragma unroll
                for (int ks = 0; ks < 4; ++ks) bfr[ks] = bnx[ks];
                a0 = mm(bfr, 0); }
            fin(3, a1, skey);
        }
    }
    }
    __syncthreads();
    if (mode & 2) {
        const int tq = t0 + wid, lim = ntiles * 32;
        unsigned key[64];
        const LAS unsigned* scb = SC + wid * 4096 + 64 * lane;
#pragma unroll
        for (int q = 0; q < 16; ++q) { const int jj = (4 * q + 4 * lane) & 63;
            u32x4 v = *(const LAS u32x4*)(scb + jj);
            if (64 * lane + 4 * q >= lim) v = (u32x4){0u, 0u, 0u, 0u};
            key[4 * q] = v.x; key[4 * q + 1] = v.y; key[4 * q + 2] = v.z; key[4 * q + 3] = v.w; }
        unsigned theta = 1u;
        if (tq + 1 > 256) {
            unsigned one2; asm volatile("v_mov_b32 %0, 0x10001" : "=v"(one2));
            unsigned hp[32];
#pragma unroll
            for (int i = 0; i < 32; ++i) hp[i] = (key[2 * i] >> 16) | (key[2 * i + 1] & 0xffff0000u);
            unsigned th = 0u; bool exact = false;
            for (int bit = 15; bit >= 0; --bit) {
                const unsigned cand = th | (1u << bit), cand2 = cand * 0x10001u; unsigned c0 = 0, c1 = 0, c2 = 0, c3 = 0;
#pragma unroll
                for (int i = 0; i < 32; i += 4) { c0 += lt1pk(cand2, hp[i], one2); c1 += lt1pk(cand2, hp[i + 1], one2); c2 += lt1pk(cand2, hp[i + 2], one2); c3 += lt1pk(cand2, hp[i + 3], one2); }
                const unsigned tot = (c0 + c1) + (c2 + c3);
                const int cnt = 4096 - wave_sum_dpp((int)((tot & 0xffffu) + (tot >> 16)));
                if (cnt >= 256) { th = cand; if (cnt == 256) { exact = true; break; } }
            }
            theta = th << 16;
            if (!exact) {
            int ngt = 0;
            if (th != 0xffffu) { const unsigned cand2 = (th + 1u) * 0x10001u; unsigned c0 = 0, c1 = 0, c2 = 0, c3 = 0;
#pragma unroll
                for (int i = 0; i < 32; i += 4) { c0 += lt1pk(cand2, hp[i], one2); c1 += lt1pk(cand2, hp[i + 1], one2); c2 += lt1pk(cand2, hp[i + 2], one2); c3 += lt1pk(cand2, hp[i + 3], one2); }
                const unsigned tot = (c0 + c1) + (c2 + c3);
                ngt = 4096 - wave_sum_dpp((int)((tot & 0xffffu) + (tot >> 16))); }
            const unsigned th2 = th * 0x10001u;
#pragma unroll
            for (int i = 0; i < 32; ++i) {
                const unsigned x = hp[i] ^ th2; unsigned ne; asm("v_pk_min_u16 %0, %1, %2" : "=v"(ne) : "v"(x), "v"(one2));
                const unsigned eq = one2 - ne, msk = __umul24(eq, 0xffffu);
                hp[i] = ((key[2 * i] & 0xffffu) | (key[2 * i + 1] << 16)) & msk; }
            unsigned tl = 0u;
            for (int bit = 15; bit >= 0; --bit) {
                const unsigned cand = tl | (1u << bit), cand2 = cand * 0x10001u; unsigned c0 = 0, c1 = 0, c2 = 0, c3 = 0;
#pragma unroll
                for (int i = 0; i < 32; i += 4) { c0 += lt1pk(cand2, hp[i], one2); c1 += lt1pk(cand2, hp[i + 1], one2); c2 += lt1pk(cand2, hp[i + 2], one2); c3 += lt1pk(cand2, hp[i + 3], one2); }
                const unsigned tot = (c0 + c1) + (c2 + c3);
                const int cnt = ngt + 4096 - wave_sum_dpp((int)((tot & 0xffffu) + (tot >> 16)));
                if (cnt >= 256) { tl = cand; if (cnt == 256) break; }
            }
            theta = (th << 16) | tl;
            }
        }
        unsigned lo = 0u, hi32 = 0u;
#pragma unroll
        for (int j = 31; j >= 0; --j) { lo = (lo << 1) | ((key[j] >= theta) ? 1u : 0u); hi32 = (hi32 << 1) | ((key[32 + j] >= theta) ? 1u : 0u); }
        if (mode == 3 || (lo == 0x12345u && hi32 == 0x54321u)) *(u32x2*)(WSP(unsigned long long, WS_MASK) + ((size_t)b * SEQ + tq) * 64 + lane) = (u32x2){lo, hi32};
    }
    LDS_BARRIER();
}

__device__ __forceinline__ void router_tile(Frame& F, int tile) {
    const int lane = opaque(F.lane), wid = F.wave, r = lane & 31, hh = lane >> 5;
    const int tok = tile * 32 + r;
    const bf16* xr = WSP(bf16, WS_X1B) + (size_t)tok * DM + 512 * wid + 8 * hh;
    unsigned char* h2 = WSP(unsigned char, WS_H2) + (size_t)tok * DM + 512 * wid + 8 * hh;
    const float* nw = F.ffnw() + 512 * wid + 8 * hh;
    const u32x4* WRF = WSP(u32x4, WS_WRF) + (size_t)(32 * wid) * 64 + lane;
    f32x16 a0 = {}, a1 = {}; float ss = 0.f;
#pragma unroll 4
    for (int s = 0; s < 32; ++s) {
        const u32x4 hi = *(const u32x4*)(xr + 16 * s);
        const f32x4 v0 = {bflo(hi.x), bfhi(hi.x), bflo(hi.y), bfhi(hi.y)}, v1 = {bflo(hi.z), bfhi(hi.z), bflo(hi.w), bfhi(hi.w)};
        const f32x4 n0 = *(const f32x4*)(nw + 16 * s), n1 = *(const f32x4*)(nw + 16 * s + 4);
        ss += (v0.x * v0.x + v0.y * v0.y) + (v0.z * v0.z + v0.w * v0.w) + (v1.x * v1.x + v1.y * v1.y) + (v1.z * v1.z + v1.w * v1.w);
        { unsigned w0 = 0u, w1 = 0u;
          w0 = cvt2_fp8(v0.x * n0.x, v0.y * n0.y, w0, false); w0 = cvt2_fp8(v0.z * n0.z, v0.w * n0.w, w0, true); w1 = cvt2_fp8(v1.x * n1.x, v1.y * n1.y, w1, false); w1 = cvt2_fp8(v1.z * n1.z, v1.w * n1.w, w1, true);
          *(u32x2*)(h2 + 16 * s) = (u32x2){w0, w1}; }
        const u32x4 b0h = WRF[(size_t)(0 * 256 + s) * 64], b0l = WRF[(size_t)(1 * 256 + s) * 64], b1h = WRF[(size_t)(2 * 256 + s) * 64], b1l = WRF[(size_t)(3 * 256 + s) * 64];
        a0 = __builtin_amdgcn_mfma_f32_32x32x16_bf16(*(const bf16x8*)&hi, *(const bf16x8*)&b0h, a0, 0, 0, 0);
        a0 = __builtin_amdgcn_mfma_f32_32x32x16_bf16(*(const bf16x8*)&hi, *(const bf16x8*)&b0l, a0, 0, 0, 0);
        a1 = __builtin_amdgcn_mfma_f32_32x32x16_bf16(*(const bf16x8*)&hi, *(const bf16x8*)&b1h, a1, 0, 0, 0);
        a1 = __builtin_amdgcn_mfma_f32_32x32x16_bf16(*(const bf16x8*)&hi, *(const bf16x8*)&b1l, a1, 0, 0, 0);
    }
    ss += __shfl_xor(ss, 32);
    LAS float* PART = (LAS float*)F.lds;
    LAS float* SS = PART + 10240;
    if (hh == 0) SS[wid * 32 + r] = ss;
#pragma unroll
    for (int i = 0; i < 16; ++i) { const int tr = crow(i, hh); PART[(wid * 32 + tr) * 40 + r] = a0[i]; if (r < 4) PART[(wid * 32 + tr) * 40 + 32 + r] = a1[i]; }
    __syncthreads();
    if (wid == 0 && lane < 32) {
        float sq = 0.f;
#pragma unroll
        for (int w = 0; w < 8; ++w) sq += SS[w * 32 + lane];
        const float rstd = rsqrtf(sq * (1.f / DM) + EPS);
        WSP(float, WS_RSTD)[tile * 32 + lane] = rstd;
        float g4[4]; float mg = -3.4e38f; int gi = 0;
#pragma unroll
        for (int j = 0; j < 4; ++j) { float v = 0.f;
#pragma unroll
            for (int w = 0; w < 8; ++w) v += PART[(w * 32 + lane) * 40 + 32 + j];
            g4[j] = v * rstd + F.brg()[j]; if (g4[j] > mg) { mg = g4[j]; gi = j; } }
        float sg = 0.f;
#pragma unroll
        for (int j = 0; j < 4; ++j) sg += __expf(g4[j] - mg);
        const float pgrp = 1.f / sg;
        float e8[8]; float m0 = -3.4e38f; int i0 = 0;
#pragma unroll
        for (int j = 0; j < 8; ++j) { float v = 0.f;
#pragma unroll
            for (int w = 0; w < 8; ++w) v += PART[(w * 32 + lane) * 40 + gi * 8 + j];
            e8[j] = v * rstd + F.bre()[gi * 8 + j]; if (e8[j] > m0) { m0 = e8[j]; i0 = j; } }
        float m1 = -3.4e38f; int i1 = 0;
#pragma unroll
        for (int j = 0; j < 8; ++j) if (j != i0 && e8[j] > m1) { m1 = e8[j]; i1 = j; }
        const float p1 = __expf(m1 - m0), den = 1.f + p1;
        const float w0 = pgrp / den, w1 = pgrp * p1 / den;
        int* LIST = WSP(int, WS_LIST); float* LWT = WSP(float, WS_LWT); unsigned* cnt = F.ctl + CW_CNT;
        const int tk = tile * 32 + lane;
        const int sg0 = (gi * 8 + i0) * 2, sg1 = (gi * 8 + i1) * 2 + 1;
        const unsigned p0 = __hip_atomic_fetch_add(cnt + 64 * sg0, 1u, __ATOMIC_RELAXED, __HIP_MEMORY_SCOPE_AGENT);
        LIST[sg0 * 16384 + p0] = tk; LWT[sg0 * 16384 + p0] = w0;
        const unsigned q0 = __hip_atomic_fetch_add(cnt + 64 * sg1, 1u, __ATOMIC_RELAXED, __HIP_MEMORY_SCOPE_AGENT);
        LIST[sg1 * 16384 + q0] = tk; LWT[sg1 * 16384 + q0] = w1;
    }
    LDS_BARRIER();
}

__device__ __forceinline__ void moe_tables(Frame& F) {
    LAS int* segc = (LAS int*)(F.lds + LT_SEGC); LAS int* segt = (LAS int*)(F.lds + LT_SEGT); LAS int* rtseg = (LAS int*)(F.lds + LT_RTSEG); LAS int* rk = (LAS int*)(F.lds + LT_RK); LAS int* nrk = (LAS int*)(F.lds + LT_NRK);
    if (F.tid < 64) segc[F.tid] = (int)__hip_atomic_load(F.ctl + CW_CNT + 64 * F.tid, __ATOMIC_RELAXED, __HIP_MEMORY_SCOPE_AGENT);
    __syncthreads();
    if (F.tid == 0) { int acc = 0, n0 = 0, n1 = 0;
        for (int s = 0; s < 64; ++s) { segt[s] = acc; const int nt = (segc[s] + 255) >> 8; for (int q = 0; q < nt; ++q) { rtseg[acc + q] = s; if (s & 1) rk[160 + n1++] = acc + q; else rk[n0++] = acc + q; } acc += nt; }
        segt[64] = acc; nrk[0] = n0; nrk[1] = n1; }
    __syncthreads();
}
struct MoeGUOrder {
    const LAS int* segc; const LAS int* segt; const LAS int* rtseg; int G, c; const char* A; const char* W; const int* LIST;
    __device__ __forceinline__ bool next(int i, pg8::Unit& u) const {
        const int L = i * G + c, nrt = __builtin_amdgcn_readfirstlane(segt[64]); if (L >= nrt * 4) return false;
        const int g = L >> 2, ct = L & 3, sgm = __builtin_amdgcn_readfirstlane(rtseg[g]), rt = g - __builtin_amdgcn_readfirstlane(segt[sgm]), e = sgm >> 1;
        u.pm = g; u.pn = ct; u.A = A; u.B = W + ((size_t)e * 1024 + 256 * ct) * 4096;         u.rows = LIST + sgm * 16384 + rt * 256; u.nrows = __builtin_amdgcn_readfirstlane(segc[sgm]) - rt * 256; u.aux0 = sgm; u.aux1 = rt; return true;
    }
};
struct MoeDownOrder {
    const LAS int* segc; const LAS int* segt; const LAS int* rtseg; const LAS int* rk; int nr, G, c; const char* HE; const char* W;
    __device__ __forceinline__ bool next(int i, pg8::Unit& u) const {
        const int L = i * G + c; if (L >= nr * 16) return false;
        const int g = __builtin_amdgcn_readfirstlane(rk[L >> 4]), ct = L & 15, sgm = __builtin_amdgcn_readfirstlane(rtseg[g]), rt = g - __builtin_amdgcn_readfirstlane(segt[sgm]), e = sgm >> 1;
        u.pm = g; u.pn = ct; u.A = HE + (size_t)g * 256 * 512 * 2; u.B = W + ((size_t)e * 4096 + 256 * ct) * 512 * 2; u.rows = nullptr; u.nrows = __builtin_amdgcn_readfirstlane(segc[sgm]) - rt * 256; u.aux0 = sgm; u.aux1 = rt; return true;
    }
};
struct EpiGU {
    bf16* HE; const int* LIST; const float* RSTD;
    __device__ __forceinline__ void operator()(const f32x4 (&acc)[2][2][4][2], const pg8::Unit& u, int wr, int wc, int fr, int fq) const {
        const int col0 = u.pn * 128 + wc * 32 + 8 * fq;
        int zz; asm volatile("v_mov_b32 %0, 0" : "=v"(zz));
        float rsv[2][4];
#pragma unroll
        for (int ai = 0; ai < 2; ++ai)
#pragma unroll
            for (int m = 0; m < 4; ++m) { const int lr = ai * 128 + wr * 64 + m * 16 + fr + zz; const int tok = lr < u.nrows ? u.rows[lr] : 0; rsv[ai][m] = RSTD[tok]; }
#pragma unroll
        for (int ai = 0; ai < 2; ++ai)
#pragma unroll
            for (int m = 0; m < 4; ++m) { const int lr = ai * 128 + wr * 64 + m * 16 + fr + zz;
                if (lr < u.nrows) { const float rs = rsv[ai][m];
                    const f32x4 g0 = acc[ai][0][m][0] * rs, g1 = acc[ai][0][m][1] * rs, u0 = acc[ai][1][m][0] * rs, u1 = acc[ai][1][m][1] * rs;
                    u32x4 w; w.x = cvt_pk_bf16(g0[0] * sigmoidf_(g0[0]) * u0[0], g0[1] * sigmoidf_(g0[1]) * u0[1]); w.y = cvt_pk_bf16(g0[2] * sigmoidf_(g0[2]) * u0[2], g0[3] * sigmoidf_(g0[3]) * u0[3]);
                    w.z = cvt_pk_bf16(g1[0] * sigmoidf_(g1[0]) * u1[0], g1[1] * sigmoidf_(g1[1]) * u1[1]); w.w = cvt_pk_bf16(g1[2] * sigmoidf_(g1[2]) * u1[2], g1[3] * sigmoidf_(g1[3]) * u1[3]);
                    *(u32x4*)(HE + ((size_t)u.pm * 256 + lr) * 512 + col0) = w; } }
    }
};
template <int ROUND> struct EpiDown {
    float* O; const int* LIST; const float* LWT; bf16* PART; const bf16* X1;
    __device__ __forceinline__ void operator()(const f32x4 (&acc)[2][2][4][2], const pg8::Unit& u, int wr, int wc, int fr, int fq) const {
        const int col0 = u.pn * 256 + wc * 32 + 8 * fq; const int lbase = u.aux0 * 16384 + u.aux1 * 256;
        int zz; asm volatile("v_mov_b32 %0, 0" : "=v"(zz));
        int tk[2][4]; float wt[2][4];
#pragma unroll
        for (int ai = 0; ai < 2; ++ai)
#pragma unroll
            for (int m = 0; m < 4; ++m) { const int lr = ai * 128 + wr * 64 + m * 16 + fr + zz; const bool ok = lr < u.nrows; tk[ai][m] = ok ? LIST[lbase + lr] : -1; wt[ai][m] = ok ? LWT[lbase + lr] : 0.f; }
        if constexpr (ROUND == 0) {
#pragma unroll
            for (int ai = 0; ai < 2; ++ai)
#pragma unroll
                for (int m = 0; m < 4; ++m) if (tk[ai][m] >= 0) { bf16* pp = PART + (size_t)tk[ai][m] * DM + col0;
#pragma unroll
                    for (int bj = 0; bj < 2; ++bj) { const f32x4 v0 = acc[ai][bj][m][0] * wt[ai][m], v1 = acc[ai][bj][m][1] * wt[ai][m];
                        *(u32x4*)(pp + bj * 128) = (u32x4){cvt_pk_bf16(v0[0], v0[1]), cvt_pk_bf16(v0[2], v0[3]), cvt_pk_bf16(v1[0], v1[1]), cvt_pk_bf16(v1[2], v1[3])}; } }
        } else {
#pragma unroll
        for (int ai = 0; ai < 2; ++ai)
#pragma unroll
        for (int mh = 0; mh < 1; ++mh) {
            u32x4 rv[4][2], pv[4][2];
#pragma unroll
            for (int m2 = 0; m2 < 4; ++m2) { const int m = mh * 2 + m2; const size_t ro = (size_t)(tk[ai][m] < 0 ? 0 : tk[ai][m]) * DM + col0; const bf16* op = X1 + ro; const bf16* pp = PART + ro;
#pragma unroll
                for (int bj = 0; bj < 2; ++bj) { rv[m2][bj] = *(const u32x4*)(op + bj * 128); pv[m2][bj] = *(const u32x4*)(pp + bj * 128); } }
#pragma unroll
            for (int m2 = 0; m2 < 4; ++m2) { const int m = mh * 2 + m2; if (tk[ai][m] >= 0) { float* op = O + (size_t)tk[ai][m] * DM + col0;
#pragma unroll
                for (int bj = 0; bj < 2; ++bj) { const u32x4 p = pv[m2][bj], x = rv[m2][bj];
                    const f32x4 p0 = {__uint_as_float(p.x << 16), __uint_as_float(p.x & 0xffff0000u), __uint_as_float(p.y << 16), __uint_as_float(p.y & 0xffff0000u)};
                    const f32x4 p1 = {__uint_as_float(p.z << 16), __uint_as_float(p.z & 0xffff0000u), __uint_as_float(p.w << 16), __uint_as_float(p.w & 0xffff0000u)};
                    const f32x4 x0 = {__uint_as_float(x.x << 16), __uint_as_float(x.x & 0xffff0000u), __uint_as_float(x.y << 16), __uint_as_float(x.y & 0xffff0000u)};
                    const f32x4 x1 = {__uint_as_float(x.z << 16), __uint_as_float(x.z & 0xffff0000u), __uint_as_float(x.w << 16), __uint_as_float(x.w & 0xffff0000u)};
                    *(f32x4*)(op + bj * 128) = (x0 + p0) + acc[ai][bj][m][0] * wt[ai][m]; *(f32x4*)(op + bj * 128 + 4) = (x1 + p1) + acc[ai][bj][m][1] * wt[ai][m]; } } }
        }
        }
    }
};

namespace att {
constexpr int D = 128, NW = 8, QBLK = 32, KVBLK = 64, QB = 256, H = 16, HKV = 4;
constexpr int SHM_V = KVBLK * D * 2, SHM_K = KVBLK * D * 2;
constexpr int ATT_LDS = 2 * SHM_V + 2 * SHM_K + NW * 64 * 4;
constexpr float SCALE = 0.08838834764831845f, THR = 8.f;
constexpr int LDV = LDP, LDO = 2048;
#define KSWZ(row, colB) ((row) * 256 + ((colB) ^ (((row) & 7) << 4)))
#define SBAR() __builtin_amdgcn_sched_barrier(0)
typedef short s16x4 __attribute__((ext_vector_type(4)));
__device__ __forceinline__ int v_st(int k, int c) { const int kk = (k & ~0xC) | ((k & 4) << 1) | ((k & 8) >> 1); return ((kk >> 3) * 4 + (c >> 5)) * 512 + ((kk & 7) * 32 + (c & 31)) * 2; }
__device__ __forceinline__ int v_rd_base(int lane) { return ((lane & 3) << 3) | (((lane >> 2) & 3) << 6) | (((lane >> 4) & 1) << 5) | (((lane >> 5) & 1) << 8); }
constexpr int v_rd_off(int d0, int ks, int half) { return d0 * 512 + ks * 4096 + half * 2048; }
__device__ __forceinline__ bf16x8 load8(const bf16* p) { return *reinterpret_cast<const bf16x8*>(p); }

__device__ __forceinline__ void partialSM(f32x16& p0, f32x16& p1, float& m_reg, float& mn, float& alpha) {
    float pmax = p0[0];
#pragma unroll
    for (int r = 1; r < 16; ++r) pmax = fmaxf(pmax, p0[r]);
#pragma unroll
    for (int r = 0; r < 16; ++r) pmax = fmaxf(pmax, p1[r]);
    { auto rr = __builtin_amdgcn_permlane32_swap(__float_as_uint(pmax), __float_as_uint(pmax), false, false);
      pmax = fmaxf(__uint_as_float(rr[0]), __uint_as_float(rr[1])); }
    constexpr float C2 = 1.4426950408889634f * SCALE;
    if (__builtin_expect(__all((pmax - m_reg) * SCALE <= THR), 1)) { mn = m_reg; alpha = 1.f; }
    else { mn = fmaxf(m_reg, pmax); alpha = __builtin_amdgcn_exp2f((m_reg - mn) * C2); m_reg = mn; }
    const float mnL = -mn * C2;
#pragma unroll
    for (int r = 0; r < 16; ++r) p0[r] = fmaf(p0[r], C2, mnL);
#pragma unroll
    for (int r = 0; r < 16; ++r) p1[r] = fmaf(p1[r], C2, mnL);
#pragma unroll
    for (int r = 0; r < 16; ++r) p0[r] = __builtin_amdgcn_exp2f(p0[r]);
}
__device__ __forceinline__ void finishSM(f32x16& p0, f32x16& p1, float alpha, float& l_reg, unsigned mlo, unsigned mhi, bf16x8& pa0, bf16x8& pa1, bf16x8& pa2, bf16x8& pa3) {
#pragma unroll
    for (int r = 0; r < 16; ++r) p1[r] = __builtin_amdgcn_exp2f(p1[r]);
#pragma unroll
    for (int r = 0; r < 16; ++r) { const int c = (r & 3) + 8 * (r >> 2);
        p0[r] = __uint_as_float(__float_as_uint(p0[r]) & (unsigned)__builtin_amdgcn_sbfe((int)mlo, c, 1));
        p1[r] = __uint_as_float(__float_as_uint(p1[r]) & (unsigned)__builtin_amdgcn_sbfe((int)mhi, c, 1)); }
    float ps = 0;
#pragma unroll
    for (int r = 0; r < 16; ++r) ps += p0[r];
#pragma unroll
    for (int r = 0; r < 16; ++r) ps += p1[r];
    { auto rr = __builtin_amdgcn_permlane32_swap(__float_as_uint(ps), __float_as_uint(ps), false, false);
      ps = __uint_as_float(rr[0]) + __uint_as_float(rr[1]); }
    l_reg = l_reg * alpha + ps;
#define PK4(P, B_, OUT) do { unsigned a0 = cvt_pk_bf16(P[B_+0], P[B_+1]), a1 = cvt_pk_bf16(P[B_+2], P[B_+3]);                          \
        unsigned b0 = cvt_pk_bf16(P[B_+4], P[B_+5]), b1 = cvt_pk_bf16(P[B_+6], P[B_+7]);                                             \
        auto r0 = __builtin_amdgcn_permlane32_swap(a0, b0, false, false); auto r1 = __builtin_amdgcn_permlane32_swap(a1, b1, false, false); \
        u32x4 w = {r0[0], r1[0], r0[1], r1[1]}; OUT = *reinterpret_cast<bf16x8*>(&w); } while (0)
    PK4(p0, 0, pa0); PK4(p0, 8, pa1); PK4(p1, 0, pa2); PK4(p1, 8, pa3);
#undef PK4
}
template <int KB>
__device__ __forceinline__ void qkt(f32x16& p0, f32x16& p1, const char* K_lds, int r32, int hi, const bf16x8* qr) {
    p0 = f32x16{}; p1 = f32x16{};
    const char* kb[4];
#pragma unroll
    for (int dd = 0; dd < 4; ++dd) kb[dd] = K_lds + KB * SHM_K + KSWZ(r32, (dd * 16 + hi * 8) * 2);
#pragma unroll
    for (int d0 = 0; d0 < 8; ++d0) { const char* a = kb[d0 & 3] + (d0 >> 2) * 128;
        bf16x8 b0 = *reinterpret_cast<const bf16x8*>(a);
        bf16x8 b1 = *reinterpret_cast<const bf16x8*>(a + 32 * 256);
        p0 = __builtin_amdgcn_mfma_f32_32x32x16_bf16(b0, qr[d0], p0, 0, 0, 0);
        p1 = __builtin_amdgcn_mfma_f32_32x32x16_bf16(b1, qr[d0], p1, 0, 0, 0); }
}
template <int VB>
__device__ __forceinline__ void pv_tile(f32x16* o, int vb0, bf16x8 pa0, bf16x8 pa1, bf16x8 pa2, bf16x8 pa3) {
#define TRRD(dst, off) asm volatile("ds_read_b64_tr_b16 %0, %1 offset:%2" : "=&v"(dst) : "v"(vb0), "i"(off) : "memory")
#define PV_D0(d0) do { s16x4 l0, l1, l2, l3, h0, h1, h2, h3; constexpr int b_ = VB * SHM_V + v_rd_off(d0, 0, 0); \
        TRRD(l0, b_); TRRD(h0, b_ + 2048); TRRD(l1, b_ + 4096); TRRD(h1, b_ + 6144); TRRD(l2, b_ + 8192); TRRD(h2, b_ + 10240); TRRD(l3, b_ + 12288); TRRD(h3, b_ + 14336); \
        asm volatile("s_waitcnt lgkmcnt(0)" ::: "memory"); SBAR();   \
        o[d0] = __builtin_amdgcn_mfma_f32_32x32x16_bf16(pa0, (bf16x8){l0[0], l0[1], l0[2], l0[3], h0[0], h0[1], h0[2], h0[3]}, o[d0], 0, 0, 0);   \
        o[d0] = __builtin_amdgcn_mfma_f32_32x32x16_bf16(pa1, (bf16x8){l1[0], l1[1], l1[2], l1[3], h1[0], h1[1], h1[2], h1[3]}, o[d0], 0, 0, 0);   \
        o[d0] = __builtin_amdgcn_mfma_f32_32x32x16_bf16(pa2, (bf16x8){l2[0], l2[1], l2[2], l2[3], h2[0], h2[1], h2[2], h2[3]}, o[d0], 0, 0, 0);   \
        o[d0] = __builtin_amdgcn_mfma_f32_32x32x16_bf16(pa3, (bf16x8){l3[0], l3[1], l3[2], l3[3], h3[0], h3[1], h3[2], h3[3]}, o[d0], 0, 0, 0); } while (0)
    PV_D0(0); PV_D0(1); PV_D0(2); PV_D0(3);
#undef PV_D0
#undef TRRD
}
struct BlockRef { const bf16* Q; const bf16* K; const bf16* V; bf16* O; const unsigned long long* M; int P0; };
struct Seam { bf16x8 qr[8]; bf16x8 st_v0, st_v1, st_k0, st_k1; };
#define ROWK(p, k0, rr) ((const bf16*)((const char*)(p) + (size_t)(k0) * (D * 2) + (unsigned)(((rr) * D + sc) * 2)))
#define ROWV(p, k0, rr) ((const bf16*)((const char*)(p) + (size_t)(k0) * (LDV * 2) + (unsigned)(((rr) * LDV + sc) * 2)))
#define VMW() asm volatile("s_waitcnt vmcnt(0)" ::: "memory")
#define VMWN(n) asm volatile("s_waitcnt vmcnt(%0)" :: "i"(n) : "memory")
#define SLOAD_H(Kp, Vp, k0) do { S.st_v0 = load8(ROWV(Vp, k0, sr)); S.st_v1 = load8(ROWV(Vp, k0, 32 + sr));              \
                         S.st_k0 = load8(ROWK(Kp, k0, sr)); S.st_k1 = load8(ROWK(Kp, k0, 32 + sr)); } while (0)
#define SWRITE_HK(bf) do { *(bf16x8*)(K_lds + (bf) * SHM_K + kws) = S.st_k0; *(bf16x8*)(K_lds + (bf) * SHM_K + kws + 32 * 256) = S.st_k1; } while (0)
#define SWRITE_HV(bf) do { *(bf16x8*)(V_lds + (bf) * SHM_V + vst0) = S.st_v0; *(bf16x8*)(V_lds + (bf) * SHM_V + vst1) = S.st_v1; } while (0)
#define SWRITE_H(bf) do { SWRITE_HV(bf); SWRITE_HK(bf); } while (0)
__device__ __forceinline__ void prime(const BlockRef& cur, char* lds, Seam& S, const int tid) {
    const int wid = __builtin_amdgcn_readfirstlane(tid >> 6), lane = tid & 63, r32 = lane & 31, hi = lane >> 5;
    const int sr = tid >> 4, sc = (tid & 15) * 8, kws = KSWZ(sr, sc * 2); char* K_lds = lds + 2 * SHM_V;
#pragma unroll
    for (int d0 = 0; d0 < 8; ++d0) S.qr[d0] = load8(cur.Q + (size_t)(wid * QBLK + r32) * D + d0 * 16 + hi * 8);
    SLOAD_H(cur.K, cur.V, 0); VMW(); SWRITE_HK(0);
    __syncthreads();
}
__device__ __forceinline__ void block(const BlockRef& cur, const BlockRef& nxt, char* lds, Seam& S, const int tid) {
    const int wid = __builtin_amdgcn_readfirstlane(tid >> 6), lane = tid & 63, r32 = lane & 31, hi = lane >> 5;
    const int NT = (cur.P0 + QB - 1) / KVBLK + 1;
    char* V_lds = lds; char* K_lds = lds + 2 * SHM_V;
    float* ws = (float*)(lds + 2 * SHM_V + 2 * SHM_K) + wid * 64; float* li_l = ws, * al_l = ws + 32;
    float m_reg = -1e30f, l_reg = 0; f32x16 o[4] = {};
    const int sr = tid >> 4, sc = (tid & 15) * 8, vst0 = v_st(sr, sc), vst1 = v_st(32 + sr, sc), kws = KSWZ(sr, sc * 2);
    const int vb0 = (int)(uintptr_t)V_lds + v_rd_base(lane);
    const bf16* Kh = cur.K; const bf16* Vh = cur.V;
    const int mrow = (wid * QBLK + r32) * 64;
    const int msh = 4 * hi;
#define RESC(a) do { if (__any((a) < 1.f)) { if (hi == 0) al_l[r32] = (a); asm volatile("s_waitcnt lgkmcnt(0)" ::: "memory");              \
                     for (int d_ = 0; d_ < 4; ++d_) for (int r = 0; r < 16; ++r) o[d_][r] *= al_l[crow(r, hi)]; } } while (0)
#define KBASE(t) ((t) * KVBLK)
#define LDM(ML, MH, t) do { const u32x2 mw_ = *(const u32x2*)(cur.M + mrow + (t)); ML = mw_.x >> msh; MH = mw_.y >> msh; } while (0)
#define SEAM_K0() do { VMWN(8); SWRITE_HK(0); SBAR(); } while (0)
    f32x16 pA0, pA1, pB0, pB1; float mnA, mnB, alA, alB; bf16x8 pa0, pa1, pa2, pa3; unsigned ml, mh;
    SWRITE_HV(0); SBAR();
    if (NT > 1) SLOAD_H(Kh, Vh, KBASE(1));
    SBAR(); qkt<0>(pA0, pA1, K_lds, r32, hi, S.qr);
    partialSM(pA0, pA1, m_reg, mnA, alA);
    if (NT > 1) { VMW(); SWRITE_H(1); }
    __syncthreads();
#define HALF_STEP(PX0, PX1, mnX, alX, PY0, PY1, alY, t, KB, VB, SB) do {                                                      \
        LDM(ml, mh, (t) - 1);                                                                                                 \
        SBAR(); qkt<KB>(PX0, PX1, K_lds, r32, hi, S.qr);                                                                      \
        finishSM(PY0, PY1, alY, l_reg, ml, mh, pa0, pa1, pa2, pa3); SBAR();                                                   \
        if ((t) + 1 < NT) { SLOAD_H(Kh, Vh, KBASE((t) + 1)); SBAR(); }                                                        \
        pv_tile<VB>(o, vb0, pa0, pa1, pa2, pa3); partialSM(PX0, PX1, m_reg, mnX, alX);                                        \
        __syncthreads();                                                                                                      \
        if ((t) + 1 < NT) { VMW(); SWRITE_H(SB); }                                                                            \
        RESC(alX); __syncthreads(); } while (0)
    for (int t = 1; t + 1 < NT; t += 2) {
        HALF_STEP(pB0, pB1, mnB, alB, pA0, pA1, alA, t, 1, 0, 0);
        HALF_STEP(pA0, pA1, mnA, alA, pB0, pB1, alB, t + 1, 0, 1, 1);
    }
    LDM(ml, mh, NT - 2);
    SBAR(); qkt<1>(pB0, pB1, K_lds, r32, hi, S.qr); SBAR();
    SLOAD_H(nxt.K, nxt.V, 0); SBAR();
#pragma unroll
    for (int d0 = 0; d0 < 8; ++d0) S.qr[d0] = load8(nxt.Q + (size_t)(wid * QBLK + r32) * D + d0 * 16 + hi * 8);
    SBAR();
    finishSM(pA0, pA1, alA, l_reg, ml, mh, pa0, pa1, pa2, pa3); SBAR();
    pv_tile<0>(o, vb0, pa0, pa1, pa2, pa3);
    partialSM(pB0, pB1, m_reg, mnB, alB); __syncthreads(); RESC(alB);
    SBAR(); SEAM_K0();
    LDM(ml, mh, NT - 1);
    finishSM(pB0, pB1, alB, l_reg, ml, mh, pa0, pa1, pa2, pa3); SBAR(); pv_tile<1>(o, vb0, pa0, pa1, pa2, pa3);
    if (hi == 0) li_l[r32] = l_reg; asm volatile("s_waitcnt lgkmcnt(0)" ::: "memory");
    float rli[16];
#pragma unroll
    for (int r = 0; r < 16; ++r) rli[r] = __builtin_amdgcn_rcpf(li_l[crow(r, hi)]);
    bf16* Ow = cur.O + (size_t)(wid * QBLK) * LDO;
#pragma unroll
    for (int r = 0; r < 16; ++r) { const int orow = crow(r, hi);
#pragma unroll
        for (int d0 = 0; d0 < 4; ++d0) { const float v = o[d0][r] * rli[r];
            const float vn = __shfl_xor(v, 1);
            if ((r32 & 1) == 0) *(unsigned*)(Ow + (size_t)orow * LDO + d0 * 32 + r32) = cvt_pk_bf16(v, vn); } }
    __syncthreads();
#undef RESC
#undef KBASE
#undef LDM
#undef SEAM_K0
#undef HALF_STEP
}
#undef ROWK
#undef ROWV
#undef VMW
#undef VMWN
#undef SLOAD_H
#undef SWRITE_HK
#undef SWRITE_HV
#undef SWRITE_H
struct Item { int bh, qb0, qb1; };
__device__ __forceinline__ Item decode(int L) {
    constexpr int nx = 8, G = H / HKV; Item it;
    const int xcd = L & 7, k = L >> 3, per = G * nx, gi = k / per, rr = k - gi * per;
    it.bh = (gi * 8 + xcd) * G + rr / nx; const int x = rr % nx;
    it.qb0 = x; it.qb1 = 15 - x; return it;
}
__device__ __forceinline__ BlockRef mkref(const Item& it, int pass, const bf16* Q, const bf16* K, const bf16* V, bf16* O, const unsigned long long* M) {
    const int qb = pass ? it.qb1 : it.qb0, b = it.bh / H, h = it.bh % H, kvh = h / (H / HKV);
    BlockRef r;
    r.Q = Q + ((size_t)it.bh * SEQ + (size_t)qb * QB) * D;
    r.K = K + (size_t)(b * HKV + kvh) * SEQ * D;
    r.V = V + (size_t)b * SEQ * LDV + kvh * D;
    r.O = O + ((size_t)b * SEQ + (size_t)qb * QB) * LDO + h * D;
    r.M = M + ((size_t)b * SEQ + (size_t)qb * QB) * 64;
    r.P0 = qb * QB; return r;
}
__device__ __forceinline__ void phase(char* lds, const bf16* Q, const bf16* K, const bf16* V, bf16* O, const unsigned long long* M, int G, int c, const int tid) {
    constexpr int total = 8 * NB * H;
    int L = c; if (L >= total) return;
    Item it = decode(L); int pass = 0;
    BlockRef cur = mkref(it, 0, Q, K, V, O, M);
    Seam S;
    prime(cur, lds, S, tid);
    for (;;) {
        const bool more_pass = pass == 0, more_item = L + G < total, last = !more_pass && !more_item;
        Item itn = it; int passn = pass + 1, Ln = L;
        if (!more_pass) { passn = 0; Ln = more_item ? L + G : L; itn = decode(Ln); }
        const BlockRef nxt = last ? cur : mkref(itn, passn, Q, K, V, O, M);
        block(cur, nxt, lds, S, tid);
        if (last) break;
        cur = nxt; it = itn; pass = passn; L = Ln;
    }
}
#undef KSWZ
#undef SBAR
}

struct Args { const void* in[22]; float* out; unsigned char* ws; int ph_lo, ph_hi; };
__global__ void __launch_bounds__(512, 2) mega_fwd(Args args) {
    extern __shared__ __attribute__((aligned(16))) unsigned char lds[];
    Frame F;
    F.lds = (LAS unsigned char*)lds;
#define F_REFRESH() do { int l_; asm volatile("v_mbcnt_lo_u32_b32 %0, -1, 0\n\tv_mbcnt_hi_u32_b32 %0, -1, %0" : "=v"(l_)); F.lane = l_; F.wave = wave_id; F.tid = wave_id * 64 + l_; F.gw = (int)blockIdx.x * 8 + wave_id; } while (0)
    const int wave_id = __builtin_amdgcn_readfirstlane((int)threadIdx.x >> 6);
    F.G = gridDim.x; F.NGW = F.G * 8; F_REFRESH();
    F.ws = args.ws; F.out = args.out; F.ctl = (unsigned*)(args.ws + WS_CTL);
    F.kin = (const __attribute__((address_space(4))) void* const*)__builtin_amdgcn_kernarg_segment_ptr();
    for (int u = F.tid; u < (LDS_BYTES - LDSCTL_OFF) / 4; u += 512) ((LAS unsigned*)(F.lds + LDSCTL_OFF))[u] = 0u;
    __syncthreads();
    const int lo = args.ph_lo, hi = args.ph_hi;
    XcdBarrier bar; bar.bar = F.ctl + CW_BAR; bar.x = 0; bar.st = nullptr;
    if (hi - lo > 1) bar = xcd_barrier_post(F.ctl + CW_BAR, (volatile LAS unsigned*)(F.lds + LDSCTL_OFF + 32), F.tid);
#ifndef PHMASK
#define PHMASK 0x1fff
#endif
#define IN(k) (((PHMASK >> (k)) & 1) && lo <= (k) && (k) < hi)
#ifndef REP_PH
#define REP_PH -1
#endif
#ifndef DBG_P1_MODE
#define DBG_P1_MODE 3
#endif
#ifndef DBG_G1_MODE
#define DBG_G1_MODE 9
#endif
#ifndef DBG_IDX_MODE
#define DBG_IDX_MODE 3
#endif
#define REPS(k) ((REP_PH) == (k) ? 2 : 1)
#define SEAM(k) do { if (IN(k) && IN((k) + 1)) { F_REFRESH(); xcd_barrier(bar, F.tid); } } while (0)
    const int G = F.G, c = (int)blockIdx.x;

    if (lo < 0) { F_REFRESH(); p_amax(F); if (hi > 0) { F_REFRESH(); xcd_barrier(bar, F.tid); } }
    if (IN(0)) { F_REFRESH(); for (int rp_ = 0; rp_ < REPS(0); ++rp_) { if (rp_) { xcd_barrier(bar, F.tid); F_REFRESH(); } p0_prologue(F); __syncthreads(); } }
    SEAM(0);
    if (IN(1)) { F_REFRESH(); for (int rp_ = 0; rp_ < REPS(1); ++rp_) { if (rp_) { xcd_barrier(bar, F.tid); F_REFRESH(); }
        {
            const float sw = fmaxf(__uint_as_float(__hip_atomic_load(F.ctl + CW_AMAX, __ATOMIC_RELAXED, __HIP_MEMORY_SCOPE_AGENT)), 1e-30f) * (1.f / 127.f);
            const bool stag = (G == 256) && rp_ == 0;
            const int grp = c & 7, cw = ((grp - 2) * 32 + (c >> 3)) * 8 + F.wave, ncw = 192 * 8;
            const int kpre = grp == 2 ? 3 : grp == 3 ? 4 : grp == 4 ? 6 : grp == 5 ? 7 : grp == 6 ? 8 : grp == 7 ? 10 : 0;
            const int cv0 = CV_NITEMS - CV_LATE - CV_MID, cvm = cv0 + kpre * ncw;
            if (stag && grp >= 2 && kpre > 0) { convert_items(F, cv0, cvm, cw, ncw); __syncthreads(); F_REFRESH(); }
            if (stag && grp == 1) { __builtin_amdgcn_s_sleep(127); __builtin_amdgcn_s_sleep(127); }
            pg8::StaggerOrder S; S.init(WSP(unsigned char, WS_XN8), WSP(unsigned char, WS_WIN8), T, NPAD, 2048, G, c);
            EpiProj E{WSP(bf16, WS_PROJ), WSP(float, WS_SMALL), WSP(float, WS_SA), sw};
            pg8::gemm_phase<EpiProj, pg8::StaggerOrder, true, false, 2, 16>(F.lds, F.tid, 2048, S, E);
            if (stag && grp >= 2) { F_REFRESH(); convert_items(F, cvm, CV_NITEMS - CV_LATE, ((grp - 2) * 32 + (c >> 3)) * 8 + F.wave, ncw); }
        }
    }
    }
    SEAM(1);
    if (IN(2)) { F_REFRESH(); for (int rp_ = 0; rp_ < REPS(2); ++rp_) { if (rp_) { xcd_barrier(bar, F.tid); F_REFRESH(); }
        if (rp_ == 0 || DBG_G1_MODE == 0 || DBG_G1_MODE == 9) for (int tok = F.gw; tok < T; tok += F.NGW) p2_post_token(F, tok);
        if (rp_ == 0 && IN(3)) { split_arrive(F.ctl + CW_SPLIT, F.tid); F_REFRESH(); }
        if (rp_ == 0 || DBG_G1_MODE != 0) {
            const int nper = 4096 / G, bh = (c * nper) >> 6, hd = bh & 15;
            for (int i = F.tid; i < 3 * 4 * 128; i += 512) { const int tz = i / 512, m = (i >> 7) & 3, d = i & 127; ((LAS float*)(F.lds + G_CW))[i] = F.convw()[(size_t)m * 6144 + tz * 2048 + hd * 128 + d]; }
            __syncthreads();
            for (int i = 0; i < nper; ++i) gdn_chunk(F, c * nper + i, rp_ ? DBG_G1_MODE : 9);
        }
    }
    }
    if (IN(2) && IN(3)) { F_REFRESH(); split_wait(F.ctl + CW_SPLIT, F.ctl + CW_BAR, (unsigned)G, F.tid); }
    if (IN(3)) { F_REFRESH(); for (int rp_ = 0; rp_ < REPS(3); ++rp_) { if (rp_) { xcd_barrier(bar, F.tid); F_REFRESH(); }
        for (int i = 0; i * G < 2048; ++i) { const int idx = i * G + ((i & 1) ? G - 1 - c : c); if (idx < 2048) idx_unit(F, idx & 3, (idx >> 2) * 8, rp_ ? DBG_IDX_MODE : 3); }
    }
    }
    SEAM(3);
    if (IN(4)) { F_REFRESH(); for (int rp_ = 0; rp_ < REPS(4); ++rp_) { if (rp_) { xcd_barrier(bar, F.tid); F_REFRESH(); }
        att::phase((char*)lds, WSP(bf16, WS_QB), WSP(bf16, WS_KB), WSP(bf16, WS_PROJ) + C_AV, WSP(bf16, WS_YA), WSP(unsigned long long, WS_MASK), G, c, F.tid);
        __syncthreads();
    }
    }
    SEAM(4);
    if (IN(5)) { F_REFRESH(); for (int rp_ = 0; rp_ < REPS(5); ++rp_) { if (rp_) { xcd_barrier(bar, F.tid); F_REFRESH(); }
        if (c >= 128) { for (int tok = (c - 128) * 8 + F.wave; tok < T; tok += (G - 128) * 8) ya_to_fp8_token(F, tok);
            convert_items(F, CV_NITEMS - CV_LATE, CV_NITEMS, (c - 128) * 8 + F.wave, (G - 128) * 8); }
        if (c < 128) gdn_scan_wg(F, ((c >> 4) << 3) | (c & 7), (c >> 3) & 1);
    }
    }
    SEAM(5);
    if (IN(6)) { F_REFRESH(); for (int rp_ = 0; rp_ < REPS(6); ++rp_) { if (rp_) { xcd_barrier(bar, F.tid); F_REFRESH(); }
        if (rp_ == 0) for (int tok = F.gw; tok < T; tok += F.NGW) gdn_norm_token(F, tok);
        if (rp_ == 0 && IN(7)) { split_arrive(F.ctl + CW_SPLIT + 64, F.tid); F_REFRESH(); }
        pg8::StaticOrder S; S.init(WSP(unsigned char, WS_YA8), WSP(unsigned char, WS_WPA), T, 4096, 1024, G, c);
        EpiGate<false> E{WSP(bf16, WS_MIX), WSP(bf16, WS_PROJ), C_GTA, nullptr};
        pg8::gemm_phase<EpiGate<false>, pg8::StaticOrder, true, false, 1>(F.lds, F.tid, 1024, S, E, 0x7a7a7a7a, 0x7a7a7a7a);
    }
    }
    if (IN(6) && IN(7)) { F_REFRESH(); split_wait(F.ctl + CW_SPLIT + 64, F.ctl + CW_BAR, (unsigned)G, F.tid); }
    if (IN(7)) { F_REFRESH();
        pg8::StaticOrder S; S.init((const unsigned char*)F.out, WSP(unsigned char, WS_WPG), T, 4096, 1024, G, c);
        EpiGate<true> E{WSP(bf16, WS_MIX), WSP(bf16, WS_PROJ), C_GTG, WSP(unsigned char, WS_MIX8)};
        pg8::gemm_phase<EpiGate<true>, pg8::StaticOrder, true, false, 1>(F.lds, F.tid, 1024, S, E, 0x7a7a7a7a, 0x7c7c7c7c);
    }
    SEAM(7);
    if (IN(8)) { F_REFRESH(); for (int rp_ = 0; rp_ < REPS(8); ++rp_) { if (rp_) { xcd_barrier(bar, F.tid); F_REFRESH(); }
        pg8::StaticOrder S; S.init(WSP(unsigned char, WS_MIX8), WSP(unsigned char, WS_WOUT), T, 4096, 2048, G, c);
        EpiRes E{WSP(bf16, WS_X1B), F.x()};
        pg8::gemm_phase<EpiRes, pg8::StaticOrder, true, false, 1>(F.lds, F.tid, 2048, S, E, 0x79797979, 0x7a7a7a7a);
    }
    }
    SEAM(8);
    if (IN(9)) { F_REFRESH(); for (int rp_ = 0; rp_ < REPS(9); ++rp_) {
        if (rp_) { xcd_barrier(bar, F.tid); F_REFRESH(); if (c == 0 && F.tid < 64) __hip_atomic_store(F.ctl + CW_CNT + 64 * F.tid, 0u, __ATOMIC_RELAXED, __HIP_MEMORY_SCOPE_AGENT); xcd_barrier(bar, F.tid); F_REFRESH(); }
        for (int tile = c; tile < T / 32; tile += G) router_tile(F, tile);
    } }
    SEAM(9);
    if (IN(10)) { F_REFRESH(); for (int rp_ = 0; rp_ < REPS(10); ++rp_) { if (rp_) { xcd_barrier(bar, F.tid); F_REFRESH(); }
        moe_tables(F);
        MoeGUOrder S{(const LAS int*)(F.lds + LT_SEGC), (const LAS int*)(F.lds + LT_SEGT), (const LAS int*)(F.lds + LT_RTSEG), G, c, (const char*)WSP(bf16, WS_H2), (const char*)WSP(bf16, WS_WGU), WSP(int, WS_LIST)};
        EpiGU E{WSP(bf16, WS_HE), WSP(int, WS_LIST), WSP(float, WS_RSTD)};
        pg8::gemm_phase<EpiGU, MoeGUOrder, true, true, 1>(F.lds, F.tid, 2048, S, E, 0x79797979, 0x7f7f7f7f);
    }
    }
    SEAM(10);
#define DOWN_ROUND(k) do { if (IN(11 + (k))) { F_REFRESH(); \
            moe_tables(F); \
            MoeDownOrder S{(const LAS int*)(F.lds + LT_SEGC), (const LAS int*)(F.lds + LT_SEGT), (const LAS int*)(F.lds + LT_RTSEG), (const LAS int*)(F.lds + LT_RK) + 160 * (k), ((const LAS int*)(F.lds + LT_NRK))[k], G, c, (const char*)WSP(bf16, WS_HE), (const char*)WSP(bf16, WS_WD)}; \
            EpiDown<k> E{F.out, WSP(int, WS_LIST), WSP(float, WS_LWT), WSP(bf16, WS_DPART), WSP(bf16, WS_X1B)};        \
            pg8::gemm_phase<EpiDown<k>, MoeDownOrder, true, false>(F.lds, F.tid, 512, S, E); } } while (0)
    DOWN_ROUND(0);
    SEAM(11);
    DOWN_ROUND(1);
#undef DOWN_ROUND
#undef IN
#undef SEAM
}

#ifdef DBG_STOP
__global__ void dbg_dump(float* o, const unsigned short* A, int lda, const unsigned short* B, int ldb) {
    for (size_t i = (size_t)blockIdx.x * blockDim.x + threadIdx.x; i < (size_t)T * DM; i += (size_t)gridDim.x * blockDim.x) { const size_t t = i / DM, c = i % DM;
        const unsigned short v = c < 2048 ? A[t * lda + c] : B[t * ldb + (c - 2048)]; float f = __uint_as_float(((unsigned)v) << 16); if (!(f - f == 0.f)) f = 0.f; o[i] = f; } }
#endif
#ifdef DBG_SANITIZE
__global__ void dbg_sanitize(float* o, size_t n) { for (size_t i = (size_t)blockIdx.x * blockDim.x + threadIdx.x; i < n; i += (size_t)gridDim.x * blockDim.x) { const float v = o[i]; if (!(v - v == 0.f)) o[i] = 0.f; } }
#endif
extern "C" void kernel_launch(void* const* d_in, const int* in_sizes, int n_in, void* d_out, int out_size, void* d_ws, size_t ws_size, hipStream_t stream) {
    static int grid = 0;
    if (grid == 0) {
        if (n_in != 22 || out_size != T * DM || ws_size < WS_END) { fprintf(stderr, "kernel_launch: unexpected shapes (n_in %d out %d ws %zu, need %zu)\n", n_in, out_size, ws_size, (size_t)WS_END); grid = -1; return; }
        int dev = 0, cus = 0, per_cu = 0;
        if (hipGetDevice(&dev) != hipSuccess || hipDeviceGetAttribute(&cus, hipDeviceAttributeMultiprocessorCount, dev) != hipSuccess) { grid = -1; return; }
        if (hipFuncSetAttribute((const void*)mega_fwd, hipFuncAttributeMaxDynamicSharedMemorySize, LDS_BYTES) != hipSuccess) { fprintf(stderr, "kernel_launch: hipFuncSetAttribute failed\n"); grid = -1; return; }
        if (hipOccupancyMaxActiveBlocksPerMultiprocessor(&per_cu, (const void*)mega_fwd, 512, LDS_BYTES) != hipSuccess || per_cu < 1) fprintf(stderr, "kernel_launch: occupancy query reports %d\n", per_cu);
        (void)hipGetLastError();
        grid = cus;
    }
    if (grid < 0) return;
    (void)hipMemsetAsync((char*)d_ws + WS_CTL, 0, CTL_BYTES, stream);
    Args a{};
    for (int i = 0; i < 22; ++i) a.in[i] = d_in[i];
    a.out = (float*)d_out; a.ws = (unsigned char*)d_ws;
#if ONE_LAUNCH
    a.ph_lo = -1; a.ph_hi = NPH;
    hipLaunchKernelGGL(mega_fwd, dim3(grid), dim3(512), LDS_BYTES, stream, a);
#else
#ifdef DBG_STOP
    for (int k = 0; k < DBG_STOP; ++k) { a.ph_lo = k; a.ph_hi = k + 1; hipLaunchKernelGGL(mega_fwd, dim3(grid), dim3(512), LDS_BYTES, stream, a); }
    hipLaunchKernelGGL(dbg_dump, dim3(2048), dim3(256), 0, stream, (float*)d_out, (const unsigned short*)((char*)d_ws + DBG_A), DBG_LDA, (const unsigned short*)((char*)d_ws + DBG_B), DBG_LDB);
#else
    for (int k = -1; k < NPH; ++k) { a.ph_lo = k; a.ph_hi = k + 1; hipLaunchKernelGGL(mega_fwd, dim3(grid), dim3(512), LDS_BYTES, stream, a); }
#endif
#endif
#ifdef DBG_SANITIZE
    hipLaunchKernelGGL(dbg_sanitize, dim3(2048), dim3(256), 0, stream, (float*)d_out, (size_t)T * DM);
#endif
}
```

```cpp
#include <hip/hip_runtime.h>
#include <cstdio>
#include <cstdint>

#ifndef ONE_LAUNCH
#define ONE_LAUNCH 1
#endif

#define GAS __attribute__((address_space(1)))
#define LAS __attribute__((address_space(3)))
typedef unsigned short bf16;
typedef short bf16x8 __attribute__((ext_vector_type(8)));
typedef short bf16x4 __attribute__((ext_vector_type(4)));
typedef float f32x2 __attribute__((ext_vector_type(2)));
typedef float f32x4 __attribute__((ext_vector_type(4)));
typedef float f32x16 __attribute__((ext_vector_type(16)));
typedef unsigned u32x2 __attribute__((ext_vector_type(2)));
typedef unsigned u32x4 __attribute__((ext_vector_type(4)));

constexpr int NB = 4, SEQ = 4096, T = NB * SEQ, DM = 4096;
constexpr int NIN = 20592, NPAD = 20736, LDP = 20480, LDSM = 256;
constexpr int C_AQ = 0, C_AK = 2048, C_AV = 2560, C_IQ = 3072, C_GQ = 4096, C_GK = 6144, C_GV = 8192, C_GZ = 10240, C_GTA = 12288, C_GTG = 16384;
constexpr int SMALL_PN = 80;
constexpr int SM_IK = 0, SM_IW = 64, SM_GA = 80, SM_GB = 96;
constexpr float EPS = 1e-6f;
constexpr int NPH = 13;

constexpr size_t MiB = 1u << 20;
constexpr size_t WS_CTL = 0, CTL_BYTES = 1 * MiB;
constexpr size_t WS_WPA = 1 * MiB, WS_WPG = 17 * MiB, WS_WOUT = 33 * MiB, WS_WGU = 65 * MiB, WS_WD = 321 * MiB;
constexpr size_t WS_WIN8 = 449 * MiB;
constexpr size_t WS_XN8 = 1395 * MiB;
constexpr size_t WS_GQ = 449 * MiB, WS_GO = 513 * MiB, WS_KB = 577 * MiB, WS_IKF = 593 * MiB, WS_MASK = 595 * MiB;
constexpr size_t WS_MIX = 449 * MiB;
constexpr size_t WS_HE = 449 * MiB;
constexpr size_t WS_XN = 611 * MiB;
constexpr size_t WS_QB = 611 * MiB, WS_YA = 675 * MiB;
constexpr size_t WS_YA8 = 611 * MiB;
constexpr size_t WS_MIX8 = 675 * MiB;
constexpr size_t WS_H2 = 611 * MiB;
constexpr size_t WS_PROJ = 739 * MiB; constexpr size_t WS_DPART = WS_PROJ, WS_X1B = WS_PROJ + ((size_t)128 << 20);
constexpr size_t WS_SMALL = 1379 * MiB;
constexpr size_t WS_OSC = 1395 * MiB;
constexpr size_t WS_LIST = 1395 * MiB, WS_LWT = 1399 * MiB;
constexpr size_t WS_R128C = 1459 * MiB, WS_R128S = 1463 * MiB, WS_R64C = 1467 * MiB, WS_R64S = 1469 * MiB;
constexpr size_t WS_WRF = 1471 * MiB;
constexpr size_t WS_RSTD = 1472 * MiB, WS_GG = WS_RSTD + 65536, WS_SA = WS_GG + 65536;
constexpr size_t WS_END = 1472 * MiB + 196608;
constexpr int CW_BAR = 4096;
constexpr int CW_CNT = 16384;
constexpr int CW_SPLIT = 36864;
constexpr int CW_AMAX = 32768;

constexpr int RING_BYTES = 131072, LDSCTL_OFF = 131072, LDS_BYTES = 147456;
constexpr int LT_SEGC = LDSCTL_OFF + 256;
constexpr int LT_SEGT = LT_SEGC + 256;
constexpr int LT_RTSEG = LT_SEGT + 320;
constexpr int LT_RK = LT_RTSEG + 1024;
constexpr int LT_NRK = LT_RK + 1280;

#define LDS_WAIT() asm volatile("s_waitcnt lgkmcnt(0)" ::: "memory")
#define LDS_BARRIER() do { asm volatile("s_waitcnt lgkmcnt(0)" ::: "memory"); __builtin_amdgcn_s_barrier(); asm volatile("" ::: "memory"); } while (0)
#define VM_WAIT() asm volatile("s_waitcnt vmcnt(0)" ::: "memory")

typedef __bf16 bf16x2_t __attribute__((ext_vector_type(2)));
__device__ __forceinline__ unsigned cvt_pk_bf16(float lo, float hi) { const f32x2 f = {lo, hi}; return __builtin_bit_cast(unsigned, __builtin_convertvector(f, bf16x2_t)); }
__device__ __forceinline__ unsigned cvt2_fp8(float a, float b, unsigned old, bool hi) { a = __builtin_amdgcn_fmed3f(a, -440.f, 440.f); b = __builtin_amdgcn_fmed3f(b, -440.f, 440.f); return hi ? __builtin_amdgcn_cvt_pk_fp8_f32(a, b, old, true) : __builtin_amdgcn_cvt_pk_fp8_f32(a, b, old, false); }
__device__ __forceinline__ unsigned q4_i8(float a, float b, float c, float d, float inv) {
    const float M = 12582912.f;
    const unsigned ua = __float_as_uint(__builtin_amdgcn_fmed3f(a * inv, -127.f, 127.f) + M), ub = __float_as_uint(__builtin_amdgcn_fmed3f(b * inv, -127.f, 127.f) + M);
    const unsigned uc = __float_as_uint(__builtin_amdgcn_fmed3f(c * inv, -127.f, 127.f) + M), ud = __float_as_uint(__builtin_amdgcn_fmed3f(d * inv, -127.f, 127.f) + M);
    return __builtin_amdgcn_perm(ub, ua, 0x0c0c0400) | __builtin_amdgcn_perm(ud, uc, 0x04000c0c);
}
__device__ __forceinline__ float bf2f(unsigned short b) { return __uint_as_float(((unsigned)b) << 16); }
__device__ __forceinline__ float bflo(unsigned w) { return __uint_as_float(w << 16); }
__device__ __forceinline__ float bfhi(unsigned w) { return __uint_as_float(w & 0xffff0000u); }
__device__ __forceinline__ unsigned short f2bf(float f) { return (unsigned short)(cvt_pk_bf16(f, 0.f) & 0xffffu); }
__device__ __forceinline__ float sigmoidf_(float x) { return __builtin_amdgcn_rcpf(1.f + __expf(-x)); }
__device__ __forceinline__ float wave_sum(float v) {
#pragma unroll
    for (int o = 1; o < 64; o <<= 1) v += __shfl_xor(v, o);
    return v;
}
__device__ __forceinline__ int opaque(int v) { int r; asm volatile("v_mov_b32 %0, %1" : "=v"(r) : "v"(v)); return r; }
__device__ __forceinline__ int crow(int r, int hi) { return (r & 3) + 8 * (r >> 2) + 4 * hi; }

__device__ __forceinline__ const char* uniform_ptr(const char* p) { const unsigned long long v = (unsigned long long)p; const unsigned lo = __builtin_amdgcn_readfirstlane((unsigned)v), hi = __builtin_amdgcn_readfirstlane((unsigned)(v >> 32)); return (const char*)(((unsigned long long)hi << 32) | lo); }
namespace pg8 {
typedef int v4i_t __attribute__((ext_vector_type(4)));
typedef int v8i_t __attribute__((ext_vector_type(8)));
constexpr int BM = 256, BK = 64, HALF = 128, HTB = HALF * BK * 2, STAGE_BYTES = 8 * HTB, NXCD = 8, WGM = 8;
__host__ __device__ __forceinline__ int lds_byte(int r, int c) { const int st = (r >> 4) * 2 + (c >> 5), rr = r & 15, cc = c & 31, ob = rr * 64 + cc * 2; return st * 1024 + (ob ^ (((ob >> 9) & 1) << 5)); }
__host__ __device__ __forceinline__ void stage_rc(int b, int& R, int& C) { const int st = b / 1024, sb = b % 1024, swz = sb ^ (((sb >> 9) & 1) << 5); R = (st >> 1) * 16 + swz / 64; C = (st & 1) * 32 + (swz % 64) / 2; }
__host__ __device__ __forceinline__ int perm32(int rho) { const int n = rho >> 4, i = rho & 15; return 8 * (i >> 2) + 4 * n + (i & 3); }

struct Unit { int pm, pn; const char* A; const char* B; const int* rows; int nrows; int aux0, aux1; };

struct StaticOrder {
    int nM, nN, nwg, G, c; const char* A; const char* Bt; size_t tstep;
    __device__ void init(const void* A_, const void* Bt_, int M, int N, int K, int G_, int c_) { nM = M / BM; nN = N / BM; nwg = nM * nN; G = G_; c = c_; A = (const char*)A_; Bt = (const char*)Bt_; tstep = (size_t)BM * K * 2; }
    __device__ __forceinline__ bool next(int i, Unit& u) const { return at((long)i * G + c, u); }
    __device__ __forceinline__ bool at(long L, Unit& u) const {
        if (L < 0 || L >= nwg) return false;
        int wgid = (int)L; { const int q = nwg / NXCD, r = nwg % NXCD, xcd = wgid % NXCD, off = wgid / NXCD; wgid = (xcd < r ? xcd * (q + 1) : r * (q + 1) + (xcd - r) * q) + off; }
        const int nig = WGM * nN, gid = wgid / nig, fm = gid * WGM, gsz = (nM - fm) < WGM ? (nM - fm) : WGM;
        u.pm = fm + ((wgid % nig) % gsz); u.pn = (wgid % nig) / gsz; u.A = A + (size_t)u.pm * tstep; u.B = Bt + (size_t)u.pn * tstep; u.rows = nullptr; u.nrows = 256; u.aux0 = 0; u.aux1 = 0; return true;
    }
};

struct StaggerOrder : StaticOrder {
    __device__ __forceinline__ bool next(int i, Unit& u) const {
        if (G != 256 || nwg != 5184) return at((long)i * G + c, u);
        if (i < 20) return at((long)i * 256 + c, u);
        if (i == 20 && (c & 7) < 2) return at(5120 + (c >> 3) * 2 + (c & 7), u);
        return false;
    }
};
struct SkewOrder : StaticOrder {
    __device__ __forceinline__ bool next(int i, Unit& u) const {
        if (G != 256 || nwg != 2816) return at((long)i * G + c, u);
        if (i < 9) return at((long)i * 256 + c, u);
        if (c < 64) return false;
        const int j = c - 64;
        if (i == 9) return at(2304 + j, u);
        if (j < 128) { if (i == 10) return at(2304 + 192 + j, u); if (i == 11) return at(2304 + 192 + 128 + j, u); return false; }
        if (i == 10) return at(2304 + 192 + 256 + (j - 128), u);
        return false;
    }
};
template <class Epi, class Sched, bool ALIGN_EPI, bool GATHER, int MODE = 0>
__device__ __forceinline__ void gemm_phase(LAS unsigned char* lds, const int tid, const int K, const Sched& S, const Epi& E, const int sw = 0x79797979, const int sa = 0x7f7f7f7f) {
    const int wid = __builtin_amdgcn_readfirstlane(tid >> 6), lane = tid & 63, wr = wid >> 2, wc = wid & 3, fr = lane & 15, fq = lane >> 4;
    constexpr bool FP8 = MODE == 1, I8 = MODE == 2;
    const int nt = K / BK;
    unsigned vA[2][2], voffB[2];
    const size_t hstep = (size_t)HALF * K * 2;
#pragma unroll
    for (int i = 0; i < 2; ++i) { int R, C; stage_rc(tid * 16 + i * 8192, R, C); const int Rb = (R & ~31) + perm32(R & 31);
        vA[0][i] = (unsigned)(R * K + C) * 2u; vA[1][i] = 0u; voffB[i] = (unsigned)(Rb * K + C) * 2u; }
    const unsigned ldsw = (unsigned)wid * 1024u;
    const int aoff = lds_byte(wr * 64 + fr, fq * 8), boff = lds_byte(wc * 32 + fr, fq * 8);
#define PG8_SA(b, h) (((b) * 2 + (h)) * HTB)
#define PG8_SB(b, h) ((4 + (b) * 2 + (h)) * HTB)
#define PG8_STAGEV(bufoff, rs, soff, o0, o1) do { \
        __builtin_amdgcn_raw_ptr_buffer_load_lds(rs, (LAS void*)(lds + (bufoff) + ldsw), 16, (int)(o0), (int)(soff), 0, 0); \
        __builtin_amdgcn_raw_ptr_buffer_load_lds(rs, (LAS void*)(lds + (bufoff) + ldsw + 8192), 16, (int)(o1), (int)(soff), 0, 0); } while (0)
#define PG8_STAGEB(bufoff, rs, soff) PG8_STAGEV(bufoff, rs, soff, voffB[0], voffB[1])
#define PG8_STAGEA(bufoff, rs, soff, h) do { if constexpr (GATHER) PG8_STAGEV(bufoff, rs, soff, vA[h][0], vA[h][1]); else PG8_STAGEV(bufoff, rs, (soff) + (h) * (int)hstep, vA[0][0], vA[0][1]); } while (0)
#define PG8_RSRC(p) __builtin_amdgcn_make_buffer_rsrc((void*)uniform_ptr(p), 0, 0xffffffffu, 0x00020000)
#define PG8_LDA(dst, b, h) do { _Pragma("unroll") for (int m = 0; m < 4; ++m) _Pragma("unroll") for (int k = 0; k < 2; ++k) dst[m][k] = *(const LAS bf16x8*)(lds + PG8_SA(b, h) + aoff + m * 2048 + k * 1024); } while (0)
#define PG8_LDB(dst, b, h) do { _Pragma("unroll") for (int n = 0; n < 2; ++n) _Pragma("unroll") for (int k = 0; k < 2; ++k) dst[n][k] = *(const LAS bf16x8*)(lds + PG8_SB(b, h) + boff + n * 2048 + k * 1024); } while (0)
#define PG8_MMA(ai, bj, At, Bt) do { __builtin_amdgcn_s_setprio(1); _Pragma("unroll") for (int m = 0; m < 4; ++m) _Pragma("unroll") for (int n = 0; n < 2; ++n) _Pragma("unroll") for (int k = 0; k < 2; ++k) \
        acc[ai][bj][m][n] = __builtin_amdgcn_mfma_f32_16x16x32_bf16(Bt[n][k], At[m][k], acc[ai][bj][m][n], 0, 0, 0); __builtin_amdgcn_s_setprio(0); } while (0)
#define PG8_LDA8(dst, b, h) do { _Pragma("unroll") for (int m = 0; m < 4; ++m) { dst[m].lo = *(const LAS v4i_t*)(lds + PG8_SA(b, h) + aoff + m * 2048); dst[m].hi = *(const LAS v4i_t*)(lds + PG8_SA(b, h) + aoff + m * 2048 + 1024); } } while (0)
#define PG8_LDB8(dst, b, h) do { _Pragma("unroll") for (int n = 0; n < 2; ++n) { dst[n].lo = *(const LAS v4i_t*)(lds + PG8_SB(b, h) + boff + n * 2048); dst[n].hi = *(const LAS v4i_t*)(lds + PG8_SB(b, h) + boff + n * 2048 + 1024); } } while (0)
#define PG8_MMA8(ai, bj, At, Bt) do { __builtin_amdgcn_s_setprio(1); _Pragma("unroll") for (int m = 0; m < 4; ++m) _Pragma("unroll") for (int n = 0; n < 2; ++n) \
        acc[ai][bj][m][n] = __builtin_amdgcn_mfma_scale_f32_16x16x128_f8f6f4(Bt[n], At[m], acc[ai][bj][m][n], 0, 0, 0, sw, 0, sa); __builtin_amdgcn_s_setprio(0); } while (0)
#define PG8_MMAI(ai, bj, At, Bt) do { __builtin_amdgcn_s_setprio(1); _Pragma("unroll") for (int m = 0; m < 4; ++m) _Pragma("unroll") for (int n = 0; n < 2; ++n) _Pragma("unroll") for (int k = 0; k < 2; ++k) \
        acci[ai][bj][m][n] = __builtin_amdgcn_mfma_i32_16x16x64_i8(__builtin_bit_cast(v4i_t, Bt[n][k]), __builtin_bit_cast(v4i_t, At[m][k]), acci[ai][bj][m][n], 0, 0, 0); __builtin_amdgcn_s_setprio(0); } while (0)
#define PG8_WAIT_V(n) asm volatile("s_waitcnt vmcnt(" #n ")" ::: "memory")
#define PG8_WAIT_L(n) asm volatile("s_waitcnt lgkmcnt(" #n ")" ::: "memory")
#define PG8_BAR __builtin_amdgcn_s_barrier()
#define PG8_SCHED __builtin_amdgcn_sched_barrier(0)
    Unit cur, nxt; int ui = 0;
    if (!S.next(0, cur)) return;
    if constexpr (GATHER) {
#pragma unroll
        for (int h = 0; h < 2; ++h)
#pragma unroll
            for (int i = 0; i < 2; ++i) { int R, C; stage_rc(tid * 16 + i * 8192, R, C); const int lr = h * HALF + R; const int tok = lr < cur.nrows ? cur.rows[lr] : 0; vA[h][i] = (unsigned)tok * (unsigned)(K * 2) + (unsigned)(C * 2); }
    }
    f32x4 acc[2][2][4][2];
#pragma unroll
    for (int a = 0; a < 2; ++a)
#pragma unroll
        for (int b = 0; b < 2; ++b)
#pragma unroll
            for (int m = 0; m < 4; ++m)
#pragma unroll
                for (int n = 0; n < 2; ++n) acc[a][b][m][n] = (f32x4){0.f, 0.f, 0.f, 0.f};
    v4i_t acci[2][2][4][2];
#pragma unroll
    for (int a = 0; a < 2; ++a)
#pragma unroll
        for (int b = 0; b < 2; ++b)
#pragma unroll
            for (int m = 0; m < 4; ++m)
#pragma unroll
                for (int n = 0; n < 2; ++n) acci[a][b][m][n] = (v4i_t){0, 0, 0, 0};
    bf16x8 At[4][2], B0[2][2], B1[2][2]; v8i_t A8[4], B08[2], B18[2];
    auto rA = PG8_RSRC(cur.A), rB = PG8_RSRC(cur.B);
    const int ks = BK * 2, hs = (int)hstep;
    PG8_STAGEB(PG8_SB(0, 0), rB, 0); PG8_STAGEB(PG8_SB(0, 1), rB, hs); PG8_STAGEA(PG8_SA(0, 0), rA, 0, 0); PG8_STAGEA(PG8_SA(0, 1), rA, 0, 1);
    if (wr == 1) PG8_BAR;
    PG8_WAIT_V(2); PG8_BAR;
    PG8_STAGEB(PG8_SB(1, 0), rB, ks); PG8_STAGEA(PG8_SA(1, 0), rA, ks, 0); PG8_STAGEB(PG8_SB(1, 1), rB, hs + ks);
    PG8_WAIT_V(6); PG8_BAR;
    for (;;) {
        const bool has_next = S.next(ui + 1, nxt);
        auto rAn = rA, rBn = rB; if (has_next) { rAn = PG8_RSRC(nxt.A); rBn = PG8_RSRC(nxt.B); }
        for (int t = 0; t < nt; t += 2) {
            const bool last = (t == nt - 2);
            const int o1 = (t + 1) * ks, o2 = last ? 0 : (t + 2) * ks, o3 = o2 + ks;
            const auto rA2 = last ? rAn : rA; const auto rB2 = last ? rBn : rB;
            if constexpr (FP8) {
            PG8_LDB8(B08, 0, 0); PG8_LDB8(B18, 0, 1); PG8_SCHED; PG8_LDA8(A8, 0, 0); PG8_STAGEA(PG8_SA(1, 1), rA, o1, 1);
            PG8_WAIT_V(8); PG8_WAIT_L(0); PG8_BAR; PG8_MMA8(0, 0, A8, B08); PG8_MMA8(0, 1, A8, B18); PG8_BAR; PG8_SCHED;
            if constexpr (GATHER) { if (last && has_next) {
#pragma unroll
                for (int h = 0; h < 2; ++h)
#pragma unroll
                    for (int i = 0; i < 2; ++i) { int R, C; stage_rc(tid * 16 + i * 8192, R, C); const int lr = h * HALF + R; const int tok = lr < nxt.nrows ? nxt.rows[lr] : 0; vA[h][i] = (unsigned)tok * (unsigned)(K * 2) + (unsigned)(C * 2); } } }
            PG8_LDA8(A8, 0, 1); PG8_STAGEB(PG8_SB(0, 0), rB2, o2); PG8_STAGEB(PG8_SB(0, 1), rB2, o2 + hs); PG8_STAGEA(PG8_SA(0, 0), rA2, o2, 0);
            PG8_WAIT_V(8); PG8_WAIT_L(0); PG8_BAR; PG8_MMA8(1, 0, A8, B08); PG8_MMA8(1, 1, A8, B18); PG8_BAR; PG8_SCHED;
            PG8_LDB8(B08, 1, 0); PG8_LDB8(B18, 1, 1); PG8_SCHED; PG8_LDA8(A8, 1, 0); PG8_STAGEA(PG8_SA(0, 1), rA2, o2, 1);
            PG8_WAIT_V(8); PG8_WAIT_L(0); PG8_BAR; PG8_MMA8(0, 0, A8, B08); PG8_MMA8(0, 1, A8, B18); PG8_BAR; PG8_SCHED;
            PG8_LDA8(A8, 1, 1); PG8_STAGEB(PG8_SB(1, 0), rB2, o3); PG8_STAGEB(PG8_SB(1, 1), rB2, o3 + hs); PG8_STAGEA(PG8_SA(1, 0), rA2, o3, 0);
            PG8_WAIT_V(8); PG8_WAIT_L(0); PG8_BAR; PG8_MMA8(1, 0, A8, B08); PG8_MMA8(1, 1, A8, B18); PG8_BAR; PG8_SCHED;
            } else {
            PG8_LDB(B0, 0, 0); PG8_LDB(B1, 0, 1); PG8_SCHED; PG8_LDA(At, 0, 0); PG8_STAGEA(PG8_SA(1, 1), rA, o1, 1);
            PG8_WAIT_V(8); PG8_WAIT_L(0); PG8_BAR; if constexpr (I8) { PG8_MMAI(0, 0, At, B0); PG8_MMAI(0, 1, At, B1); } else { PG8_MMA(0, 0, At, B0); PG8_MMA(0, 1, At, B1); } PG8_BAR; PG8_SCHED;
            if constexpr (GATHER) { if (last && has_next) {
#pragma unroll
                for (int h = 0; h < 2; ++h)
#pragma unroll
                    for (int i = 0; i < 2; ++i) { int R, C; stage_rc(tid * 16 + i * 8192, R, C); const int lr = h * HALF + R; const int tok = lr < nxt.nrows ? nxt.rows[lr] : 0; vA[h][i] = (unsigned)tok * (unsigned)(K * 2) + (unsigned)(C * 2); } } }
            PG8_LDA(At, 0, 1); PG8_STAGEB(PG8_SB(0, 0), rB2, o2); PG8_STAGEB(PG8_SB(0, 1), rB2, o2 + hs); PG8_STAGEA(PG8_SA(0, 0), rA2, o2, 0);
            PG8_WAIT_V(8); PG8_WAIT_L(0); PG8_BAR; if constexpr (I8) { PG8_MMAI(1, 0, At, B0); PG8_MMAI(1, 1, At, B1); } else { PG8_MMA(1, 0, At, B0); PG8_MMA(1, 1, At, B1); } PG8_BAR; PG8_SCHED;
            PG8_LDB(B0, 1, 0); PG8_LDB(B1, 1, 1); PG8_SCHED; PG8_LDA(At, 1, 0); PG8_STAGEA(PG8_SA(0, 1), rA2, o2, 1);
            PG8_WAIT_V(8); PG8_WAIT_L(0); PG8_BAR; if constexpr (I8) { PG8_MMAI(0, 0, At, B0); PG8_MMAI(0, 1, At, B1); } else { PG8_MMA(0, 0, At, B0); PG8_MMA(0, 1, At, B1); } PG8_BAR; PG8_SCHED;
            PG8_LDA(At, 1, 1); PG8_STAGEB(PG8_SB(1, 0), rB2, o3); PG8_STAGEB(PG8_SB(1, 1), rB2, o3 + hs); PG8_STAGEA(PG8_SA(1, 0), rA2, o3, 0);
            PG8_WAIT_V(8); PG8_WAIT_L(0); PG8_BAR; if constexpr (I8) { PG8_MMAI(1, 0, At, B0); PG8_MMAI(1, 1, At, B1); } else { PG8_MMA(1, 0, At, B0); PG8_MMA(1, 1, At, B1); } PG8_BAR; PG8_SCHED;
            }
        }
        if constexpr (ALIGN_EPI) { if (wr == 0) PG8_BAR; }
        if constexpr (I8) {
#pragma unroll
            for (int a = 0; a < 2; ++a)
#pragma unroll
                for (int b = 0; b < 2; ++b)
#pragma unroll
                    for (int m = 0; m < 4; ++m)
#pragma unroll
                        for (int n = 0; n < 2; ++n) { const v4i_t q = acci[a][b][m][n]; acc[a][b][m][n] = (f32x4){(float)q[0], (float)q[1], (float)q[2], (float)q[3]}; acci[a][b][m][n] = (v4i_t){0, 0, 0, 0}; } }
        E(acc, cur, wr, wc, fr, fq);
        if (!has_next) break;
#pragma unroll
        for (int a = 0; a < 2; ++a)
#pragma unroll
            for (int b = 0; b < 2; ++b)
#pragma unroll
                for (int m = 0; m < 4; ++m)
#pragma unroll
                    for (int n = 0; n < 2; ++n) acc[a][b][m][n] = (f32x4){0.f, 0.f, 0.f, 0.f};
        cur = nxt; rA = rAn; rB = rBn; ++ui;
        if constexpr (ALIGN_EPI) { if (wr == 1) PG8_BAR; }
    }
    PG8_WAIT_V(0);
    if constexpr (!ALIGN_EPI) { if (wr == 0) PG8_BAR; }
    PG8_BAR;
#undef PG8_SA
#undef PG8_SB
#undef PG8_STAGEV
#undef PG8_STAGEB
#undef PG8_STAGEA
#undef PG8_RSRC
#undef PG8_LDA
#undef PG8_LDB
#undef PG8_MMA
#undef PG8_LDA8
#undef PG8_LDB8
#undef PG8_MMA8
#undef PG8_MMAI
#undef PG8_WAIT_V
#undef PG8_WAIT_L
#undef PG8_BAR
#undef PG8_SCHED
}
}

#define XB_TMO      128
#define XB_XCNT(j)  (256  + 64 * (j))
#define XB_XSUB(j)  (1280 + 64 * (j))
#define XB_XGEN(j)  (2304 + 64 * (j))
#define XB_TOP      3328
#define XB_TOPGEN   3392
#define XCD_BAR_WORDS 3456
#define XB_SPIN_CAP (1u << 20)
__device__ __forceinline__ unsigned xb_ld(unsigned* p)              { return __hip_atomic_load(p, __ATOMIC_RELAXED, __HIP_MEMORY_SCOPE_AGENT); }
__device__ __forceinline__ unsigned xb_add(unsigned* p, unsigned v) { return __hip_atomic_fetch_add(p, v, __ATOMIC_RELAXED, __HIP_MEMORY_SCOPE_AGENT); }
__device__ __forceinline__ unsigned xb_xcc_id() { return (unsigned)__builtin_amdgcn_s_getreg((3 << 11) | 20) & 0xFu; }
#define XB_SPIN(cond, bar) do { unsigned _sp = 0; while (cond) { __builtin_amdgcn_s_sleep(1); \
    if ((++_sp & 255u) == 0u) { if (xb_ld(&(bar)[XB_TMO])) break; if (_sp > XB_SPIN_CAP) { atomicAdd(&(bar)[XB_TMO], 1u); break; } } } } while (0)
struct XcdBarrier { unsigned* bar; unsigned x; volatile LAS unsigned* st; };
__device__ __forceinline__ XcdBarrier xcd_barrier_post(unsigned* bar, volatile LAS unsigned* st, int tid) {
    XcdBarrier b; b.bar = bar; b.x = xb_xcc_id(); b.st = st;
    if (tid == 0) (void)xb_add(&bar[XB_XCNT(b.x)], 1u);
    return b;
}
__device__ __forceinline__ void xcd_barrier_complete(unsigned* bar, unsigned x, unsigned& nloc, unsigned& nx) {
    const unsigned G = gridDim.x * gridDim.y * gridDim.z;
    unsigned sum, cnt, mine, sp = 0u;
    for (;;) {
        sum = 0u; cnt = 0u; mine = 0u;
#pragma unroll
        for (unsigned j = 0; j < 16; ++j) { const unsigned c = xb_ld(&bar[XB_XCNT(j)]); sum += c; cnt += (c > 0u) ? 1u : 0u; mine = (j == x) ? c : mine; }
        if (sum == G) break;
        __builtin_amdgcn_s_sleep(1);
        if ((++sp & 255u) == 0u) { if (xb_ld(&bar[XB_TMO])) break; if (sp > XB_SPIN_CAP) { atomicAdd(&bar[XB_TMO], 1u); break; } }
    }
    nloc = mine > 0u ? mine : 1u; nx = cnt > 0u ? cnt : 1u;
}
__device__ __forceinline__ void xcd_barrier(const XcdBarrier& b, int tid) {
    asm volatile("s_waitcnt vmcnt(0)" ::: "memory");
    __syncthreads();
    if (tid == 0) {
        unsigned* bar = b.bar;
        __builtin_amdgcn_s_waitcnt(0);
        unsigned nloc = b.st[0], nx = b.st[1];
        if (nloc == 0u) { xcd_barrier_complete(bar, b.x, nloc, nx); b.st[0] = nloc; b.st[1] = nx; }
        const unsigned old = xb_add(&bar[XB_XSUB(b.x)], 1u);
        const unsigned gen = old / nloc;
        if (old + 1u == (gen + 1u) * nloc) {
            __builtin_amdgcn_fence(__ATOMIC_RELEASE, "agent");
            asm volatile("s_waitcnt vmcnt(0)" ::: "memory");
            const unsigned og = xb_add(&bar[XB_TOP], 1u);
            const unsigned tg = og / nx;
            if (og + 1u == (tg + 1u) * nx) xb_add(&bar[XB_TOPGEN], 1u);
            else XB_SPIN(xb_ld(&bar[XB_TOPGEN]) == tg, bar);
            __builtin_amdgcn_fence(__ATOMIC_ACQUIRE, "agent");
            xb_add(&bar[XB_XGEN(b.x)], 1u);
            asm volatile("s_waitcnt vmcnt(0)" ::: "memory");
        } else {
            XB_SPIN(xb_ld(&bar[XB_XGEN(b.x)]) == gen, bar);
            __builtin_amdgcn_fence(__ATOMIC_ACQUIRE, "agent");
            asm volatile("s_waitcnt vmcnt(0)" ::: "memory");
        }
    }
    __syncthreads();
}

__device__ __forceinline__ void split_arrive(unsigned* ctr, int tid) {
    asm volatile("s_waitcnt vmcnt(0)" ::: "memory");
    __syncthreads();
    if (tid == 0) { __builtin_amdgcn_fence(__ATOMIC_RELEASE, "agent"); asm volatile("s_waitcnt vmcnt(0)" ::: "memory"); (void)xb_add(ctr, 1u); }
}
__device__ __forceinline__ void split_wait(unsigned* ctr, unsigned* bar, unsigned G, int tid) {
    asm volatile("s_waitcnt vmcnt(0)" ::: "memory");
    __syncthreads();
    if (tid == 0) { XB_SPIN(xb_ld(ctr) < G, bar); __builtin_amdgcn_fence(__ATOMIC_ACQUIRE, "agent"); asm volatile("s_waitcnt vmcnt(0)" ::: "memory"); }
    __syncthreads();
}

struct Frame {
    LAS unsigned char* lds;
    int tid, lane, wave, G, gw, NGW;
    unsigned char* ws; float* out; unsigned* ctl;
    const __attribute__((address_space(4))) void* const* kin;
    __device__ __forceinline__ const float* x() const { return (const float*)kin[0]; }
    __device__ __forceinline__ const int* pos() const { return (const int*)kin[1]; }
    __device__ __forceinline__ const float* mixw() const { return (const float*)kin[2]; }
    __device__ __forceinline__ const float* w_in() const { return (const float*)kin[3]; }
    __device__ __forceinline__ const float* qnw() const { return (const float*)kin[4]; }
    __device__ __forceinline__ const float* knw() const { return (const float*)kin[5]; }
    __device__ __forceinline__ const float* iknw() const { return (const float*)kin[6]; }
    __device__ __forceinline__ const float* convw() const { return (const float*)kin[7]; }
    __device__ __forceinline__ const float* alog() const { return (const float*)kin[8]; }
    __device__ __forceinline__ const float* dtb() const { return (const float*)kin[9]; }
    __device__ __forceinline__ const float* gnw() const { return (const float*)kin[10]; }
    __device__ __forceinline__ const float* wpa() const { return (const float*)kin[11]; }
    __device__ __forceinline__ const float* wpg() const { return (const float*)kin[12]; }
    __device__ __forceinline__ const float* wout() const { return (const float*)kin[13]; }
    __device__ __forceinline__ const float* ffnw() const { return (const float*)kin[14]; }
    __device__ __forceinline__ const float* wrg() const { return (const float*)kin[15]; }
    __device__ __forceinline__ const float* brg() const { return (const float*)kin[16]; }
    __device__ __forceinline__ const float* wre() const { return (const float*)kin[17]; }
    __device__ __forceinline__ const float* bre() const { return (const float*)kin[18]; }
    __device__ __forceinline__ const float* wg() const { return (const float*)kin[19]; }
    __device__ __forceinline__ const float* wu() const { return (const float*)kin[20]; }
    __device__ __forceinline__ const float* wd() const { return (const float*)kin[21]; }
};
#define WSP(type, off) ((type*)(F.ws + (off)))

struct RmIn { __device__ __forceinline__ int operator()(int n) const {
    if (n < 4096) return n;
    if (n < 4160) return 20480 + (n - 4096);
    if (n < 4176) return 20544 + (n - 4160);
    if (n < 12368) return 4096 + (n - 4176);
    if (n < 12384) return 20560 + (n - 12368);
    if (n < 12400) return 20576 + (n - 12384);
    return 12288 + (n - 12400); } };
struct TDesc { const float* W; bf16* WT; unsigned char* W8; int K, N, kind, off, k0, n0; float ws8; };
__device__ __forceinline__ int t_row(const TDesc& d, int n) { return d.kind == 0 ? ~RmIn{}(n) : d.kind == 1 ? ~n : d.kind == 2 ? ~(d.off + 256 * (n >> 7) + (n & 127)) : d.off + n; }
__device__ __forceinline__ void t_load(const TDesc& d, f32x4 (&raw)[8], int lane) {
    const int nn = d.n0 + 4 * (lane & 7);
#pragma unroll
    for (int j = 0; j < 8; ++j) { const float* p = d.W + (size_t)(d.k0 + (lane >> 3) + 8 * j) * d.N + nn;
        if (nn + 3 < d.N) raw[j] = *(const f32x4*)p; else { raw[j] = (f32x4){0.f, 0.f, 0.f, 0.f}; if (nn < d.N) raw[j].x = p[0]; if (nn + 1 < d.N) raw[j].y = p[1]; if (nn + 2 < d.N) raw[j].z = p[2]; } }
}
__device__ __forceinline__ void t_store(const TDesc& d, LAS float* scr, int lane) {
    const int c = lane & 7;
#pragma unroll
    for (int j = 0; j < 4; ++j) { const int n = (lane >> 3) + 8 * j; const LAS float* s = scr + (8 * c) * 33 + n;
        if (d.n0 + n < d.N) { const int row = t_row(d, d.n0 + n);
            if (row >= 0) { u32x4 o; o.x = cvt_pk_bf16(s[0 * 33], s[1 * 33]); o.y = cvt_pk_bf16(s[2 * 33], s[3 * 33]); o.z = cvt_pk_bf16(s[4 * 33], s[5 * 33]); o.w = cvt_pk_bf16(s[6 * 33], s[7 * 33]);
                *(u32x4*)(d.WT + (size_t)row * d.K + d.k0 + 8 * c) = o; }
            else if (d.kind == 0) { const float ws8 = d.ws8; *(u32x2*)(d.W8 + (size_t)(~row) * d.K + d.k0 + 8 * c) = (u32x2){q4_i8(s[0 * 33], s[1 * 33], s[2 * 33], s[3 * 33], ws8), q4_i8(s[4 * 33], s[5 * 33], s[6 * 33], s[7 * 33], ws8)}; }
            else { unsigned lo = 0u, hi = 0u; const float ws8 = d.ws8;
                lo = cvt2_fp8(s[0 * 33] * ws8, s[1 * 33] * ws8, lo, false); lo = cvt2_fp8(s[2 * 33] * ws8, s[3 * 33] * ws8, lo, true);
                hi = cvt2_fp8(s[4 * 33] * ws8, s[5 * 33] * ws8, hi, false); hi = cvt2_fp8(s[6 * 33] * ws8, s[7 * 33] * ws8, hi, true);
                *(u32x2*)(d.W8 + (size_t)(~row) * d.K + d.k0 + 8 * c) = (u32x2){lo, hi}; } } }
}
__device__ __forceinline__ void p_amax(Frame& F) {
    const f32x4* w = (const f32x4*)F.w_in(); const size_t n4 = (size_t)4096 * NIN / 4; float am = 0.f;
    for (size_t i = (size_t)F.gw * 64 + F.lane; i < n4; i += (size_t)F.NGW * 64) { const f32x4 v = w[n4 - 1 - i];
        am = fmaxf(am, fmaxf(fmaxf(fabsf(v.x), fabsf(v.y)), fmaxf(fabsf(v.z), fabsf(v.w)))); }
#pragma unroll
    for (int o = 1; o < 64; o <<= 1) am = fmaxf(am, __shfl_xor(am, o));
    if (F.lane == 0) __hip_atomic_fetch_max(F.ctl + CW_AMAX, __float_as_uint(am), __ATOMIC_RELAXED, __HIP_MEMORY_SCOPE_AGENT);
}
constexpr int CV_I_IN = 64 * 644, CV_I_PA = 32 * 128, CV_I_OUT = 64 * 128, CV_I_G = 64 * 16, CV_I_D = 8 * 128;
constexpr int CV_NITEMS = CV_I_IN + 2 * CV_I_PA + CV_I_OUT + 32 * (2 * CV_I_G + CV_I_D);
constexpr int CV_MID = 18432;
constexpr int CV_LATE = 36864;
__device__ __forceinline__ void convert_items(Frame& F, int first, int last, int w, int nw) {
    LAS float* scr = (LAS float*)(F.lds + F.wave * 16384);
    const int lane = opaque(F.lane);
    unsigned char* WIN8 = WSP(unsigned char, WS_WIN8); bf16* WPA = WSP(bf16, WS_WPA); bf16* WPG = WSP(bf16, WS_WPG); bf16* WOUT = WSP(bf16, WS_WOUT); bf16* WGU = WSP(bf16, WS_WGU); bf16* WD = WSP(bf16, WS_WD);
    constexpr int I_IN = CV_I_IN, I_PA = CV_I_PA, I_OUT = CV_I_OUT, I_G = CV_I_G, I_D = CV_I_D;
    const float winv = 127.f / fmaxf(__uint_as_float(__hip_atomic_load(F.ctl + CW_AMAX, __ATOMIC_RELAXED, __HIP_MEMORY_SCOPE_AGENT)), 1e-30f);
    auto decode = [&](int it) -> TDesc { TDesc d; int r = it; d.WT = nullptr; d.W8 = nullptr; d.off = 0; d.ws8 = 64.f;
        if (r < I_IN) { d.W = F.w_in(); d.K = 4096; d.N = NIN; d.kind = 0; d.W8 = WIN8; d.ws8 = winv; }
        else if ((r -= I_IN) < I_PA) { d.W = F.wpa(); d.K = 2048; d.N = 4096; d.kind = 1; d.W8 = (unsigned char*)WPA; d.ws8 = 32.f; }
        else if ((r -= I_PA) < I_PA) { d.W = F.wpg(); d.K = 2048; d.N = 4096; d.kind = 1; d.W8 = (unsigned char*)WPG; d.ws8 = 32.f; }
        else if ((r -= I_PA) < I_OUT) { d.W = F.wout(); d.K = 4096; d.N = 4096; d.kind = 1; d.W8 = (unsigned char*)WOUT; }
        else { r -= I_OUT; const int e = r / (2 * I_G + I_D); r -= e * (2 * I_G + I_D);
            if (r < I_G) { d.W = F.wg() + (size_t)e * 4096 * 512; d.K = 4096; d.N = 512; d.kind = 2; d.off = e * 1024; d.W8 = (unsigned char*)WGU; }
            else if ((r -= I_G) < I_G) { d.W = F.wu() + (size_t)e * 4096 * 512; d.K = 4096; d.N = 512; d.kind = 2; d.off = e * 1024 + 128; d.W8 = (unsigned char*)WGU; }
            else { r -= I_G; d.W = F.wd() + (size_t)e * 512 * 4096; d.K = 512; d.N = 4096; d.kind = 3; d.off = e * 4096; d.WT = WD; } }
        const int nblk = (d.N + 31) / 32; d.k0 = 64 * (r / nblk); d.n0 = 32 * (r % nblk); return d; };
    {
        const int it0 = first + w;
        f32x4 raw[8]; TDesc cur = decode(it0 < last ? it0 : first);
        if (it0 < last) t_load(cur, raw, lane);
        for (int it = it0; it < last; it += nw) {
#pragma unroll
            for (int j = 0; j < 8; ++j) { LAS float* q = scr + ((lane >> 3) + 8 * j) * 33 + 4 * (lane & 7); q[0] = raw[j].x; q[1] = raw[j].y; q[2] = raw[j].z; q[3] = raw[j].w; }
            TDesc nxt = cur; const bool more = it + nw < last;
            if (more) { nxt = decode(it + nw); t_load(nxt, raw, lane); }
            LDS_WAIT(); asm volatile("" ::: "memory");
            t_store(cur, scr, lane);
            LDS_WAIT(); asm volatile("" ::: "memory");
            cur = nxt;
        }
    }
}
__device__ __forceinline__ void p0_prologue(Frame& F) {
    const int gw = F.gw, NGW = F.NGW, lane = opaque(F.lane);
    unsigned char* WIN8 = WSP(unsigned char, WS_WIN8);
    convert_items(F, 0, CV_NITEMS - CV_LATE - (F.G == 256 ? CV_MID : 0), gw, NGW);
    for (int i = gw * 64 + lane; i < 144 * 256; i += NGW * 64) *((u32x4*)(WIN8 + (size_t)NIN * 4096) + i) = (u32x4){0u, 0u, 0u, 0u};
    for (int m = gw; m < T; m += NGW) {
        const f32x4* xr = (const f32x4*)(F.x() + (size_t)m * DM) + lane; f32x4 v[16]; float s = 0.f;
#pragma unroll
        for (int j = 0; j < 16; ++j) { v[j] = xr[64 * j]; s += (v[j].x * v[j].x + v[j].y * v[j].y) + (v[j].z * v[j].z + v[j].w * v[j].w); }
        const float rs = rsqrtf(wave_sum(s) * (1.f / DM) + EPS); float am = 0.f;
#pragma unroll
        for (int j = 0; j < 16; ++j) { const f32x4 w = ((const f32x4*)F.mixw())[64 * j + lane]; v[j].x *= rs * w.x; v[j].y *= rs * w.y; v[j].z *= rs * w.z; v[j].w *= rs * w.w;
            am = fmaxf(am, fmaxf(fmaxf(fabsf(v[j].x), fabsf(v[j].y)), fmaxf(fabsf(v[j].z), fabsf(v[j].w)))); }
#pragma unroll
        for (int o = 1; o < 64; o <<= 1) am = fmaxf(am, __shfl_xor(am, o));
        am = fmaxf(am, 1e-30f); const float inv = 127.f / am;
        if (lane == 0) WSP(float, WS_SA)[m] = am * (1.f / 127.f);
        unsigned* q8 = (unsigned*)(WSP(unsigned char, WS_XN8) + (size_t)m * DM) + lane;
#pragma unroll
        for (int j = 0; j < 16; ++j) q8[64 * j] = q4_i8(v[j].x, v[j].y, v[j].z, v[j].w, inv);
    }
    { float* c128 = WSP(float, WS_R128C); float* s128 = WSP(float, WS_R128S); float* c64 = WSP(float, WS_R64C); float* s64 = WSP(float, WS_R64S);
      for (int i = gw * 64 + lane; i < T * 96; i += NGW * 64) { const int t = i / 96, j = i % 96; const bool big = j < 64; const int jj = big ? j : j - 64; const float d = big ? 128.f : 64.f;
          const float inv = exp2f(-(2.f * (float)jj / d) * 13.287712379549449f);
          const float ang = (float)F.pos()[t] * inv;
          const double rev = (double)ang * 0.15915494309189535; const float fr = (float)(rev - floor(rev));
          const float cs = __builtin_amdgcn_cosf(fr), sn = __builtin_amdgcn_sinf(fr);
          if (big) { c128[t * 64 + jj] = cs; s128[t * 64 + jj] = sn; } else { c64[t * 32 + jj] = cs; s64[t * 32 + jj] = sn; } } }
    { bf16* WRF = WSP(bf16, WS_WRF);
      for (int i = gw * 64 + lane; i < 2 * 256 * 64; i += NGW * 64) { const int ln = i & 63, s = (i >> 6) & 255, ct = i >> 14; const int col = ln & 31, hh = ln >> 5;
          float v[8];
#pragma unroll
          for (int j = 0; j < 8; ++j) { const int k = 16 * s + 8 * hh + j; float w = 0.f; if (ct == 0) w = F.wre()[((size_t)(col >> 3) * 4096 + k) * 8 + (col & 7)]; else if (col < 4) w = F.wrg()[(size_t)k * 4 + col]; v[j] = w * F.ffnw()[k]; }
          unsigned hi[4], lo[4];
#pragma unroll
          for (int j = 0; j < 4; ++j) { hi[j] = cvt_pk_bf16(v[2 * j], v[2 * j + 1]); lo[j] = cvt_pk_bf16(v[2 * j] - bflo(hi[j]), v[2 * j + 1] - bfhi(hi[j])); }
          *(u32x4*)(WRF + ((size_t)((ct * 2 + 0) * 256 + s) * 64 + ln) * 8) = (u32x4){hi[0], hi[1], hi[2], hi[3]};
          *(u32x4*)(WRF + ((size_t)((ct * 2 + 1) * 256 + s) * 64 + ln) * 8) = (u32x4){lo[0], lo[1], lo[2], lo[3]}; } }
}

struct EpiProj {
    bf16* P; float* Sm; const float* SA; float sw;
    __device__ __forceinline__ void operator()(const f32x4 (&acc)[2][2][4][2], const pg8::Unit& u, int wr, int wc, int fr, int fq) const {
        int zz; asm volatile("v_mov_b32 %0, 0" : "=v"(zz)); const int row0 = u.pm * 256 + wr * 64 + fr + zz;
        float sc[2][4];
#pragma unroll
        for (int ai = 0; ai < 2; ++ai)
#pragma unroll
            for (int m = 0; m < 4; ++m) sc[ai][m] = SA[row0 + ai * 128 + m * 16] * sw;
        if (u.pn != SMALL_PN) {
            const int col0 = u.pn * 256 + wc * 32 + 8 * fq;
#pragma unroll
            for (int ai = 0; ai < 2; ++ai)
#pragma unroll
                for (int m = 0; m < 4; ++m) { const int row = row0 + ai * 128 + m * 16; bf16* rowp = P + (size_t)row * LDP + col0;
#pragma unroll
                    for (int bj = 0; bj < 2; ++bj) { const f32x4 v0 = acc[ai][bj][m][0] * sc[ai][m], v1 = acc[ai][bj][m][1] * sc[ai][m];
                        u32x4 w; w.x = cvt_pk_bf16(v0[0], v0[1]); w.y = cvt_pk_bf16(v0[2], v0[3]); w.z = cvt_pk_bf16(v1[0], v1[1]); w.w = cvt_pk_bf16(v1[2], v1[3]);
                        *(u32x4*)(rowp + bj * 128) = w; } }
        } else {
            const int col0 = wc * 32 + 8 * fq;
#pragma unroll
            for (int ai = 0; ai < 2; ++ai)
#pragma unroll
                for (int m = 0; m < 4; ++m) { const int row = row0 + ai * 128 + m * 16; float* rowp = Sm + (size_t)row * LDSM + col0;
#pragma unroll
                    for (int bj = 0; bj < 2; ++bj) { *(f32x4*)(rowp + bj * 128) = acc[ai][bj][m][0] * sc[ai][m]; *(f32x4*)(rowp + bj * 128 + 4) = acc[ai][bj][m][1] * sc[ai][m]; } }
        }
    }
};
template <bool ADD> struct EpiGate {
    bf16* O; const bf16* P; int gcol; unsigned char* O8;
    __device__ __forceinline__ void operator()(const f32x4 (&acc)[2][2][4][2], const pg8::Unit& u, int wr, int wc, int fr, int fq) const {
        int zz; asm volatile("v_mov_b32 %0, 0" : "=v"(zz)); const int row0 = u.pm * 256 + wr * 64 + fr + zz, col0 = u.pn * 256 + wc * 32 + 8 * fq;
#pragma unroll
        for (int hq = 0; hq < 4; ++hq) { const int ai = hq >> 1, mb = (hq & 1) * 2;
            u32x4 g[2][2], pv[2][2];
#pragma unroll
            for (int mm = 0; mm < 2; ++mm)
#pragma unroll
                for (int bj = 0; bj < 2; ++bj) { const size_t row = (size_t)(row0 + ai * 128 + (mb + mm) * 16); g[mm][bj] = *(const u32x4*)(P + row * LDP + gcol + col0 + bj * 128);
                    if constexpr (ADD) pv[mm][bj] = *(const u32x4*)(O + row * DM + col0 + bj * 128); }
#pragma unroll
            for (int mm = 0; mm < 2; ++mm) { const int m = mb + mm; const size_t row = (size_t)(row0 + ai * 128 + m * 16);
#pragma unroll
                for (int bj = 0; bj < 2; ++bj) { const u32x4 gg = g[mm][bj];
                    const f32x4 v0 = acc[ai][bj][m][0], v1 = acc[ai][bj][m][1];
                    float r[8] = {v0[0] * sigmoidf_(bflo(gg.x)), v0[1] * sigmoidf_(bfhi(gg.x)), v0[2] * sigmoidf_(bflo(gg.y)), v0[3] * sigmoidf_(bfhi(gg.y)),
                                  v1[0] * sigmoidf_(bflo(gg.z)), v1[1] * sigmoidf_(bfhi(gg.z)), v1[2] * sigmoidf_(bflo(gg.w)), v1[3] * sigmoidf_(bfhi(gg.w))};
                    if constexpr (ADD) { const u32x4 p = pv[mm][bj]; r[0] += bflo(p.x); r[1] += bfhi(p.x); r[2] += bflo(p.y); r[3] += bfhi(p.y); r[4] += bflo(p.z); r[5] += bfhi(p.z); r[6] += bflo(p.w); r[7] += bfhi(p.w);
                        unsigned w0 = 0u, w1 = 0u;
                        w0 = cvt2_fp8(r[0] * 32.f, r[1] * 32.f, w0, false); w0 = cvt2_fp8(r[2] * 32.f, r[3] * 32.f, w0, true);
                        w1 = cvt2_fp8(r[4] * 32.f, r[5] * 32.f, w1, false); w1 = cvt2_fp8(r[6] * 32.f, r[7] * 32.f, w1, true);
                        *(u32x2*)(O8 + row * DM + col0 + bj * 128) = (u32x2){w0, w1}; }
                    else { u32x4 w; w.x = cvt_pk_bf16(r[0], r[1]); w.y = cvt_pk_bf16(r[2], r[3]); w.z = cvt_pk_bf16(r[4], r[5]); w.w = cvt_pk_bf16(r[6], r[7]);
                        *(u32x4*)(O + row * DM + col0 + bj * 128) = w; } } }
        }
    }
};
struct EpiRes {
    bf16* O; const float* R;
    __device__ __forceinline__ void operator()(const f32x4 (&acc)[2][2][4][2], const pg8::Unit& u, int wr, int wc, int fr, int fq) const {
        int zz; asm volatile("v_mov_b32 %0, 0" : "=v"(zz)); const int row0 = u.pm * 256 + wr * 64 + fr + zz, col0 = u.pn * 256 + wc * 32 + 8 * fq;
#pragma unroll
        for (int ai = 0; ai < 2; ++ai) {
            f32x4 rv[4][2][2];
#pragma unroll
            for (int m = 0; m < 4; ++m)
#pragma unroll
                for (int bj = 0; bj < 2; ++bj) { const size_t off = (size_t)(row0 + ai * 128 + m * 16) * DM + col0 + bj * 128; rv[m][bj][0] = *(const f32x4*)(R + off); rv[m][bj][1] = *(const f32x4*)(R + off + 4); }
#pragma unroll
            for (int m = 0; m < 4; ++m)
#pragma unroll
                for (int bj = 0; bj < 2; ++bj) { const size_t off = (size_t)(row0 + ai * 128 + m * 16) * DM + col0 + bj * 128;
                    const f32x4 v0 = rv[m][bj][0] + acc[ai][bj][m][0], v1 = rv[m][bj][1] + acc[ai][bj][m][1];
                    *(u32x4*)(O + off) = (u32x4){cvt_pk_bf16(v0[0], v0[1]), cvt_pk_bf16(v0[2], v0[3]), cvt_pk_bf16(v1[0], v1[1]), cvt_pk_bf16(v1[2], v1[3])}; }
        }
    }
};

template <int K>
__device__ __forceinline__ f32x16 mma32(f32x16 acc, const LAS bf16* A, int lda, const LAS bf16* Bt, int ldb, int r, int hh) {
    const LAS bf16* ap = A + r * lda + 8 * hh; const LAS bf16* bp = Bt + r * ldb + 8 * hh;
#pragma unroll
    for (int k0 = 0; k0 < K; k0 += 16) { const bf16x8 a = *(const LAS bf16x8*)(ap + k0); const bf16x8 b = *(const LAS bf16x8*)(bp + k0); acc = __builtin_amdgcn_mfma_f32_32x32x16_bf16(a, b, acc, 0, 0, 0); }
    return acc;
}
__device__ __forceinline__ u32x4 pack8(const f32x16& a, int b0) { u32x4 w; w.x = cvt_pk_bf16(a[b0 + 0], a[b0 + 1]); w.y = cvt_pk_bf16(a[b0 + 2], a[b0 + 3]); w.z = cvt_pk_bf16(a[b0 + 4], a[b0 + 5]); w.w = cvt_pk_bf16(a[b0 + 6], a[b0 + 7]); return w; }
__device__ __forceinline__ void unpack8(f32x16& a, int b0, const u32x4 w) { a[b0 + 0] = bflo(w.x); a[b0 + 1] = bfhi(w.x); a[b0 + 2] = bflo(w.y); a[b0 + 3] = bfhi(w.y); a[b0 + 4] = bflo(w.z); a[b0 + 5] = bfhi(w.z); a[b0 + 6] = bflo(w.w); a[b0 + 7] = bfhi(w.w); }

__device__ __forceinline__ void p2_post_token(Frame& F, int tok) {
    const int lane = opaque(F.lane); const int b = tok / SEQ, s = tok % SEQ;
    const bf16* P = WSP(bf16, WS_PROJ) + (size_t)tok * LDP;
    const float* rc = WSP(float, WS_R128C) + (size_t)tok * 64; const float* rs = WSP(float, WS_R128S) + (size_t)tok * 64;
#pragma unroll
    for (int pass = 0; pass < 2; ++pass) {
        if (pass == 1 && lane >= 16) break;
        const int head = lane >> 2, sub = lane & 3;
        const bf16* src = P + (pass ? C_AK : C_AQ) + head * 128 + 16 * sub;
        const float* nw = pass ? F.knw() : F.qnw();
        const u32x4 a0 = *(const u32x4*)src, a1 = *(const u32x4*)(src + 8), b0 = *(const u32x4*)(src + 64), b1 = *(const u32x4*)(src + 72);
        float x1[16], x2[16];
        { const unsigned wa[8] = {a0.x, a0.y, a0.z, a0.w, a1.x, a1.y, a1.z, a1.w}, wb[8] = {b0.x, b0.y, b0.z, b0.w, b1.x, b1.y, b1.z, b1.w};
#pragma unroll
          for (int j = 0; j < 8; ++j) { x1[2 * j] = bflo(wa[j]); x1[2 * j + 1] = bfhi(wa[j]); x2[2 * j] = bflo(wb[j]); x2[2 * j + 1] = bfhi(wb[j]); } }
        float ss = 0.f;
#pragma unroll
        for (int e = 0; e < 16; ++e) ss += x1[e] * x1[e] + x2[e] * x2[e];
        ss += __shfl_xor(ss, 1); ss += __shfl_xor(ss, 2);
        const float rinv = rsqrtf(ss * (1.f / 128.f) + EPS);
        unsigned o1[8], o2[8];
#pragma unroll
        for (int e = 0; e < 16; e += 2) {
            float r1[2], r2[2];
#pragma unroll
            for (int q = 0; q < 2; ++q) { const int d = 16 * sub + e + q; const float c = rc[d], sn = rs[d]; const float y1 = x1[e + q] * rinv * nw[d], y2 = x2[e + q] * rinv * nw[d + 64];
                r1[q] = y1 * c - y2 * sn; r2[q] = y2 * c + y1 * sn; }
            o1[e >> 1] = cvt_pk_bf16(r1[0], r1[1]); o2[e >> 1] = cvt_pk_bf16(r2[0], r2[1]);
        }
        bf16* dst = pass ? (WSP(bf16, WS_KB) + ((size_t)(b * 4 + head) * SEQ + s) * 128 + 16 * sub) : (WSP(bf16, WS_QB) + ((size_t)(b * 16 + head) * SEQ + s) * 128 + 16 * sub);
        *(u32x4*)dst = (u32x4){o1[0], o1[1], o1[2], o1[3]}; *(u32x4*)(dst + 8) = (u32x4){o1[4], o1[5], o1[6], o1[7]};
        *(u32x4*)(dst + 64) = (u32x4){o2[0], o2[1], o2[2], o2[3]}; *(u32x4*)(dst + 72) = (u32x4){o2[4], o2[5], o2[6], o2[7]};
    }
    if (lane < 8) {
        const float* sm = WSP(float, WS_SMALL) + (size_t)tok * LDSM + SM_IK;
        const f32x4 a = *(const f32x4*)(sm + 4 * lane), c = *(const f32x4*)(sm + 32 + 4 * lane);
        float ss = (a.x * a.x + a.y * a.y) + (a.z * a.z + a.w * a.w) + (c.x * c.x + c.y * c.y) + (c.z * c.z + c.w * c.w);
        ss += __shfl_xor(ss, 1); ss += __shfl_xor(ss, 2); ss += __shfl_xor(ss, 4);
        const float rinv = rsqrtf(ss * (1.f / 64.f) + EPS);
        const float* r64c = WSP(float, WS_R64C) + (size_t)tok * 32 + 4 * lane; const float* r64s = WSP(float, WS_R64S) + (size_t)tok * 32 + 4 * lane;
        float r1[4], r2[4];
#pragma unroll
        for (int e = 0; e < 4; ++e) { const float y1 = a[e] * rinv * F.iknw()[4 * lane + e], y2 = c[e] * rinv * F.iknw()[32 + 4 * lane + e]; const float cs = r64c[e], sn = r64s[e]; r1[e] = y1 * cs - y2 * sn; r2[e] = y2 * cs + y1 * sn; }
        const int tile = s >> 5, cc = s & 31, p = lane >> 1;
        bf16* base = WSP(bf16, WS_IKF);
        { const int ks = p >> 1, hf = p & 1; *(u32x2*)(base + ((size_t)((b * 128 + tile) * 4 + ks) * 64 + hf * 32 + cc) * 8 + 4 * (lane & 1)) = (u32x2){cvt_pk_bf16(r1[0], r1[1]), cvt_pk_bf16(r1[2], r1[3])}; }
        { const int ks = (p >> 1) + 2, hf = p & 1; *(u32x2*)(base + ((size_t)((b * 128 + tile) * 4 + ks) * 64 + hf * 32 + cc) * 8 + 4 * (lane & 1)) = (u32x2){cvt_pk_bf16(r2[0], r2[1]), cvt_pk_bf16(r2[2], r2[3])}; }
    }
}

constexpr int G_QH = 0, G_KH = 17408, G_VBT = 35840, G_KBT = 54272, G_KDT = 72704, G_L = 91136, G_TM = 109568, G_IN = 118784, G_SM = 128000;
constexpr int G_WT = G_KH, G_UT = G_L;
constexpr int G_CW = 135168;
__device__ __forceinline__ void gdn_chunk(Frame& F, int cid, const int gm = 9) {
    const int lane = opaque(F.lane), wid = F.wave, tid = wid * 64 + lane, r = lane & 31, hh = lane >> 5;
    const int b = cid >> 10, h = (cid >> 6) & 15, n = cid & 63, t0 = n * 64, row0 = b * SEQ + t0;
    LAS bf16* Qh = (LAS bf16*)(F.lds + G_QH); LAS bf16* Kh = (LAS bf16*)(F.lds + G_KH); LAS bf16* VbT = (LAS bf16*)(F.lds + G_VBT); LAS bf16* KbT = (LAS bf16*)(F.lds + G_KBT);
    LAS bf16* KdT = (LAS bf16*)(F.lds + G_KDT); LAS float* Lf = (LAS float*)(F.lds + G_L); LAS bf16* Tm = (LAS bf16*)(F.lds + G_TM); LAS bf16* In = (LAS bf16*)(F.lds + G_IN);
    LAS bf16* WT = (LAS bf16*)(F.lds + G_WT); LAS bf16* UT = (LAS bf16*)(F.lds + G_UT);
    LAS bf16* Vh = (LAS bf16*)(F.lds + G_L);
    LAS bf16* T11t = (LAS bf16*)(F.lds + G_KH); LAS bf16* Xt = T11t + 32 * 40;
    LAS float* sm_gc = (LAS float*)(F.lds + G_SM); LAS float* sm_beta = sm_gc + 64; LAS float* sm_eg = sm_gc + 128; LAS float* sm_ed = sm_gc + 192;
    const bf16* PROJ = WSP(bf16, WS_PROJ); const float* SMALL = WSP(float, WS_SMALL);
    const int rr = tid >> 3, c0 = 16 * (tid & 7);
    u32x4 raw[3][4][2];
#pragma unroll
    for (int tz = 0; tz < 3; ++tz)
#pragma unroll
        for (int m = 0; m < 4; ++m) { const int trow = t0 + rr - 3 + m; const int tr = trow < 0 ? 0 : trow;
            const bf16* src = PROJ + (size_t)(b * SEQ + tr) * LDP + (tz == 0 ? C_GQ : tz == 1 ? C_GK : C_GV) + h * 128 + c0;
            raw[tz][m][0] = *(const u32x4*)src; raw[tz][m][1] = *(const u32x4*)(src + 8); }
    if (wid == 0) {
        const float a = SMALL[(size_t)(row0 + lane) * LDSM + SM_GA + h], bb = SMALL[(size_t)(row0 + lane) * LDSM + SM_GB + h];
        const float xx = a + F.dtb()[h]; const float sp = xx > 20.f ? xx : log1pf(__expf(xx));
        float gc = -__expf(F.alog()[h]) * sp;
#pragma unroll
        for (int o = 1; o < 64; o <<= 1) { const float v = __shfl_up(gc, o); if (lane >= o) gc += v; }
        const float Gl = __shfl(gc, 63);
        sm_gc[lane] = gc; sm_beta[lane] = sigmoidf_(bb); sm_eg[lane] = __expf(gc); sm_ed[lane] = __expf(Gl - gc);
        if (lane == 0) WSP(float, WS_GG)[cid] = __expf(Gl);
    }
    __syncthreads();
    {
        const LAS float* CW = (const LAS float*)(F.lds + G_CW);
#pragma unroll
        for (int tz = 0; tz < 3; ++tz) {
            float y[16];
#pragma unroll
            for (int e = 0; e < 16; ++e) y[e] = 0.f;
#pragma unroll
            for (int m = 0; m < 4; ++m) {
                const float on = (t0 + rr - 3 + m) >= 0 ? 1.f : 0.f;
                const LAS float* cw = CW + (tz * 4 + m) * 128 + c0;
                const f32x4 w0 = *(const LAS f32x4*)cw * on, w1 = *(const LAS f32x4*)(cw + 4) * on, w2 = *(const LAS f32x4*)(cw + 8) * on, w3 = *(const LAS f32x4*)(cw + 12) * on;
                const u32x4 a0 = raw[tz][m][0], a1 = raw[tz][m][1];
                y[0] += w0.x * bflo(a0.x); y[1] += w0.y * bfhi(a0.x); y[2] += w0.z * bflo(a0.y); y[3] += w0.w * bfhi(a0.y);
                y[4] += w1.x * bflo(a0.z); y[5] += w1.y * bfhi(a0.z); y[6] += w1.z * bflo(a0.w); y[7] += w1.w * bfhi(a0.w);
                y[8] += w2.x * bflo(a1.x); y[9] += w2.y * bfhi(a1.x); y[10] += w2.z * bflo(a1.y); y[11] += w2.w * bfhi(a1.y);
                y[12] += w3.x * bflo(a1.z); y[13] += w3.y * bfhi(a1.z); y[14] += w3.z * bflo(a1.w); y[15] += w3.w * bfhi(a1.w);
            }
            float ss = 0.f;
#pragma unroll
            for (int e = 0; e < 16; ++e) { y[e] = y[e] * sigmoidf_(y[e]); ss += y[e] * y[e]; }
            if (tz < 2) { ss += __shfl_xor(ss, 1); ss += __shfl_xor(ss, 2); ss += __shfl_xor(ss, 4); const float rinv = rsqrtf(ss + EPS) * (tz == 0 ? 0.08838834764831845f : 1.f);
#pragma unroll
                for (int e = 0; e < 16; ++e) y[e] *= rinv; }
            LAS bf16* d = (tz == 0 ? Qh : tz == 1 ? Kh : Vh) + rr * 136 + c0;
            *(LAS u32x4*)d = (u32x4){cvt_pk_bf16(y[0], y[1]), cvt_pk_bf16(y[2], y[3]), cvt_pk_bf16(y[4], y[5]), cvt_pk_bf16(y[6], y[7])};
            *(LAS u32x4*)(d + 8) = (u32x4){cvt_pk_bf16(y[8], y[9]), cvt_pk_bf16(y[10], y[11]), cvt_pk_bf16(y[12], y[13]), cvt_pk_bf16(y[14], y[15])};
        }
    }
    __syncthreads();
    if (gm == 1) return;
    {
        const int i = lane, c0 = 16 * wid; const float beta = sm_beta[i], eg = sm_eg[i], ed = sm_ed[i];
        const u32x4 k0 = *(const LAS u32x4*)(Kh + i * 136 + c0), k1 = *(const LAS u32x4*)(Kh + i * 136 + c0 + 8), v0 = *(const LAS u32x4*)(Vh + i * 136 + c0), v1 = *(const LAS u32x4*)(Vh + i * 136 + c0 + 8);
        const unsigned kw[8] = {k0.x, k0.y, k0.z, k0.w, k1.x, k1.y, k1.z, k1.w}, vw[8] = {v0.x, v0.y, v0.z, v0.w, v1.x, v1.y, v1.z, v1.w};
#pragma unroll
        for (int q = 0; q < 8; ++q) { const float ka = bflo(kw[q]), kb = bfhi(kw[q]), va = bflo(vw[q]), vb = bfhi(vw[q]);
            KbT[(c0 + 2 * q) * 72 + i] = f2bf(ka * beta * eg); KbT[(c0 + 2 * q + 1) * 72 + i] = f2bf(kb * beta * eg);
            KdT[(c0 + 2 * q) * 72 + i] = f2bf(ka * ed); KdT[(c0 + 2 * q + 1) * 72 + i] = f2bf(kb * ed);
            VbT[(c0 + 2 * q) * 72 + i] = f2bf(va * beta); VbT[(c0 + 2 * q + 1) * 72 + i] = f2bf(vb * beta); }
    }
    __syncthreads();
    if (gm == 2) return;
    if (wid < 6) {
        const int which = wid / 3, ti = wid % 3, a = ti ? 1 : 0, bt = ti == 2 ? 1 : 0;
        f32x16 acc = {};
        acc = mma32<128>(acc, (which ? Qh : Kh) + 32 * a * 136, 136, Kh + 32 * bt * 136, 136, r, hh);
        const int j = 32 * bt + r; const float gcj = sm_gc[j];
#pragma unroll
        for (int i = 0; i < 16; ++i) { const int ii = 32 * a + crow(i, hh); const float dec = __expf(sm_gc[ii] - gcj);
            if (which == 0) Lf[ii * 72 + j] = (ii > j) ? sm_beta[ii] * acc[i] * dec : 0.f;
            else In[ii * 72 + j] = f2bf((ii >= j) ? acc[i] * dec : 0.f); }
    } else if (wid == 6) {
#pragma unroll
        for (int i = 0; i < 16; ++i) In[(2 * i + hh) * 72 + 32 + r] = 0;
    }
    __syncthreads();
    if (gm == 3) return;
    if (wid == 0) {
        const int hb = lane >> 5, cc = lane & 31;
        int zoff; asm volatile("v_mov_b32 %0, 0" : "=v"(zoff));
        const LAS float* Ld = Lf + (32 * hb) * 72 + 32 * hb + zoff;
        float x[32];
#pragma unroll
        for (int i = 0; i < 32; ++i) {
            float v = (i == cc) ? 1.f : 0.f;
#pragma unroll
            for (int j4 = 0; j4 < i; j4 += 4) { const f32x4 l4 = *(const LAS f32x4*)(Ld + i * 72 + j4);
                v -= l4.x * x[j4]; if (j4 + 1 < i) v -= l4.y * x[j4 + 1]; if (j4 + 2 < i) v -= l4.z * x[j4 + 2]; if (j4 + 3 < i) v -= l4.w * x[j4 + 3]; }
            x[i] = v; Tm[(32 * hb + i) * 72 + 32 * hb + cc] = f2bf(v);
            if (hb == 0) Tm[i * 72 + 32 + cc] = 0;
        }
        if (hb == 0) {
#pragma unroll
            for (int q = 0; q < 4; ++q) *(LAS u32x4*)(T11t + cc * 40 + 8 * q) = (u32x4){cvt_pk_bf16(x[8 * q], x[8 * q + 1]), cvt_pk_bf16(x[8 * q + 2], x[8 * q + 3]), cvt_pk_bf16(x[8 * q + 4], x[8 * q + 5]), cvt_pk_bf16(x[8 * q + 6], x[8 * q + 7])}; }
        f32x16 X = {};
#pragma unroll
        for (int ks = 0; ks < 2; ++ks) { const LAS float* lp = Lf + (32 + r) * 72 + 16 * ks + 8 * hh; const f32x4 l0 = *(const LAS f32x4*)lp, l1 = *(const LAS f32x4*)(lp + 4);
            const u32x4 aw = {cvt_pk_bf16(l0.x, l0.y), cvt_pk_bf16(l0.z, l0.w), cvt_pk_bf16(l1.x, l1.y), cvt_pk_bf16(l1.z, l1.w)};
            const bf16x8 bb = *(const LAS bf16x8*)(T11t + r * 40 + 16 * ks + 8 * hh);
            X = __builtin_amdgcn_mfma_f32_32x32x16_bf16(*(const bf16x8*)&aw, bb, X, 0, 0, 0); }
#pragma unroll
        for (int g = 0; g < 4; ++g) *(LAS u32x2*)(Xt + r * 40 + 8 * g + 4 * hh) = (u32x2){cvt_pk_bf16(X[4 * g], X[4 * g + 1]), cvt_pk_bf16(X[4 * g + 2], X[4 * g + 3])};
        f32x16 Y = {};
#pragma unroll
        for (int ks = 0; ks < 2; ++ks) { const bf16x8 aa = *(const LAS bf16x8*)(Tm + (32 + r) * 72 + 32 + 16 * ks + 8 * hh); const bf16x8 bb = *(const LAS bf16x8*)(Xt + r * 40 + 16 * ks + 8 * hh);
            Y = __builtin_amdgcn_mfma_f32_32x32x16_bf16(aa, bb, Y, 0, 0, 0); }
#pragma unroll
        for (int i = 0; i < 16; ++i) Tm[(32 + crow(i, hh)) * 72 + r] = f2bf(-Y[i]);
    }
    __syncthreads();
    if (gm == 4) return;
#ifdef DBG_G1
    {
        u32x4* GQd = WSP(u32x4, WS_GQ) + (size_t)cid * 1024; u32x4* GOd = WSP(u32x4, WS_GO) + (size_t)cid * 1024;
        const int row = tid >> 3, c8 = (tid & 7) * 8;
        GQd[tid] = *(const LAS u32x4*)((LAS bf16*)(F.lds + DBG_G1_A) + row * 72 + c8); GOd[tid] = *(const LAS u32x4*)((LAS bf16*)(F.lds + DBG_G1_B) + row * 72 + c8);
        GQd[512 + tid] = (u32x4){0u, 0u, 0u, 0u}; GOd[512 + tid] = (u32x4){0u, 0u, 0u, 0u};
        __syncthreads(); return;
    }
#endif
#pragma unroll
    for (int q = 0; q < 2; ++q) { const int idx = 2 * wid + q, which = idx >> 3, a = (idx >> 2) & 1, bt = idx & 3;
        f32x16 acc = {};
        acc = mma32<64>(acc, Tm + 32 * a * 72, 72, (which ? KbT : VbT) + 32 * bt * 72, 72, r, hh);
        LAS bf16* dst = (which ? WT : UT) + (32 * bt + r) * 72 + 32 * a + 4 * hh;
#pragma unroll
        for (int g = 0; g < 4; ++g) *(LAS u32x2*)(dst + 8 * g) = (u32x2){cvt_pk_bf16(acc[4 * g], acc[4 * g + 1]), cvt_pk_bf16(acc[4 * g + 2], acc[4 * g + 3])};
    }
    __syncthreads();
    if (gm == 5) return;
    {
        u32x4* GP = (u32x4*)F.out + (size_t)cid * 2048;
        u32x4* GB = (u32x4*)((unsigned char*)F.out + 128 * MiB) + (size_t)cid * 2048;
        u32x4* GQ = WSP(u32x4, WS_GQ) + (size_t)cid * 1024;
        u32x4* GO = WSP(u32x4, WS_GO) + (size_t)cid * 1024;
#pragma unroll
        for (int q = 0; q < 2; ++q) { const int idx = 2 * wid + q, a = idx >> 2, bt = idx & 3;
            { f32x16 acc = {}; acc = mma32<64>(acc, WT + 32 * a * 72, 72, KdT + 32 * bt * 72, 72, r, hh);
#pragma unroll
              for (int i = 0; i < 16; ++i) acc[i] = -acc[i];
              GP[(bt * 8 + 2 * a) * 64 + lane] = pack8(acc, 0); GP[(bt * 8 + 2 * a + 1) * 64 + lane] = pack8(acc, 8); }
            { f32x16 acc = {}; acc = mma32<64>(acc, KdT + 32 * a * 72, 72, UT + 32 * bt * 72, 72, r, hh);
              GB[((bt * 4 + a) * 2) * 64 + lane] = pack8(acc, 0); GB[((bt * 4 + a) * 2 + 1) * 64 + lane] = pack8(acc, 8); }
        }
        { const int a = wid >> 1, bt = wid & 1;
          f32x16 acc = {}; acc = mma32<64>(acc, WT + 32 * a * 72, 72, In + 32 * bt * 72, 72, r, hh);
          const int ii = 32 * bt + r; const float eg = sm_eg[ii];
#pragma unroll
          for (int g = 0; g < 4; ++g) { const u32x2 qv = *(const LAS u32x2*)(Qh + ii * 136 + 32 * a + 8 * g + 4 * hh);
              acc[4 * g] = bflo(qv.x) * eg - acc[4 * g]; acc[4 * g + 1] = bfhi(qv.x) * eg - acc[4 * g + 1]; acc[4 * g + 2] = bflo(qv.y) * eg - acc[4 * g + 2]; acc[4 * g + 3] = bfhi(qv.y) * eg - acc[4 * g + 3]; }
          GQ[(bt * 8 + 2 * a) * 64 + lane] = pack8(acc, 0); GQ[(bt * 8 + 2 * a + 1) * 64 + lane] = pack8(acc, 8); }
        { const int a = wid >> 2, bt = wid & 3;
          f32x16 acc = {}; acc = mma32<64>(acc, In + 32 * a * 72, 72, UT + 32 * bt * 72, 72, r, hh);
          GO[((bt * 2 + a) * 2) * 64 + lane] = pack8(acc, 0); GO[((bt * 2 + a) * 2 + 1) * 64 + lane] = pack8(acc, 8); }
    }
    LDS_BARRIER();
}

__device__ __forceinline__ void gdn_scan_wg(Frame& F, int bh, int half) {
    const int lane = opaque(F.lane), wid = F.wave, r = lane & 31, hh = lane >> 5, grp = wid >> 2, a = wid & 3, slice = 2 * half + grp; const int b = bh >> 4, h = bh & 15;
    LAS u32x4* SB = (LAS u32x4*)F.lds + grp * 1024;
    const float* GG = WSP(float, WS_GG); bf16* OSC = WSP(bf16, WS_OSC);
    const u32x4* GPb = (const u32x4*)F.out + (size_t)bh * 64 * 2048 + (a * 8) * 64 + lane;
    const u32x4* GBb = (const u32x4*)((unsigned char*)F.out + 128 * MiB) + (size_t)bh * 64 * 2048 + slice * 512 + (a * 2) * 64 + lane;
    const u32x4* GQb = WSP(u32x4, WS_GQ) + (size_t)bh * 64 * 1024 + ((a & 1) * 8) * 64 + lane;
    const u32x4* GOb = WSP(u32x4, WS_GO) + (size_t)bh * 64 * 1024 + slice * 256 + ((a & 1) * 2) * 64 + lane;
    f32x16 S = {};
    u32x4 Pv[8], Bv[2], Qv[8], Ov[2]; float gam;
#pragma unroll
    for (int s = 0; s < 8; ++s) Pv[s] = GPb[s * 64];
    Bv[0] = GBb[0]; Bv[1] = GBb[64]; gam = GG[bh * 64];
    if (a < 2) {
#pragma unroll
        for (int s = 0; s < 8; ++s) Qv[s] = GQb[s * 64];
        Ov[0] = GOb[0]; Ov[1] = GOb[64]; }
    for (int n = 0; n < 64; ++n) {
        LAS u32x4* sb = SB + (n & 1) * 512;
        sb[(2 * a) * 64 + lane] = pack8(S, 0); sb[(2 * a + 1) * 64 + lane] = pack8(S, 8);
        asm volatile("s_waitcnt lgkmcnt(0)" ::: "memory"); __builtin_amdgcn_s_barrier(); asm volatile("" ::: "memory");
        u32x4 sf[8];
#pragma unroll
        for (int s = 0; s < 8; ++s) sf[s] = sb[s * 64 + lane];
        f32x16 c; unpack8(c, 0, Bv[0]); unpack8(c, 8, Bv[1]);
#pragma unroll
        for (int i = 0; i < 16; ++i) c[i] += gam * S[i];
#pragma unroll
        for (int s = 0; s < 8; ++s) c = __builtin_amdgcn_mfma_f32_32x32x16_bf16(*(const bf16x8*)&Pv[s], *(const bf16x8*)&sf[s], c, 0, 0, 0);
        S = c;
        if (n + 1 < 64) { const size_t o1 = (size_t)(n + 1) * 2048;
#pragma unroll
            for (int s = 0; s < 8; ++s) Pv[s] = GPb[o1 + s * 64];
            Bv[0] = GBb[o1]; Bv[1] = GBb[o1 + 64]; gam = GG[bh * 64 + n + 1]; }
        if (a < 2) {
            f32x16 o; unpack8(o, 0, Ov[0]); unpack8(o, 8, Ov[1]);
#pragma unroll
            for (int s = 0; s < 8; ++s) o = __builtin_amdgcn_mfma_f32_32x32x16_bf16(*(const bf16x8*)&Qv[s], *(const bf16x8*)&sf[s], o, 0, 0, 0);
            if (n + 1 < 64) { const size_t o2 = (size_t)(n + 1) * 1024;
#pragma unroll
                for (int s = 0; s < 8; ++s) Qv[s] = GQb[o2 + s * 64];
                Ov[0] = GOb[o2]; Ov[1] = GOb[o2 + 64]; }
            bf16* op = OSC + (size_t)(b * SEQ + n * 64 + 32 * a) * 2048 + h * 128 + 32 * slice + r;
#pragma unroll
            for (int i = 0; i < 16; ++i) op[(size_t)crow(i, hh) * 2048] = f2bf(o[i]);
        }
    }
    __syncthreads();
}

__device__ __forceinline__ void ya_to_fp8_token(Frame& F, int tok) {
    const int lane = opaque(F.lane);
    const bf16* src = WSP(bf16, WS_YA) + (size_t)tok * 2048 + 32 * lane;
    unsigned char* dst = WSP(unsigned char, WS_YA8) + (size_t)tok * 2048 + 32 * lane;
    unsigned o[8];
#pragma unroll
    for (int q = 0; q < 4; ++q) { const u32x4 a = *(const u32x4*)(src + 8 * q);
        unsigned w0 = 0u, w1 = 0u;
        w0 = cvt2_fp8(bflo(a.x) * 32.f, bfhi(a.x) * 32.f, w0, false); w0 = cvt2_fp8(bflo(a.y) * 32.f, bfhi(a.y) * 32.f, w0, true);
        w1 = cvt2_fp8(bflo(a.z) * 32.f, bfhi(a.z) * 32.f, w1, false); w1 = cvt2_fp8(bflo(a.w) * 32.f, bfhi(a.w) * 32.f, w1, true);
        o[2 * q] = w0; o[2 * q + 1] = w1; }
    *(u32x4*)dst = (u32x4){o[0], o[1], o[2], o[3]}; *(u32x4*)(dst + 16) = (u32x4){o[4], o[5], o[6], o[7]};
}
__device__ __forceinline__ void gdn_norm_token(Frame& F, int tok) {
    const int lane = opaque(F.lane), head = lane >> 2, sub = lane & 3;
    bf16* o = WSP(bf16, WS_OSC) + (size_t)tok * 2048 + head * 128 + 32 * sub;
    const bf16* z = WSP(bf16, WS_PROJ) + (size_t)tok * LDP + C_GZ + head * 128 + 32 * sub;
    float v[32], zz[32]; float ss = 0.f;
#pragma unroll
    for (int q = 0; q < 4; ++q) { const u32x4 a = *(const u32x4*)(o + 8 * q), c = *(const u32x4*)(z + 8 * q); const unsigned wa[4] = {a.x, a.y, a.z, a.w}, wc[4] = {c.x, c.y, c.z, c.w};
#pragma unroll
        for (int j = 0; j < 4; ++j) { v[8 * q + 2 * j] = bflo(wa[j]); v[8 * q + 2 * j + 1] = bfhi(wa[j]); zz[8 * q + 2 * j] = bflo(wc[j]); zz[8 * q + 2 * j + 1] = bfhi(wc[j]); } }
#pragma unroll
    for (int e = 0; e < 32; ++e) ss += v[e] * v[e];
    ss += __shfl_xor(ss, 1); ss += __shfl_xor(ss, 2);
    const float rinv = rsqrtf(ss * (1.f / 128.f) + EPS);
#pragma unroll
    for (int q = 0; q < 4; ++q) { unsigned w[4];
#pragma unroll
        for (int j = 0; j < 4; ++j) { const int e = 8 * q + 2 * j; const float y0 = v[e] * rinv * F.gnw()[32 * sub + e] * (zz[e] * sigmoidf_(zz[e])), y1 = v[e + 1] * rinv * F.gnw()[32 * sub + e + 1] * (zz[e + 1] * sigmoidf_(zz[e + 1])); w[j] = cvt2_fp8(y0 * 8.f, y1 * 8.f, 0u, false) & 0xffffu; }
        *(u32x2*)((unsigned char*)F.out + (size_t)tok * 2048 + head * 128 + 32 * sub + 8 * q) = (u32x2){w[0] | (w[1] << 16), w[2] | (w[3] << 16)}; }
}

__device__ __forceinline__ unsigned lt1(unsigned cand, unsigned key) { unsigned d; asm("v_sub_u32 %0, %1, %2 clamp\n\tv_min_u32 %0, 1, %0" : "=v"(d) : "v"(cand), "v"(key)); return d; }
__device__ __forceinline__ float relu1(float x) { const int b = __float_as_int(x); return __int_as_float(b > 0 ? b : 0); }
__device__ __forceinline__ unsigned lt1pk(unsigned cand2, unsigned key2, unsigned one2) { unsigned d; asm("v_pk_sub_u16 %0, %1, %2 clamp\n\tv_pk_min_u16 %0, %0, %3" : "=&v"(d) : "v"(cand2), "v"(key2), "v"(one2)); return d; }
__device__ __forceinline__ int wave_sum_dpp(int v) {
    v += __builtin_amdgcn_update_dpp(0, v, 0x111, 0xf, 0xf, true);
    v += __builtin_amdgcn_update_dpp(0, v, 0x112, 0xf, 0xf, true);
    v += __builtin_amdgcn_update_dpp(0, v, 0x114, 0xf, 0xf, true);
    v += __builtin_amdgcn_update_dpp(0, v, 0x118, 0xf, 0xf, true);
    v += __builtin_amdgcn_update_dpp(0, v, 0x142, 0xa, 0xf, true);
    v += __builtin_amdgcn_update_dpp(0, v, 0x143, 0xc, 0xf, true);
    return __builtin_amdgcn_readlane(v, 63);
}
__device__ __forceinline__ unsigned mono_key(float f) { const unsigned u = __float_as_uint(f); return (u & 0x80000000u) ? ~u : (u | 0x80000000u); }
__device__ __forceinline__ void idx_unit(Frame& F, int b, int t0, const int mode = 3) {
    const int lane = opaque(F.lane), wid = F.wave, r = lane & 31, hh = lane >> 5;
    LAS unsigned* SC = (LAS unsigned*)F.lds;
    const bf16* PROJ = WSP(bf16, WS_PROJ); const float* SMALL = WSP(float, WS_SMALL);
    bf16x8 af[4][4]; float w[4][16];
#pragma unroll
    for (int rt = 0; rt < 4; ++rt) {
        const int tq = t0 + 2 * rt + ((r >> 2) & 1), head = (r & 3) + 4 * (r >> 3); const size_t tok = (size_t)b * SEQ + tq;
        const bf16* src = PROJ + tok * LDP + C_IQ + head * 64 + 8 * hh;
        u32x4 raw[4];
#pragma unroll
        for (int ks = 0; ks < 4; ++ks) raw[ks] = *(const u32x4*)(src + 16 * ks);
        const float* rc = WSP(float, WS_R64C) + tok * 32 + 8 * hh; const float* rs = WSP(float, WS_R64S) + tok * 32 + 8 * hh;
#pragma unroll
        for (int ks = 0; ks < 2; ++ks) {
            const f32x4 c0 = *(const f32x4*)(rc + 16 * ks), c1 = *(const f32x4*)(rc + 16 * ks + 4), s0 = *(const f32x4*)(rs + 16 * ks), s1 = *(const f32x4*)(rs + 16 * ks + 4);
            const float cs[8] = {c0.x, c0.y, c0.z, c0.w, c1.x, c1.y, c1.z, c1.w}, sn[8] = {s0.x, s0.y, s0.z, s0.w, s1.x, s1.y, s1.z, s1.w};
            const unsigned wa[4] = {raw[ks].x, raw[ks].y, raw[ks].z, raw[ks].w}, wb[4] = {raw[ks + 2].x, raw[ks + 2].y, raw[ks + 2].z, raw[ks + 2].w};
            unsigned o1[4], o2[4];
#pragma unroll
            for (int j = 0; j < 4; ++j) { const float x1a = bflo(wa[j]), x1b = bfhi(wa[j]), x2a = bflo(wb[j]), x2b = bfhi(wb[j]);
                o1[j] = cvt_pk_bf16(x1a * cs[2 * j] - x2a * sn[2 * j], x1b * cs[2 * j + 1] - x2b * sn[2 * j + 1]);
                o2[j] = cvt_pk_bf16(x2a * cs[2 * j] + x1a * sn[2 * j], x2b * cs[2 * j + 1] + x1b * sn[2 * j + 1]); }
            const u32x4 v1 = {o1[0], o1[1], o1[2], o1[3]}, v2 = {o2[0], o2[1], o2[2], o2[3]};
            af[rt][ks] = *(const bf16x8*)&v1; af[rt][ks + 2] = *(const bf16x8*)&v2;
        }
        const float* wp = SMALL + ((size_t)b * SEQ + t0 + 2 * rt + hh) * LDSM + SM_IW;
#pragma unroll
        for (int q = 0; q < 4; ++q) { const f32x4 v = *(const f32x4*)(wp + 4 * q); w[rt][4 * q] = v.x * 0.03125f; w[rt][4 * q + 1] = v.y * 0.03125f; w[rt][4 * q + 2] = v.z * 0.03125f; w[rt][4 * q + 3] = v.w * 0.03125f; }
    }
    const int ntiles = (t0 + 8 + 31) >> 5;
    if (mode & 1) {
    const u32x4* IKF = WSP(u32x4, WS_IKF) + (size_t)b * 128 * 4 * 64;
    if (wid < ntiles) {
        u32x4 bfr[4], bnx[4];
#pragma unroll
        for (int ks = 0; ks < 4; ++ks) bfr[ks] = IKF[(size_t)(wid * 4 + ks) * 64 + lane];
        auto mm = [&](const u32x4 (&bf)[4], int rt) { f32x16 acc = {};
#pragma unroll
            for (int ks = 0; ks < 4; ++ks) acc = __builtin_amdgcn_mfma_f32_32x32x16_bf16(af[rt][ks], *(const bf16x8*)&bf[ks], acc, 0, 0, 0);
            return acc; };
        auto fin = [&](int rt, const f32x16& acc, int skey) {
            float s0 = 0.f, s1 = 0.f, s2 = 0.f, s3 = 0.f;
#pragma unroll
            for (int i = 0; i < 16; i += 4) { s0 += w[rt][i] * relu1(acc[i]); s1 += w[rt][i + 1] * relu1(acc[i + 1]); s2 += w[rt][i + 2] * relu1(acc[i + 2]); s3 += w[rt][i + 3] * relu1(acc[i + 3]); }
            const float sc = (s0 + s1) + (s2 + s3);
            const int ql = 2 * rt + hh;
            SC[ql * 4096 + ((skey & ~63) | ((skey + 4 * (skey >> 6)) & 63))] = (skey <= t0 + ql) ? mono_key(sc) : 0u; };
        f32x16 a0 = mm(bfr, 0), a1;
        for (int j = wid; j < ntiles; j += 8) {
            const bool more = j + 8 < ntiles;
            if (more) {
#pragma unroll
                for (int ks = 0; ks < 4; ++ks) bnx[ks] = IKF[(size_t)((j + 8) * 4 + ks) * 64 + lane]; }
            const int skey = 32 * j + r;
            a1 = mm(bfr, 1); fin(0, a0, skey);
            a0 = mm(bfr, 2); fin(1, a1, skey);
            a1 = mm(bfr, 3); fin(2, a0, skey);
            if (more) {
#pragma unroll
                for (int ks = 0; ks < 4; ++ks) bfr[ks] = bnx[ks];
                a0 = mm(bfr, 0); }
            fin(3, a1, skey);
        }
    }
    }
    __syncthreads();
    if (mode & 2) {
        const int tq = t0 + wid, lim = ntiles * 32;
        unsigned key[64];
        const LAS unsigned* scb = SC + wid * 4096 + 64 * lane;
#pragma unroll
        for (int q = 0; q < 16; ++q) { const int jj = (4 * q + 4 * lane) & 63;
            u32x4 v = *(const LAS u32x4*)(scb + jj);
            if (64 * lane + 4 * q >= lim) v = (u32x4){0u, 0u, 0u, 0u};
            key[4 * q] = v.x; key[4 * q + 1] = v.y; key[4 * q + 2] = v.z; key[4 * q + 3] = v.w; }
        unsigned theta = 1u;
        if (tq + 1 > 256) {
            unsigned one2; asm volatile("v_mov_b32 %0, 0x10001" : "=v"(one2));
            unsigned hp[32];
#pragma unroll
            for (int i = 0; i < 32; ++i) hp[i] = (key[2 * i] >> 16) | (key[2 * i + 1] & 0xffff0000u);
            unsigned th = 0u; bool exact = false;
            for (int bit = 15; bit >= 0; --bit) {
                const unsigned cand = th | (1u << bit), cand2 = cand * 0x10001u; unsigned c0 = 0, c1 = 0, c2 = 0, c3 = 0;
#pragma unroll
                for (int i = 0; i < 32; i += 4) { c0 += lt1pk(cand2, hp[i], one2); c1 += lt1pk(cand2, hp[i + 1], one2); c2 += lt1pk(cand2, hp[i + 2], one2); c3 += lt1pk(cand2, hp[i + 3], one2); }
                const unsigned tot = (c0 + c1) + (c2 + c3);
                const int cnt = 4096 - wave_sum_dpp((int)((tot & 0xffffu) + (tot >> 16)));
                if (cnt >= 256) { th = cand; if (cnt == 256) { exact = true; break; } }
            }
            theta = th << 16;
            if (!exact) {
            int ngt = 0;
            if (th != 0xffffu) { const unsigned cand2 = (th + 1u) * 0x10001u; unsigned c0 = 0, c1 = 0, c2 = 0, c3 = 0;
#pragma unroll
                for (int i = 0; i < 32; i += 4) { c0 += lt1pk(cand2, hp[i], one2); c1 += lt1pk(cand2, hp[i + 1], one2); c2 += lt1pk(cand2, hp[i + 2], one2); c3 += lt1pk(cand2, hp[i + 3], one2); }
                const unsigned tot = (c0 + c1) + (c2 + c3);
                ngt = 4096 - wave_sum_dpp((int)((tot & 0xffffu) + (tot >> 16))); }
            const unsigned th2 = th * 0x10001u;
#pragma unroll
            for (int i = 0; i < 32; ++i) {
                const unsigned x = hp[i] ^ th2; unsigned ne; asm("v_pk_min_u16 %0, %1, %2" : "=v"(ne) : "v"(x), "v"(one2));
                const unsigned eq = one2 - ne, msk = __umul24(eq, 0xffffu);
                hp[i] = ((key[2 * i] & 0xffffu) | (key[2 * i + 1] << 16)) & msk; }
            unsigned tl = 0u;
            for (int bit = 15; bit >= 0; --bit) {
                const unsigned cand = tl | (1u << bit), cand2 = cand * 0x10001u; unsigned c0 = 0, c1 = 0, c2 = 0, c3 = 0;
#pragma unroll
                for (int i = 0; i < 32; i += 4) { c0 += lt1pk(cand2, hp[i], one2); c1 += lt1pk(cand2, hp[i + 1], one2); c2 += lt1pk(cand2, hp[i + 2], one2); c3 += lt1pk(cand2, hp[i + 3], one2); }
                const unsigned tot = (c0 + c1) + (c2 + c3);
                const int cnt = ngt + 4096 - wave_sum_dpp((int)((tot & 0xffffu) + (tot >> 16)));
                if (cnt >= 256) { tl = cand; if (cnt == 256) break; }
            }
            theta = (th << 16) | tl;
            }
        }
        unsigned lo = 0u, hi32 = 0u;
#pragma unroll
        for (int j = 31; j >= 0; --j) { lo = (lo << 1) | ((key[j] >= theta) ? 1u : 0u); hi32 = (hi32 << 1) | ((key[32 + j] >= theta) ? 1u : 0u); }
        if (mode == 3 || (lo == 0x12345u && hi32 == 0x54321u)) *(u32x2*)(WSP(unsigned long long, WS_MASK) + ((size_t)b * SEQ + tq) * 64 + lane) = (u32x2){lo, hi32};
    }
    LDS_BARRIER();
}

__device__ __forceinline__ void router_tile(Frame& F, int tile) {
    const int lane = opaque(F.lane), wid = F.wave, r = lane & 31, hh = lane >> 5;
    const int tok = tile * 32 + r;
    const bf16* xr = WSP(bf16, WS_X1B) + (size_t)tok * DM + 512 * wid + 8 * hh;
    unsigned char* h2 = WSP(unsigned char, WS_H2) + (size_t)tok * DM + 512 * wid + 8 * hh;
    const float* nw = F.ffnw() + 512 * wid + 8 * hh;
    const u32x4* WRF = WSP(u32x4, WS_WRF) + (size_t)(32 * wid) * 64 + lane;
    f32x16 a0 = {}, a1 = {}; float ss = 0.f; unsigned pw0 = 0u, pw1 = 0u;
#pragma unroll 4
    for (int s = 0; s < 32; ++s) {
        const u32x4 hi = *(const u32x4*)(xr + 16 * s);
        const f32x4 v0 = {bflo(hi.x), bfhi(hi.x), bflo(hi.y), bfhi(hi.y)}, v1 = {bflo(hi.z), bfhi(hi.z), bflo(hi.w), bfhi(hi.w)};
        const f32x4 n0 = *(const f32x4*)(nw + 16 * s), n1 = *(const f32x4*)(nw + 16 * s + 4);
        ss += (v0.x * v0.x + v0.y * v0.y) + (v0.z * v0.z + v0.w * v0.w) + (v1.x * v1.x + v1.y * v1.y) + (v1.z * v1.z + v1.w * v1.w);
        { unsigned w0 = 0u, w1 = 0u;
          w0 = cvt2_fp8(v0.x * n0.x, v0.y * n0.y, w0, false); w0 = cvt2_fp8(v0.z * n0.z, v0.w * n0.w, w0, true); w1 = cvt2_fp8(v1.x * n1.x, v1.y * n1.y, w1, false); w1 = cvt2_fp8(v1.z * n1.z, v1.w * n1.w, w1, true);
          if ((s & 1) == 0) { pw0 = w0; pw1 = w1; }
          else { auto q0 = __builtin_amdgcn_permlane32_swap(pw0, w0, false, false); auto q1 = __builtin_amdgcn_permlane32_swap(pw1, w1, false, false);
                 *(u32x4*)(h2 - 8 * hh + 16 * (s - 1) + 16 * hh) = (u32x4){q0[0], q1[0], q0[1], q1[1]}; } }
        const u32x4 b0h = WRF[(size_t)(0 * 256 + s) * 64], b0l = WRF[(size_t)(1 * 256 + s) * 64], b1h = WRF[(size_t)(2 * 256 + s) * 64], b1l = WRF[(size_t)(3 * 256 + s) * 64];
        a0 = __builtin_amdgcn_mfma_f32_32x32x16_bf16(*(const bf16x8*)&hi, *(const bf16x8*)&b0h, a0, 0, 0, 0);
        a0 = __builtin_amdgcn_mfma_f32_32x32x16_bf16(*(const bf16x8*)&hi, *(const bf16x8*)&b0l, a0, 0, 0, 0);
        a1 = __builtin_amdgcn_mfma_f32_32x32x16_bf16(*(const bf16x8*)&hi, *(const bf16x8*)&b1h, a1, 0, 0, 0);
        a1 = __builtin_amdgcn_mfma_f32_32x32x16_bf16(*(const bf16x8*)&hi, *(const bf16x8*)&b1l, a1, 0, 0, 0);
    }
    ss += __shfl_xor(ss, 32);
    LAS float* PART = (LAS float*)F.lds;
    LAS float* SS = PART + 10240;
    if (hh == 0) SS[wid * 32 + r] = ss;
#pragma unroll
    for (int i = 0; i < 16; ++i) { const int tr = crow(i, hh); PART[(wid * 32 + tr) * 40 + r] = a0[i]; if (r < 4) PART[(wid * 32 + tr) * 40 + 32 + r] = a1[i]; }
    __syncthreads();
    if (wid == 0 && lane < 32) {
        float sq = 0.f;
#pragma unroll
        for (int w = 0; w < 8; ++w) sq += SS[w * 32 + lane];
        const float rstd = rsqrtf(sq * (1.f / DM) + EPS);
        WSP(float, WS_RSTD)[tile * 32 + lane] = rstd;
        float g4[4]; float mg = -3.4e38f; int gi = 0;
#pragma unroll
        for (int j = 0; j < 4; ++j) { float v = 0.f;
#pragma unroll
            for (int w = 0; w < 8; ++w) v += PART[(w * 32 + lane) * 40 + 32 + j];
            g4[j] = v * rstd + F.brg()[j]; if (g4[j] > mg) { mg = g4[j]; gi = j; } }
        float sg = 0.f;
#pragma unroll
        for (int j = 0; j < 4; ++j) sg += __expf(g4[j] - mg);
        const float pgrp = 1.f / sg;
        float e8[8]; float m0 = -3.4e38f; int i0 = 0;
#pragma unroll
        for (int j = 0; j < 8; ++j) { float v = 0.f;
#pragma unroll
            for (int w = 0; w < 8; ++w) v += PART[(w * 32 + lane) * 40 + gi * 8 + j];
            e8[j] = v * rstd + F.bre()[gi * 8 + j]; if (e8[j] > m0) { m0 = e8[j]; i0 = j; } }
        float m1 = -3.4e38f; int i1 = 0;
#pragma unroll
        for (int j = 0; j < 8; ++j) if (j != i0 && e8[j] > m1) { m1 = e8[j]; i1 = j; }
        const float p1 = __expf(m1 - m0), den = 1.f + p1;
        const float w0 = pgrp / den, w1 = pgrp * p1 / den;
        int* LIST = WSP(int, WS_LIST); float* LWT = WSP(float, WS_LWT); unsigned* cnt = F.ctl + CW_CNT;
        const int tk = tile * 32 + lane;
        const int sg0 = (gi * 8 + i0) * 2, sg1 = (gi * 8 + i1) * 2 + 1;
        const unsigned p0 = __hip_atomic_fetch_add(cnt + 64 * sg0, 1u, __ATOMIC_RELAXED, __HIP_MEMORY_SCOPE_AGENT);
        LIST[sg0 * 16384 + p0] = tk; LWT[sg0 * 16384 + p0] = w0;
        const unsigned q0 = __hip_atomic_fetch_add(cnt + 64 * sg1, 1u, __ATOMIC_RELAXED, __HIP_MEMORY_SCOPE_AGENT);
        LIST[sg1 * 16384 + q0] = tk; LWT[sg1 * 16384 + q0] = w1;
    }
    LDS_BARRIER();
}

__device__ __forceinline__ void moe_tables(Frame& F) {
    LAS int* segc = (LAS int*)(F.lds + LT_SEGC); LAS int* segt = (LAS int*)(F.lds + LT_SEGT); LAS int* rtseg = (LAS int*)(F.lds + LT_RTSEG); LAS int* rk = (LAS int*)(F.lds + LT_RK); LAS int* nrk = (LAS int*)(F.lds + LT_NRK);
    if (F.tid < 64) segc[F.tid] = (int)__hip_atomic_load(F.ctl + CW_CNT + 64 * F.tid, __ATOMIC_RELAXED, __HIP_MEMORY_SCOPE_AGENT);
    __syncthreads();
    if (F.tid == 0) { int acc = 0, n0 = 0, n1 = 0;
        for (int s = 0; s < 64; ++s) { segt[s] = acc; const int nt = (segc[s] + 255) >> 8; for (int q = 0; q < nt; ++q) { rtseg[acc + q] = s; if (s & 1) rk[160 + n1++] = acc + q; else rk[n0++] = acc + q; } acc += nt; }
        segt[64] = acc; nrk[0] = n0; nrk[1] = n1; }
    __syncthreads();
}
struct MoeGUOrder {
    const LAS int* segc; const LAS int* segt; const LAS int* rtseg; int G, c; const char* A; const char* W; const int* LIST;
    __device__ __forceinline__ bool next(int i, pg8::Unit& u) const {
        const int L = i * G + c, nrt = __builtin_amdgcn_readfirstlane(segt[64]); if (L >= nrt * 4) return false;
        const int g = L >> 2, ct = L & 3, sgm = __builtin_amdgcn_readfirstlane(rtseg[g]), rt = g - __builtin_amdgcn_readfirstlane(segt[sgm]), e = sgm >> 1;
        u.pm = g; u.pn = ct; u.A = A; u.B = W + ((size_t)e * 1024 + 256 * ct) * 4096;         u.rows = LIST + sgm * 16384 + rt * 256; u.nrows = __builtin_amdgcn_readfirstlane(segc[sgm]) - rt * 256; u.aux0 = sgm; u.aux1 = rt; return true;
    }
};
struct MoeDownOrder {
    const LAS int* segc; const LAS int* segt; const LAS int* rtseg; const LAS int* rk; int nr, G, c; const char* HE; const char* W;
    __device__ __forceinline__ bool next(int i, pg8::Unit& u) const {
        const int L = i * G + c; if (L >= nr * 16) return false;
        const int g = __builtin_amdgcn_readfirstlane(rk[L >> 4]), ct = L & 15, sgm = __builtin_amdgcn_readfirstlane(rtseg[g]), rt = g - __builtin_amdgcn_readfirstlane(segt[sgm]), e = sgm >> 1;
        u.pm = g; u.pn = ct; u.A = HE + (size_t)g * 256 * 512 * 2; u.B = W + ((size_t)e * 4096 + 256 * ct) * 512 * 2; u.rows = nullptr; u.nrows = __builtin_amdgcn_readfirstlane(segc[sgm]) - rt * 256; u.aux0 = sgm; u.aux1 = rt; return true;
    }
};
struct EpiGU {
    bf16* HE; const int* LIST; const float* RSTD;
    __device__ __forceinline__ void operator()(const f32x4 (&acc)[2][2][4][2], const pg8::Unit& u, int wr, int wc, int fr, int fq) const {
        const int col0 = u.pn * 128 + wc * 32 + 8 * fq;
        int zz; asm volatile("v_mov_b32 %0, 0" : "=v"(zz));
        float rsv[2][4];
#pragma unroll
        for (int ai = 0; ai < 2; ++ai)
#pragma unroll
            for (int m = 0; m < 4; ++m) { const int lr = ai * 128 + wr * 64 + m * 16 + fr + zz; const int tok = lr < u.nrows ? u.rows[lr] : 0; rsv[ai][m] = RSTD[tok]; }
#pragma unroll
        for (int ai = 0; ai < 2; ++ai)
#pragma unroll
            for (int m = 0; m < 4; ++m) { const int lr = ai * 128 + wr * 64 + m * 16 + fr + zz;
                if (lr < u.nrows) { const float rs = rsv[ai][m];
                    const f32x4 g0 = acc[ai][0][m][0] * rs, g1 = acc[ai][0][m][1] * rs, u0 = acc[ai][1][m][0] * rs, u1 = acc[ai][1][m][1] * rs;
                    u32x4 w; w.x = cvt_pk_bf16(g0[0] * sigmoidf_(g0[0]) * u0[0], g0[1] * sigmoidf_(g0[1]) * u0[1]); w.y = cvt_pk_bf16(g0[2] * sigmoidf_(g0[2]) * u0[2], g0[3] * sigmoidf_(g0[3]) * u0[3]);
                    w.z = cvt_pk_bf16(g1[0] * sigmoidf_(g1[0]) * u1[0], g1[1] * sigmoidf_(g1[1]) * u1[1]); w.w = cvt_pk_bf16(g1[2] * sigmoidf_(g1[2]) * u1[2], g1[3] * sigmoidf_(g1[3]) * u1[3]);
                    *(u32x4*)(HE + ((size_t)u.pm * 256 + lr) * 512 + col0) = w; } }
    }
};
template <int ROUND> struct EpiDown {
    float* O; const int* LIST; const float* LWT; bf16* PART; const bf16* X1;
    __device__ __forceinline__ void operator()(const f32x4 (&acc)[2][2][4][2], const pg8::Unit& u, int wr, int wc, int fr, int fq) const {
        const int col0 = u.pn * 256 + wc * 32 + 8 * fq; const int lbase = u.aux0 * 16384 + u.aux1 * 256;
        int zz; asm volatile("v_mov_b32 %0, 0" : "=v"(zz));
        int tk[2][4]; float wt[2][4];
#pragma unroll
        for (int ai = 0; ai < 2; ++ai)
#pragma unroll
            for (int m = 0; m < 4; ++m) { const int lr = ai * 128 + wr * 64 + m * 16 + fr + zz; const bool ok = lr < u.nrows; tk[ai][m] = ok ? LIST[lbase + lr] : -1; wt[ai][m] = ok ? LWT[lbase + lr] : 0.f; }
        if constexpr (ROUND == 0) {
#pragma unroll
            for (int ai = 0; ai < 2; ++ai)
#pragma unroll
                for (int m = 0; m < 4; ++m) if (tk[ai][m] >= 0) { bf16* pp = PART + (size_t)tk[ai][m] * DM + col0;
#pragma unroll
                    for (int bj = 0; bj < 2; ++bj) { const f32x4 v0 = acc[ai][bj][m][0] * wt[ai][m], v1 = acc[ai][bj][m][1] * wt[ai][m];
                        *(u32x4*)(pp + bj * 128) = (u32x4){cvt_pk_bf16(v0[0], v0[1]), cvt_pk_bf16(v0[2], v0[3]), cvt_pk_bf16(v1[0], v1[1]), cvt_pk_bf16(v1[2], v1[3])}; } }
        } else {
#pragma unroll
        for (int ai = 0; ai < 2; ++ai)
#pragma unroll
        for (int mh = 0; mh < 2; ++mh) {
            u32x4 rv[2][2], pv[2][2];
#pragma unroll
            for (int m2 = 0; m2 < 2; ++m2) { const int m = mh * 2 + m2; const size_t ro = (size_t)(tk[ai][m] < 0 ? 0 : tk[ai][m]) * DM + col0; const bf16* op = X1 + ro; const bf16* pp = PART + ro;
#pragma unroll
                for (int bj = 0; bj < 2; ++bj) { rv[m2][bj] = *(const u32x4*)(op + bj * 128); pv[m2][bj] = *(const u32x4*)(pp + bj * 128); } }
#pragma unroll
            for (int m2 = 0; m2 < 2; ++m2) { const int m = mh * 2 + m2; if (tk[ai][m] >= 0) { float* op = O + (size_t)tk[ai][m] * DM + col0;
#pragma unroll
                for (int bj = 0; bj < 2; ++bj) { const u32x4 p = pv[m2][bj], x = rv[m2][bj];
                    const f32x4 p0 = {__uint_as_float(p.x << 16), __uint_as_float(p.x & 0xffff0000u), __uint_as_float(p.y << 16), __uint_as_float(p.y & 0xffff0000u)};
                    const f32x4 p1 = {__uint_as_float(p.z << 16), __uint_as_float(p.z & 0xffff0000u), __uint_as_float(p.w << 16), __uint_as_float(p.w & 0xffff0000u)};
                    const f32x4 x0 = {__uint_as_float(x.x << 16), __uint_as_float(x.x & 0xffff0000u), __uint_as_float(x.y << 16), __uint_as_float(x.y & 0xffff0000u)};
                    const f32x4 x1 = {__uint_as_float(x.z << 16), __uint_as_float(x.z & 0xffff0000u), __uint_as_float(x.w << 16), __uint_as_float(x.w & 0xffff0000u)};
                    *(f32x4*)(op + bj * 128) = (x0 + p0) + acc[ai][bj][m][0] * wt[ai][m]; *(f32x4*)(op + bj * 128 + 4) = (x1 + p1) + acc[ai][bj][m][1] * wt[ai][m]; } } }
        }
        }
    }
};

namespace att {
constexpr int D = 128, NW = 8, QBLK = 32, KVBLK = 64, QB = 256, H = 16, HKV = 4;
constexpr int SHM_V = KVBLK * D * 2, SHM_K = KVBLK * D * 2;
constexpr int ATT_LDS = 2 * SHM_V + 2 * SHM_K + NW * 64 * 4;
constexpr float SCALE = 0.08838834764831845f, THR = 8.f;
constexpr int LDV = LDP, LDO = 2048;
#define KSWZ(row, colB) ((row) * 256 + ((colB) ^ (((row) & 7) << 4)))
#define SBAR() __builtin_amdgcn_sched_barrier(0)
typedef short s16x4 __attribute__((ext_vector_type(4)));
__device__ __forceinline__ int v_st(int k, int c) { const int kk = (k & ~0xC) | ((k & 4) << 1) | ((k & 8) >> 1); return ((kk >> 3) * 4 + (c >> 5)) * 512 + ((kk & 7) * 32 + (c & 31)) * 2; }
__device__ __forceinline__ int v_rd_base(int lane) { return ((lane & 3) << 3) | (((lane >> 2) & 3) << 6) | (((lane >> 4) & 1) << 5) | (((lane >> 5) & 1) << 8); }
constexpr int v_rd_off(int d0, int ks, int half) { return d0 * 512 + ks * 4096 + half * 2048; }
__device__ __forceinline__ bf16x8 load8(const bf16* p) { return *reinterpret_cast<const bf16x8*>(p); }

__device__ __forceinline__ void partialSM(f32x16& p0, f32x16& p1, float& m_reg, float& mn, float& alpha) {
    float pmax = p0[0];
#pragma unroll
    for (int r = 1; r < 16; ++r) pmax = fmaxf(pmax, p0[r]);
#pragma unroll
    for (int r = 0; r < 16; ++r) pmax = fmaxf(pmax, p1[r]);
    { auto rr = __builtin_amdgcn_permlane32_swap(__float_as_uint(pmax), __float_as_uint(pmax), false, false);
      pmax = fmaxf(__uint_as_float(rr[0]), __uint_as_float(rr[1])); }
    constexpr float C2 = 1.4426950408889634f * SCALE;
    if (__builtin_expect(__all((pmax - m_reg) * SCALE <= THR), 1)) { mn = m_reg; alpha = 1.f; }
    else { mn = fmaxf(m_reg, pmax); alpha = __builtin_amdgcn_exp2f((m_reg - mn) * C2); m_reg = mn; }
    const float mnL = -mn * C2;
#pragma unroll
    for (int r = 0; r < 16; ++r) p0[r] = fmaf(p0[r], C2, mnL);
#pragma unroll
    for (int r = 0; r < 16; ++r) p1[r] = fmaf(p1[r], C2, mnL);
#pragma unroll
    for (int r = 0; r < 16; ++r) p0[r] = __builtin_amdgcn_exp2f(p0[r]);
}
__device__ __forceinline__ void finishSM(f32x16& p0, f32x16& p1, float alpha, float& l_reg, unsigned mlo, unsigned mhi, bf16x8& pa0, bf16x8& pa1, bf16x8& pa2, bf16x8& pa3) {
#pragma unroll
    for (int r = 0; r < 16; ++r) p1[r] = __builtin_amdgcn_exp2f(p1[r]);
#pragma unroll
    for (int r = 0; r < 16; ++r) { const int c = (r & 3) + 8 * (r >> 2);
        p0[r] = __uint_as_float(__float_as_uint(p0[r]) & (unsigned)__builtin_amdgcn_sbfe((int)mlo, c, 1));
        p1[r] = __uint_as_float(__float_as_uint(p1[r]) & (unsigned)__builtin_amdgcn_sbfe((int)mhi, c, 1)); }
    float ps = 0;
#pragma unroll
    for (int r = 0; r < 16; ++r) ps += p0[r];
#pragma unroll
    for (int r = 0; r < 16; ++r) ps += p1[r];
    { auto rr = __builtin_amdgcn_permlane32_swap(__float_as_uint(ps), __float_as_uint(ps), false, false);
      ps = __uint_as_float(rr[0]) + __uint_as_float(rr[1]); }
    l_reg = l_reg * alpha + ps;
#define PK4(P, B_, OUT) do { unsigned a0 = cvt_pk_bf16(P[B_+0], P[B_+1]), a1 = cvt_pk_bf16(P[B_+2], P[B_+3]);                          \
        unsigned b0 = cvt_pk_bf16(P[B_+4], P[B_+5]), b1 = cvt_pk_bf16(P[B_+6], P[B_+7]);                                             \
        auto r0 = __builtin_amdgcn_permlane32_swap(a0, b0, false, false); auto r1 = __builtin_amdgcn_permlane32_swap(a1, b1, false, false); \
        u32x4 w = {r0[0], r1[0], r0[1], r1[1]}; OUT = *reinterpret_cast<bf16x8*>(&w); } while (0)
    PK4(p0, 0, pa0); PK4(p0, 8, pa1); PK4(p1, 0, pa2); PK4(p1, 8, pa3);
#undef PK4
}
template <int KB>
__device__ __forceinline__ void qkt(f32x16& p0, f32x16& p1, const char* K_lds, int r32, int hi, const bf16x8* qr) {
    p0 = f32x16{}; p1 = f32x16{};
    const char* kb[4];
#pragma unroll
    for (int dd = 0; dd < 4; ++dd) kb[dd] = K_lds + KB * SHM_K + KSWZ(r32, (dd * 16 + hi * 8) * 2);
#pragma unroll
    for (int d0 = 0; d0 < 8; ++d0) { const char* a = kb[d0 & 3] + (d0 >> 2) * 128;
        bf16x8 b0 = *reinterpret_cast<const bf16x8*>(a);
        bf16x8 b1 = *reinterpret_cast<const bf16x8*>(a + 32 * 256);
        p0 = __builtin_amdgcn_mfma_f32_32x32x16_bf16(b0, qr[d0], p0, 0, 0, 0);
        p1 = __builtin_amdgcn_mfma_f32_32x32x16_bf16(b1, qr[d0], p1, 0, 0, 0); }
}
template <int VB>
__device__ __forceinline__ void pv_tile(f32x16* o, int vb0, bf16x8 pa0, bf16x8 pa1, bf16x8 pa2, bf16x8 pa3) {
#define TRRD(dst, off) asm volatile("ds_read_b64_tr_b16 %0, %1 offset:%2" : "=&v"(dst) : "v"(vb0), "i"(off) : "memory")
#define PV_D0(d0) do { s16x4 l0, l1, l2, l3, h0, h1, h2, h3; constexpr int b_ = VB * SHM_V + v_rd_off(d0, 0, 0); \
        TRRD(l0, b_); TRRD(h0, b_ + 2048); TRRD(l1, b_ + 4096); TRRD(h1, b_ + 6144); TRRD(l2, b_ + 8192); TRRD(h2, b_ + 10240); TRRD(l3, b_ + 12288); TRRD(h3, b_ + 14336); \
        asm volatile("s_waitcnt lgkmcnt(0)" ::: "memory"); SBAR();   \
        o[d0] = __builtin_amdgcn_mfma_f32_32x32x16_bf16(pa0, (bf16x8){l0[0], l0[1], l0[2], l0[3], h0[0], h0[1], h0[2], h0[3]}, o[d0], 0, 0, 0);   \
        o[d0] = __builtin_amdgcn_mfma_f32_32x32x16_bf16(pa1, (bf16x8){l1[0], l1[1], l1[2], l1[3], h1[0], h1[1], h1[2], h1[3]}, o[d0], 0, 0, 0);   \
        o[d0] = __builtin_amdgcn_mfma_f32_32x32x16_bf16(pa2, (bf16x8){l2[0], l2[1], l2[2], l2[3], h2[0], h2[1], h2[2], h2[3]}, o[d0], 0, 0, 0);   \
        o[d0] = __builtin_amdgcn_mfma_f32_32x32x16_bf16(pa3, (bf16x8){l3[0], l3[1], l3[2], l3[3], h3[0], h3[1], h3[2], h3[3]}, o[d0], 0, 0, 0); } while (0)
    PV_D0(0); PV_D0(1); PV_D0(2); PV_D0(3);
#undef PV_D0
#undef TRRD
}
struct BlockRef { const bf16* Q; const bf16* K; const bf16* V; bf16* O; const unsigned long long* M; int P0; };
struct Seam { bf16x8 qr[8]; bf16x8 st_v0, st_v1, st_k0, st_k1; };
#define ROWK(p, k0, rr) ((const bf16*)((const char*)(p) + (size_t)(k0) * (D * 2) + (unsigned)(((rr) * D + sc) * 2)))
#define ROWV(p, k0, rr) ((const bf16*)((const char*)(p) + (size_t)(k0) * (LDV * 2) + (unsigned)(((rr) * LDV + sc) * 2)))
#define VMW() asm volatile("s_waitcnt vmcnt(0)" ::: "memory")
#define VMWN(n) asm volatile("s_waitcnt vmcnt(%0)" :: "i"(n) : "memory")
#define SLOAD_H(Kp, Vp, k0) do { S.st_v0 = load8(ROWV(Vp, k0, sr)); S.st_v1 = load8(ROWV(Vp, k0, 32 + sr));              \
                         S.st_k0 = load8(ROWK(Kp, k0, sr)); S.st_k1 = load8(ROWK(Kp, k0, 32 + sr)); } while (0)
#define SWRITE_HK(bf) do { *(bf16x8*)(K_lds + (bf) * SHM_K + kws) = S.st_k0; *(bf16x8*)(K_lds + (bf) * SHM_K + kws + 32 * 256) = S.st_k1; } while (0)
#define SWRITE_HV(bf) do { *(bf16x8*)(V_lds + (bf) * SHM_V + vst0) = S.st_v0; *(bf16x8*)(V_lds + (bf) * SHM_V + vst1) = S.st_v1; } while (0)
#define SWRITE_H(bf) do { SWRITE_HV(bf); SWRITE_HK(bf); } while (0)
__device__ __forceinline__ void prime(const BlockRef& cur, char* lds, Seam& S, const int tid) {
    const int wid = __builtin_amdgcn_readfirstlane(tid >> 6), lane = tid & 63, r32 = lane & 31, hi = lane >> 5;
    const int sr = tid >> 4, sc = (tid & 15) * 8, kws = KSWZ(sr, sc * 2); char* K_lds = lds + 2 * SHM_V;
#pragma unroll
    for (int d0 = 0; d0 < 8; ++d0) S.qr[d0] = load8(cur.Q + (size_t)(wid * QBLK + r32) * D + d0 * 16 + hi * 8);
    SLOAD_H(cur.K, cur.V, 0); VMW(); SWRITE_HK(0);
    __syncthreads();
}
__device__ __forceinline__ void block(const BlockRef& cur, const BlockRef& nxt, char* lds, Seam& S, const int tid) {
    const int wid = __builtin_amdgcn_readfirstlane(tid >> 6), lane = tid & 63, r32 = lane & 31, hi = lane >> 5;
    const int NT = (cur.P0 + QB - 1) / KVBLK + 1;
    char* V_lds = lds; char* K_lds = lds + 2 * SHM_V;
    float* ws = (float*)(lds + 2 * SHM_V + 2 * SHM_K) + wid * 64; float* li_l = ws, * al_l = ws + 32;
    float m_reg = -1e30f, l_reg = 0; f32x16 o[4] = {};
    const int sr = tid >> 4, sc = (tid & 15) * 8, vst0 = v_st(sr, sc), vst1 = v_st(32 + sr, sc), kws = KSWZ(sr, sc * 2);
    const int vb0 = (int)(uintptr_t)V_lds + v_rd_base(lane);
    const bf16* Kh = cur.K; const bf16* Vh = cur.V;
    const int mrow = (wid * QBLK + r32) * 64;
    const int msh = 4 * hi;
#define RESC(a) do { if (__any((a) < 1.f)) { if (hi == 0) al_l[r32] = (a); asm volatile("s_waitcnt lgkmcnt(0)" ::: "memory");              \
                     for (int d_ = 0; d_ < 4; ++d_) for (int r = 0; r < 16; ++r) o[d_][r] *= al_l[crow(r, hi)]; } } while (0)
#define KBASE(t) ((t) * KVBLK)
#define LDM(ML, MH, t) do { const u32x2 mw_ = *(const u32x2*)(cur.M + mrow + (t)); ML = mw_.x >> msh; MH = mw_.y >> msh; } while (0)
#define SEAM_K0() do { VMWN(8); SWRITE_HK(0); SBAR(); } while (0)
    f32x16 pA0, pA1, pB0, pB1; float mnA, mnB, alA, alB; bf16x8 pa0, pa1, pa2, pa3; unsigned ml, mh;
    SWRITE_HV(0); SBAR();
    if (NT > 1) SLOAD_H(Kh, Vh, KBASE(1));
    SBAR(); qkt<0>(pA0, pA1, K_lds, r32, hi, S.qr);
    partialSM(pA0, pA1, m_reg, mnA, alA);
    if (NT > 1) { VMW(); SWRITE_H(1); }
    __syncthreads();
#define HALF_STEP(PX0, PX1, mnX, alX, PY0, PY1, alY, t, KB, VB, SB) do {                                                      \
        LDM(ml, mh, (t) - 1);                                                                                                 \
        SBAR(); qkt<KB>(PX0, PX1, K_lds, r32, hi, S.qr);                                                                      \
        finishSM(PY0, PY1, alY, l_reg, ml, mh, pa0, pa1, pa2, pa3); SBAR();                                                   \
        if ((t) + 1 < NT) { SLOAD_H(Kh, Vh, KBASE((t) + 1)); SBAR(); }                                                        \
        pv_tile<VB>(o, vb0, pa0, pa1, pa2, pa3); partialSM(PX0, PX1, m_reg, mnX, alX);                                        \
        __syncthreads();                                                                                                      \
        if ((t) + 1 < NT) { VMW(); SWRITE_H(SB); }                                                                            \
        RESC(alX); __syncthreads(); } while (0)
    for (int t = 1; t + 1 < NT; t += 2) {
        HALF_STEP(pB0, pB1, mnB, alB, pA0, pA1, alA, t, 1, 0, 0);
        HALF_STEP(pA0, pA1, mnA, alA, pB0, pB1, alB, t + 1, 0, 1, 1);
    }
    LDM(ml, mh, NT - 2);
    SBAR(); qkt<1>(pB0, pB1, K_lds, r32, hi, S.qr); SBAR();
    SLOAD_H(nxt.K, nxt.V, 0); SBAR();
#pragma unroll
    for (int d0 = 0; d0 < 8; ++d0) S.qr[d0] = load8(nxt.Q + (size_t)(wid * QBLK + r32) * D + d0 * 16 + hi * 8);
    SBAR();
    finishSM(pA0, pA1, alA, l_reg, ml, mh, pa0, pa1, pa2, pa3); SBAR();
    pv_tile<0>(o, vb0, pa0, pa1, pa2, pa3);
    partialSM(pB0, pB1, m_reg, mnB, alB); __syncthreads(); RESC(alB);
    SBAR(); SEAM_K0();
    LDM(ml, mh, NT - 1);
    finishSM(pB0, pB1, alB, l_reg, ml, mh, pa0, pa1, pa2, pa3); SBAR(); pv_tile<1>(o, vb0, pa0, pa1, pa2, pa3);
    if (hi == 0) li_l[r32] = l_reg; asm volatile("s_waitcnt lgkmcnt(0)" ::: "memory");
    float rli[16];
#pragma unroll
    for (int r = 0; r < 16; ++r) rli[r] = __builtin_amdgcn_rcpf(li_l[crow(r, hi)]);
    bf16* Ow = cur.O + (size_t)(wid * QBLK) * LDO;
#pragma unroll
    for (int r = 0; r < 16; ++r) { const int orow = crow(r, hi);
#pragma unroll
        for (int d0 = 0; d0 < 4; ++d0) { const float v = o[d0][r] * rli[r];
            const float vn = __shfl_xor(v, 1);
            if ((r32 & 1) == 0) *(unsigned*)(Ow + (size_t)orow * LDO + d0 * 32 + r32) = cvt_pk_bf16(v, vn); } }
    __syncthreads();
#undef RESC
#undef KBASE
#undef LDM
#undef SEAM_K0
#undef HALF_STEP
}
#undef ROWK
#undef ROWV
#undef VMW
#undef VMWN
#undef SLOAD_H
#undef SWRITE_HK
#undef SWRITE_HV
#undef SWRITE_H
struct Item { int bh, qb0, qb1; };
__device__ __forceinline__ Item decode(int L) {
    constexpr int nx = 8, G = H / HKV; Item it;
    const int xcd = L & 7, k = L >> 3, per = G * nx, gi = k / per, rr = k - gi * per;
    it.bh = (gi * 8 + xcd) * G + rr / nx; const int x = rr % nx;
    it.qb0 = x; it.qb1 = 15 - x; return it;
}
__device__ __forceinline__ BlockRef mkref(const Item& it, int pass, const bf16* Q, const bf16* K, const bf16* V, bf16* O, const unsigned long long* M) {
    const int qb = pass ? it.qb1 : it.qb0, b = it.bh / H, h = it.bh % H, kvh = h / (H / HKV);
    BlockRef r;
    r.Q = Q + ((size_t)it.bh * SEQ + (size_t)qb * QB) * D;
    r.K = K + (size_t)(b * HKV + kvh) * SEQ * D;
    r.V = V + (size_t)b * SEQ * LDV + kvh * D;
    r.O = O + ((size_t)b * SEQ + (size_t)qb * QB) * LDO + h * D;
    r.M = M + ((size_t)b * SEQ + (size_t)qb * QB) * 64;
    r.P0 = qb * QB; return r;
}
__device__ __forceinline__ void phase(char* lds, const bf16* Q, const bf16* K, const bf16* V, bf16* O, const unsigned long long* M, int G, int c, const int tid) {
    constexpr int total = 8 * NB * H;
    int L = c; if (L >= total) return;
    Item it = decode(L); int pass = 0;
    BlockRef cur = mkref(it, 0, Q, K, V, O, M);
    Seam S;
    prime(cur, lds, S, tid);
    for (;;) {
        const bool more_pass = pass == 0, more_item = L + G < total, last = !more_pass && !more_item;
        Item itn = it; int passn = pass + 1, Ln = L;
        if (!more_pass) { passn = 0; Ln = more_item ? L + G : L; itn = decode(Ln); }
        const BlockRef nxt = last ? cur : mkref(itn, passn, Q, K, V, O, M);
        block(cur, nxt, lds, S, tid);
        if (last) break;
        cur = nxt; it = itn; pass = passn; L = Ln;
    }
}
#undef KSWZ
#undef SBAR
}

struct Args { const void* in[22]; float* out; unsigned char* ws; int ph_lo, ph_hi; };
__global__ void __launch_bounds__(512, 2) mega_fwd(Args args) {
    extern __shared__ __attribute__((aligned(16))) unsigned char lds[];
    Frame F;
    F.lds = (LAS unsigned char*)lds;
#define F_REFRESH() do { int l_; asm volatile("v_mbcnt_lo_u32_b32 %0, -1, 0\n\tv_mbcnt_hi_u32_b32 %0, -1, %0" : "=v"(l_)); F.lane = l_; F.wave = wave_id; F.tid = wave_id * 64 + l_; F.gw = (int)blockIdx.x * 8 + wave_id; } while (0)
    const int wave_id = __builtin_amdgcn_readfirstlane((int)threadIdx.x >> 6);
    F.G = gridDim.x; F.NGW = F.G * 8; F_REFRESH();
    F.ws = args.ws; F.out = args.out; F.ctl = (unsigned*)(args.ws + WS_CTL);
    F.kin = (const __attribute__((address_space(4))) void* const*)__builtin_amdgcn_kernarg_segment_ptr();
    for (int u = F.tid; u < (LDS_BYTES - LDSCTL_OFF) / 4; u += 512) ((LAS unsigned*)(F.lds + LDSCTL_OFF))[u] = 0u;
    __syncthreads();
    const int lo = args.ph_lo, hi = args.ph_hi;
    XcdBarrier bar; bar.bar = F.ctl + CW_BAR; bar.x = 0; bar.st = nullptr;
    if (hi - lo > 1) bar = xcd_barrier_post(F.ctl + CW_BAR, (volatile LAS unsigned*)(F.lds + LDSCTL_OFF + 32), F.tid);
#ifndef PHMASK
#define PHMASK 0x1fff
#endif
#define IN(k) (((PHMASK >> (k)) & 1) && lo <= (k) && (k) < hi)
#ifndef REP_PH
#define REP_PH -1
#endif
#ifndef DBG_P1_MODE
#define DBG_P1_MODE 3
#endif
#ifndef DBG_G1_MODE
#define DBG_G1_MODE 9
#endif
#ifndef DBG_IDX_MODE
#define DBG_IDX_MODE 3
#endif
#define REPS(k) ((REP_PH) == (k) ? 2 : 1)
#define SEAM(k) do { if (IN(k) && IN((k) + 1)) { F_REFRESH(); xcd_barrier(bar, F.tid); } } while (0)
    const int G = F.G, c = (int)blockIdx.x;

    if (lo < 0) { F_REFRESH(); p_amax(F); if (hi > 0) { F_REFRESH(); xcd_barrier(bar, F.tid); } }
    if (IN(0)) { F_REFRESH(); for (int rp_ = 0; rp_ < REPS(0); ++rp_) { if (rp_) { xcd_barrier(bar, F.tid); F_REFRESH(); } p0_prologue(F); __syncthreads(); } }
    SEAM(0);
    if (IN(1)) { F_REFRESH(); for (int rp_ = 0; rp_ < REPS(1); ++rp_) { if (rp_) { xcd_barrier(bar, F.tid); F_REFRESH(); }
        {
            const float sw = fmaxf(__uint_as_float(__hip_atomic_load(F.ctl + CW_AMAX, __ATOMIC_RELAXED, __HIP_MEMORY_SCOPE_AGENT)), 1e-30f) * (1.f / 127.f);
            const bool stag = (G == 256) && rp_ == 0;
            const int grp = c & 7, cw = ((grp - 2) * 32 + (c >> 3)) * 8 + F.wave, ncw = 192 * 8;
            const int kpre = grp == 2 ? 3 : grp == 3 ? 4 : grp == 4 ? 6 : grp == 5 ? 7 : grp == 6 ? 8 : grp == 7 ? 10 : 0;
            const int cv0 = CV_NITEMS - CV_LATE - CV_MID, cvm = cv0 + kpre * ncw;
            if (stag && grp >= 2 && kpre > 0) { convert_items(F, cv0, cvm, cw, ncw); __syncthreads(); F_REFRESH(); }
            if (stag && grp == 1) { __builtin_amdgcn_s_sleep(127); __builtin_amdgcn_s_sleep(127); }
            pg8::StaggerOrder S; S.init(WSP(unsigned char, WS_XN8), WSP(unsigned char, WS_WIN8), T, NPAD, 2048, G, c);
            EpiProj E{WSP(bf16, WS_PROJ), WSP(float, WS_SMALL), WSP(float, WS_SA), sw};
            pg8::gemm_phase<EpiProj, pg8::StaggerOrder, true, false, 2>(F.lds, F.tid, 2048, S, E);
            if (stag && grp >= 2) { F_REFRESH(); convert_items(F, cvm, CV_NITEMS - CV_LATE, ((grp - 2) * 32 + (c >> 3)) * 8 + F.wave, ncw); }
        }
    }
    }
    SEAM(1);
    if (IN(2)) { F_REFRESH(); for (int rp_ = 0; rp_ < REPS(2); ++rp_) { if (rp_) { xcd_barrier(bar, F.tid); F_REFRESH(); }
        if (rp_ == 0 || DBG_G1_MODE == 0 || DBG_G1_MODE == 9) for (int tok = F.gw; tok < T; tok += F.NGW) p2_post_token(F, tok);
        if (rp_ == 0 && IN(3)) { split_arrive(F.ctl + CW_SPLIT, F.tid); F_REFRESH(); }
        if (rp_ == 0 || DBG_G1_MODE != 0) {
            const int nper = 4096 / G, bh = (c * nper) >> 6, hd = bh & 15;
            for (int i = F.tid; i < 3 * 4 * 128; i += 512) { const int tz = i / 512, m = (i >> 7) & 3, d = i & 127; ((LAS float*)(F.lds + G_CW))[i] = F.convw()[(size_t)m * 6144 + tz * 2048 + hd * 128 + d]; }
            __syncthreads();
            for (int i = 0; i < nper; ++i) gdn_chunk(F, c * nper + i, rp_ ? DBG_G1_MODE : 9);
        }
    }
    }
    if (IN(2) && IN(3)) { F_REFRESH(); split_wait(F.ctl + CW_SPLIT, F.ctl + CW_BAR, (unsigned)G, F.tid); }
    if (IN(3)) { F_REFRESH(); for (int rp_ = 0; rp_ < REPS(3); ++rp_) { if (rp_) { xcd_barrier(bar, F.tid); F_REFRESH(); }
        for (int i = 0; i * G < 2048; ++i) { const int idx = i * G + ((i & 1) ? G - 1 - c : c); if (idx < 2048) idx_unit(F, idx & 3, (idx >> 2) * 8, rp_ ? DBG_IDX_MODE : 3); }
    }
    }
    SEAM(3);
    if (IN(4)) { F_REFRESH(); for (int rp_ = 0; rp_ < REPS(4); ++rp_) { if (rp_) { xcd_barrier(bar, F.tid); F_REFRESH(); }
        att::phase((char*)lds, WSP(bf16, WS_QB), WSP(bf16, WS_KB), WSP(bf16, WS_PROJ) + C_AV, WSP(bf16, WS_YA), WSP(unsigned long long, WS_MASK), G, c, F.tid);
        __syncthreads();
    }
    }
    SEAM(4);
    if (IN(5)) { F_REFRESH(); for (int rp_ = 0; rp_ < REPS(5); ++rp_) { if (rp_) { xcd_barrier(bar, F.tid); F_REFRESH(); }
        if (c >= 128) { for (int tok = (c - 128) * 8 + F.wave; tok < T; tok += (G - 128) * 8) ya_to_fp8_token(F, tok);
            convert_items(F, CV_NITEMS - CV_LATE, CV_NITEMS, (c - 128) * 8 + F.wave, (G - 128) * 8); }
        if (c < 128) gdn_scan_wg(F, ((c >> 4) << 3) | (c & 7), (c >> 3) & 1);
    }
    }
    SEAM(5);
    if (IN(6)) { F_REFRESH(); for (int rp_ = 0; rp_ < REPS(6); ++rp_) { if (rp_) { xcd_barrier(bar, F.tid); F_REFRESH(); }
        if (rp_ == 0) for (int tok = F.gw; tok < T; tok += F.NGW) gdn_norm_token(F, tok);
        if (rp_ == 0 && IN(7)) { split_arrive(F.ctl + CW_SPLIT + 64, F.tid); F_REFRESH(); }
        pg8::StaticOrder S; S.init(WSP(unsigned char, WS_YA8), WSP(unsigned char, WS_WPA), T, 4096, 1024, G, c);
        EpiGate<false> E{WSP(bf16, WS_MIX), WSP(bf16, WS_PROJ), C_GTA, nullptr};
        pg8::gemm_phase<EpiGate<false>, pg8::StaticOrder, true, false, 1>(F.lds, F.tid, 1024, S, E, 0x7a7a7a7a, 0x7a7a7a7a);
    }
    }
    if (IN(6) && IN(7)) { F_REFRESH(); split_wait(F.ctl + CW_SPLIT + 64, F.ctl + CW_BAR, (unsigned)G, F.tid); }
    if (IN(7)) { F_REFRESH();
        pg8::StaticOrder S; S.init((const unsigned char*)F.out, WSP(unsigned char, WS_WPG), T, 4096, 1024, G, c);
        EpiGate<true> E{WSP(bf16, WS_MIX), WSP(bf16, WS_PROJ), C_GTG, WSP(unsigned char, WS_MIX8)};
        pg8::gemm_phase<EpiGate<true>, pg8::StaticOrder, true, false, 1>(F.lds, F.tid, 1024, S, E, 0x7a7a7a7a, 0x7c7c7c7c);
    }
    SEAM(7);
    if (IN(8)) { F_REFRESH(); for (int rp_ = 0; rp_ < REPS(8); ++rp_) { if (rp_) { xcd_barrier(bar, F.tid); F_REFRESH(); }
        pg8::StaticOrder S; S.init(WSP(unsigned char, WS_MIX8), WSP(unsigned char, WS_WOUT), T, 4096, 2048, G, c);
        EpiRes E{WSP(bf16, WS_X1B), F.x()};
        pg8::gemm_phase<EpiRes, pg8::StaticOrder, true, false, 1>(F.lds, F.tid, 2048, S, E, 0x79797979, 0x7a7a7a7a);
    }
    }
    SEAM(8);
    if (IN(9)) { F_REFRESH(); for (int rp_ = 0; rp_ < REPS(9); ++rp_) {
        if (rp_) { xcd_barrier(bar, F.tid); F_REFRESH(); if (c == 0 && F.tid < 64) __hip_atomic_store(F.ctl + CW_CNT + 64 * F.tid, 0u, __ATOMIC_RELAXED, __HIP_MEMORY_SCOPE_AGENT); xcd_barrier(bar, F.tid); F_REFRESH(); }
        for (int tile = c; tile < T / 32; tile += G) router_tile(F, tile);
    } }
    SEAM(9);
    if (IN(10)) { F_REFRESH(); for (int rp_ = 0; rp_ < REPS(10); ++rp_) { if (rp_) { xcd_barrier(bar, F.tid); F_REFRESH(); }
        moe_tables(F);
        MoeGUOrder S{(const LAS int*)(F.lds + LT_SEGC), (const LAS int*)(F.lds + LT_SEGT), (const LAS int*)(F.lds + LT_RTSEG), G, c, (const char*)WSP(bf16, WS_H2), (const char*)WSP(bf16, WS_WGU), WSP(int, WS_LIST)};
        EpiGU E{WSP(bf16, WS_HE), WSP(int, WS_LIST), WSP(float, WS_RSTD)};
        pg8::gemm_phase<EpiGU, MoeGUOrder, true, true, 1>(F.lds, F.tid, 2048, S, E, 0x79797979, 0x7f7f7f7f);
    }
    }
    SEAM(10);
#define DOWN_ROUND(k) do { if (IN(11 + (k))) { F_REFRESH(); \
            moe_tables(F); \
            MoeDownOrder S{(const LAS int*)(F.lds + LT_SEGC), (const LAS int*)(F.lds + LT_SEGT), (const LAS int*)(F.lds + LT_RTSEG), (const LAS int*)(F.lds + LT_RK) + 160 * (k), ((const LAS int*)(F.lds + LT_NRK))[k], G, c, (const char*)WSP(bf16, WS_HE), (const char*)WSP(bf16, WS_WD)}; \
            EpiDown<k> E{F.out, WSP(int, WS_LIST), WSP(float, WS_LWT), WSP(bf16, WS_DPART), WSP(bf16, WS_X1B)};        \
            pg8::gemm_phase<EpiDown<k>, MoeDownOrder, true, false>(F.lds, F.tid, 512, S, E); } } while (0)
    DOWN_ROUND(0);
    SEAM(11);
    DOWN_ROUND(1);
#undef DOWN_ROUND
#undef IN
#undef SEAM
}

#ifdef DBG_STOP
__global__ void dbg_dump(float* o, const unsigned short* A, int lda, const unsigned short* B, int ldb) {
    for (size_t i = (size_t)blockIdx.x * blockDim.x + threadIdx.x; i < (size_t)T * DM; i += (size_t)gridDim.x * blockDim.x) { const size_t t = i / DM, c = i % DM;
        const unsigned short v = c < 2048 ? A[t * lda + c] : B[t * ldb + (c - 2048)]; float f = __uint_as_float(((unsigned)v) << 16); if (!(f - f == 0.f)) f = 0.f; o[i] = f; } }
#endif
#ifdef DBG_SANITIZE
__global__ void dbg_sanitize(float* o, size_t n) { for (size_t i = (size_t)blockIdx.x * blockDim.x + threadIdx.x; i < n; i += (size_t)gridDim.x * blockDim.x) { const float v = o[i]; if (!(v - v == 0.f)) o[i] = 0.f; } }
#endif
extern "C" void kernel_launch(void* const* d_in, const int* in_sizes, int n_in, void* d_out, int out_size, void* d_ws, size_t ws_size, hipStream_t stream) {
    static int grid = 0;
    if (grid == 0) {
        if (n_in != 22 || out_size != T * DM || ws_size < WS_END) { fprintf(stderr, "kernel_launch: unexpected shapes (n_in %d out %d ws %zu, need %zu)\n", n_in, out_size, ws_size, (size_t)WS_END); grid = -1; return; }
        int dev = 0, cus = 0, per_cu = 0;
        if (hipGetDevice(&dev) != hipSuccess || hipDeviceGetAttribute(&cus, hipDeviceAttributeMultiprocessorCount, dev) != hipSuccess) { grid = -1; return; }
        if (hipFuncSetAttribute((const void*)mega_fwd, hipFuncAttributeMaxDynamicSharedMemorySize, LDS_BYTES) != hipSuccess) { fprintf(stderr, "kernel_launch: hipFuncSetAttribute failed\n"); grid = -1; return; }
        if (hipOccupancyMaxActiveBlocksPerMultiprocessor(&per_cu, (const void*)mega_fwd, 512, LDS_BYTES) != hipSuccess || per_cu < 1) fprintf(stderr, "kernel_launch: occupancy query reports %d\n", per_cu);
        (void)hipGetLastError();
        grid = cus;
    }
    if (grid < 0) return;
    (void)hipMemsetAsync((char*)d_ws + WS_CTL, 0, CTL_BYTES, stream);
    Args a{};
    for (int i = 0; i < 22; ++i) a.in[i] = d_in[i];
    a.out = (float*)d_out; a.ws = (unsigned char*)d_ws;
#if ONE_LAUNCH
    a.ph_lo = -1; a.ph_hi = NPH;
    hipLaunchKernelGGL(mega_fwd, dim3(grid), dim3(512), LDS_BYTES, stream, a);
#else
#ifdef DBG_STOP
    for (int k = 0; k < DBG_STOP; ++k) { a.ph_lo = k; a.ph_hi = k + 1; hipLaunchKernelGGL(mega_fwd, dim3(grid), dim3(512), LDS_BYTES, stream, a); }
    hipLaunchKernelGGL(dbg_dump, dim3(2048), dim3(256), 0, stream, (float*)d_out, (const unsigned short*)((char*)d_ws + DBG_A), DBG_LDA, (const unsigned short*)((char*)d_ws + DBG_B), DBG_LDB);
#else
    for (int k = -1; k < NPH; ++k) { a.ph_lo = k; a.ph_hi = k + 1; hipLaunchKernelGGL(mega_fwd, dim3(grid), dim3(512), LDS_BYTES, stream, a); }
#endif
#endif
#ifdef DBG_SANITIZE
    hipLaunchKernelGGL(dbg_sanitize, dim3(2048), dim3(256), 0, stream, (float*)d_out, (size_t)T * DM);
#endif
}
```

```cpp
#include <hip/hip_runtime.h>
#include <cstdio>
#include <cstdint>

#ifndef ONE_LAUNCH
#define ONE_LAUNCH 1
#endif

#define GAS __attribute__((address_space(1)))
#define LAS __attribute__((address_space(3)))
typedef unsigned short bf16;
typedef short bf16x8 __attribute__((ext_vector_type(8)));
typedef short bf16x4 __attribute__((ext_vector_type(4)));
typedef float f32x2 __attribute__((ext_vector_type(2)));
typedef float f32x4 __attribute__((ext_vector_type(4)));
typedef float f32x16 __attribute__((ext_vector_type(16)));
typedef unsigned u32x2 __attribute__((ext_vector_type(2)));
typedef unsigned u32x4 __attribute__((ext_vector_type(4)));

constexpr int NB = 4, SEQ = 4096, T = NB * SEQ, DM = 4096;
constexpr int NIN = 20592, NPAD = 20736, LDP = 20480, LDSM = 256;
constexpr int C_AQ = 0, C_AK = 2048, C_AV = 2560, C_IQ = 3072, C_GQ = 4096, C_GK = 6144, C_GV = 8192, C_GZ = 10240, C_GTA = 12288, C_GTG = 16384;
constexpr int SMALL_PN = 80;
constexpr int SM_IK = 0, SM_IW = 64, SM_GA = 80, SM_GB = 96;
constexpr float EPS = 1e-6f;
constexpr int NPH = 13;

constexpr size_t MiB = 1u << 20;
constexpr size_t WS_CTL = 0, CTL_BYTES = 1 * MiB;
constexpr size_t WS_WPA = 1 * MiB, WS_WPG = 17 * MiB, WS_WOUT = 33 * MiB, WS_WGU = 65 * MiB, WS_WD = 321 * MiB;
constexpr size_t WS_WIN8 = 449 * MiB;
constexpr size_t WS_XN8 = 1395 * MiB;
constexpr size_t WS_GQ = 449 * MiB, WS_GO = 513 * MiB, WS_KB = 577 * MiB, WS_IKF = 593 * MiB, WS_MASK = 595 * MiB;
constexpr size_t WS_MIX = 449 * MiB;
constexpr size_t WS_HE = 449 * MiB;
constexpr size_t WS_XN = 611 * MiB;
constexpr size_t WS_QB = 611 * MiB, WS_YA = 675 * MiB;
constexpr size_t WS_YA8 = 611 * MiB;
constexpr size_t WS_MIX8 = 675 * MiB;
constexpr size_t WS_H2 = 611 * MiB;
constexpr size_t WS_PROJ = 739 * MiB; constexpr size_t WS_DPART = WS_PROJ, WS_X1B = WS_PROJ + ((size_t)128 << 20);
constexpr size_t WS_SMALL = 1379 * MiB;
constexpr size_t WS_OSC = 1395 * MiB;
constexpr size_t WS_LIST = 1395 * MiB, WS_LWT = 1399 * MiB;
constexpr size_t WS_R128C = 1459 * MiB, WS_R128S = 1463 * MiB, WS_R64C = 1467 * MiB, WS_R64S = 1469 * MiB;
constexpr size_t WS_WRF = 1471 * MiB;
constexpr size_t WS_RSTD = 1472 * MiB, WS_GG = WS_RSTD + 65536, WS_SA = WS_GG + 65536;
constexpr size_t WS_END = 1472 * MiB + 196608;
constexpr int CW_BAR = 4096;
constexpr int CW_CNT = 16384;
constexpr int CW_SPLIT = 36864;
constexpr int CW_AMAX = 32768;

constexpr int RING_BYTES = 131072, LDSCTL_OFF = 131072, LDS_BYTES = 147456;
constexpr int LT_SEGC = LDSCTL_OFF + 256;
constexpr int LT_SEGT = LT_SEGC + 256;
constexpr int LT_RTSEG = LT_SEGT + 320;
constexpr int LT_RK = LT_RTSEG + 1024;
constexpr int LT_NRK = LT_RK + 1280;

#define LDS_WAIT() asm volatile("s_waitcnt lgkmcnt(0)" ::: "memory")
#define LDS_BARRIER() do { asm volatile("s_waitcnt lgkmcnt(0)" ::: "memory"); __builtin_amdgcn_s_barrier(); asm volatile("" ::: "memory"); } while (0)
#define VM_WAIT() asm volatile("s_waitcnt vmcnt(0)" ::: "memory")

typedef __bf16 bf16x2_t __attribute__((ext_vector_type(2)));
__device__ __forceinline__ unsigned cvt_pk_bf16(float lo, float hi) { const f32x2 f = {lo, hi}; return __builtin_bit_cast(unsigned, __builtin_convertvector(f, bf16x2_t)); }
__device__ __forceinline__ unsigned cvt2_fp8(float a, float b, unsigned old, bool hi) { a = __builtin_amdgcn_fmed3f(a, -440.f, 440.f); b = __builtin_amdgcn_fmed3f(b, -440.f, 440.f); return hi ? __builtin_amdgcn_cvt_pk_fp8_f32(a, b, old, true) : __builtin_amdgcn_cvt_pk_fp8_f32(a, b, old, false); }
__device__ __forceinline__ unsigned q4_i8(float a, float b, float c, float d, float inv) {
    const float M = 12582912.f;
    const unsigned ua = __float_as_uint(__builtin_amdgcn_fmed3f(a * inv, -127.f, 127.f) + M), ub = __float_as_uint(__builtin_amdgcn_fmed3f(b * inv, -127.f, 127.f) + M);
    const unsigned uc = __float_as_uint(__builtin_amdgcn_fmed3f(c * inv, -127.f, 127.f) + M), ud = __float_as_uint(__builtin_amdgcn_fmed3f(d * inv, -127.f, 127.f) + M);
    return __builtin_amdgcn_perm(ub, ua, 0x0c0c0400) | __builtin_amdgcn_perm(ud, uc, 0x04000c0c);
}
__device__ __forceinline__ float bf2f(unsigned short b) { return __uint_as_float(((unsigned)b) << 16); }
__device__ __forceinline__ float bflo(unsigned w) { return __uint_as_float(w << 16); }
__device__ __forceinline__ float bfhi(unsigned w) { return __uint_as_float(w & 0xffff0000u); }
__device__ __forceinline__ unsigned short f2bf(float f) { return (unsigned short)(cvt_pk_bf16(f, 0.f) & 0xffffu); }
__device__ __forceinline__ float wave_prefix_dpp_f(float x) {
#define DPPF_(v, ctrl, rm, bc) __int_as_float(__builtin_amdgcn_update_dpp(0, __float_as_int(v), ctrl, rm, 0xf, bc))
    x += DPPF_(x, 0x111, 0xf, true); x += DPPF_(x, 0x112, 0xf, true); x += DPPF_(x, 0x114, 0xf, true); x += DPPF_(x, 0x118, 0xf, true);
    x += DPPF_(x, 0x142, 0xa, true); x += DPPF_(x, 0x143, 0xc, true);
#undef DPPF_
    return x;
}
__device__ __forceinline__ float sigmoidf_(float x) { return __builtin_amdgcn_rcpf(1.f + __expf(-x)); }
__device__ __forceinline__ float wave_sum(float v) {
#pragma unroll
    for (int o = 1; o < 64; o <<= 1) v += __shfl_xor(v, o);
    return v;
}
__device__ __forceinline__ int opaque(int v) { int r; asm volatile("v_mov_b32 %0, %1" : "=v"(r) : "v"(v)); return r; }
__device__ __forceinline__ int crow(int r, int hi) { return (r & 3) + 8 * (r >> 2) + 4 * hi; }

__device__ __forceinline__ const char* uniform_ptr(const char* p) { const unsigned long long v = (unsigned long long)p; const unsigned lo = __builtin_amdgcn_readfirstlane((unsigned)v), hi = __builtin_amdgcn_readfirstlane((unsigned)(v >> 32)); return (const char*)(((unsigned long long)hi << 32) | lo); }
namespace pg8 {
typedef int v4i_t __attribute__((ext_vector_type(4)));
typedef int v8i_t __attribute__((ext_vector_type(8)));
constexpr int BM = 256, BK = 64, HALF = 128, HTB = HALF * BK * 2, STAGE_BYTES = 8 * HTB, NXCD = 8, WGM = 8;
__host__ __device__ __forceinline__ int lds_byte(int r, int c) { const int st = (r >> 4) * 2 + (c >> 5), rr = r & 15, cc = c & 31, ob = rr * 64 + cc * 2; return st * 1024 + (ob ^ (((ob >> 9) & 1) << 5)); }
__host__ __device__ __forceinline__ void stage_rc(int b, int& R, int& C) { const int st = b / 1024, sb = b % 1024, swz = sb ^ (((sb >> 9) & 1) << 5); R = (st >> 1) * 16 + swz / 64; C = (st & 1) * 32 + (swz % 64) / 2; }
__host__ __device__ __forceinline__ int perm32(int rho) { const int n = rho >> 4, i = rho & 15; return 8 * (i >> 2) + 4 * n + (i & 3); }

struct Unit { int pm, pn; const char* A; const char* B; const int* rows; int nrows; int aux0, aux1; };

struct StaticOrder {
    int nM, nN, nwg, G, c; const char* A; const char* Bt; size_t tstep;
    __device__ void init(const void* A_, const void* Bt_, int M, int N, int K, int G_, int c_) { nM = M / BM; nN = N / BM; nwg = nM * nN; G = G_; c = c_; A = (const char*)A_; Bt = (const char*)Bt_; tstep = (size_t)BM * K * 2; }
    __device__ __forceinline__ bool next(int i, Unit& u) const { return at((long)i * G + c, u); }
    __device__ __forceinline__ bool at(long L, Unit& u) const {
        if (L < 0 || L >= nwg) return false;
        int wgid = (int)L; { const int q = nwg / NXCD, r = nwg % NXCD, xcd = wgid % NXCD, off = wgid / NXCD; wgid = (xcd < r ? xcd * (q + 1) : r * (q + 1) + (xcd - r) * q) + off; }
        const int nig = WGM * nN, gid = wgid / nig, fm = gid * WGM, gsz = (nM - fm) < WGM ? (nM - fm) : WGM;
        u.pm = fm + ((wgid % nig) % gsz); u.pn = (wgid % nig) / gsz; u.A = A + (size_t)u.pm * tstep; u.B = Bt + (size_t)u.pn * tstep; u.rows = nullptr; u.nrows = 256; u.aux0 = 0; u.aux1 = 0; return true;
    }
};

struct StaggerOrder : StaticOrder {
    __device__ __forceinline__ bool next(int i, Unit& u) const {
        if (G != 256 || nwg != 5184) return at((long)i * G + c, u);
        if (i < 20) return at((long)i * 256 + c, u);
        if (i == 20 && (c & 7) < 2) return at(5120 + (c >> 3) * 2 + (c & 7), u);
        return false;
    }
};
struct SkewOrder : StaticOrder {
    __device__ __forceinline__ bool next(int i, Unit& u) const {
        if (G != 256 || nwg != 2816) return at((long)i * G + c, u);
        if (i < 9) return at((long)i * 256 + c, u);
        if (c < 64) return false;
        const int j = c - 64;
        if (i == 9) return at(2304 + j, u);
        if (j < 128) { if (i == 10) return at(2304 + 192 + j, u); if (i == 11) return at(2304 + 192 + 128 + j, u); return false; }
        if (i == 10) return at(2304 + 192 + 256 + (j - 128), u);
        return false;
    }
};
template <class Epi, class Sched, bool ALIGN_EPI, bool GATHER, int MODE = 0>
__device__ __forceinline__ void gemm_phase(LAS unsigned char* lds, const int tid, const int K, const Sched& S, const Epi& E, const int sw = 0x79797979, const int sa = 0x7f7f7f7f) {
    const int wid = __builtin_amdgcn_readfirstlane(tid >> 6), lane = tid & 63, wr = wid >> 2, wc = wid & 3, fr = lane & 15, fq = lane >> 4;
    constexpr bool FP8 = MODE == 1, I8 = MODE == 2;
    const int nt = K / BK;
    unsigned vA[2][2], voffB[2];
    const size_t hstep = (size_t)HALF * K * 2;
#pragma unroll
    for (int i = 0; i < 2; ++i) { int R, C; stage_rc(tid * 16 + i * 8192, R, C); const int Rb = (R & ~31) + perm32(R & 31);
        vA[0][i] = (unsigned)(R * K + C) * 2u; vA[1][i] = 0u; voffB[i] = (unsigned)(Rb * K + C) * 2u; }
    const unsigned ldsw = (unsigned)wid * 1024u;
    const int aoff = lds_byte(wr * 64 + fr, fq * 8), boff = lds_byte(wc * 32 + fr, fq * 8);
#define PG8_SA(b, h) (((b) * 2 + (h)) * HTB)
#define PG8_SB(b, h) ((4 + (b) * 2 + (h)) * HTB)
#define PG8_STAGEV(bufoff, rs, soff, o0, o1) do { \
        __builtin_amdgcn_raw_ptr_buffer_load_lds(rs, (LAS void*)(lds + (bufoff) + ldsw), 16, (int)(o0), (int)(soff), 0, 0); \
        __builtin_amdgcn_raw_ptr_buffer_load_lds(rs, (LAS void*)(lds + (bufoff) + ldsw + 8192), 16, (int)(o1), (int)(soff), 0, 0); } while (0)
#define PG8_STAGEB(bufoff, rs, soff) PG8_STAGEV(bufoff, rs, soff, voffB[0], voffB[1])
#define PG8_STAGEA(bufoff, rs, soff, h) do { if constexpr (GATHER) PG8_STAGEV(bufoff, rs, soff, vA[h][0], vA[h][1]); else PG8_STAGEV(bufoff, rs, (soff) + (h) * (int)hstep, vA[0][0], vA[0][1]); } while (0)
#define PG8_RSRC(p) __builtin_amdgcn_make_buffer_rsrc((void*)uniform_ptr(p), 0, 0xffffffffu, 0x00020000)
#define PG8_LDA(dst, b, h) do { _Pragma("unroll") for (int m = 0; m < 4; ++m) _Pragma("unroll") for (int k = 0; k < 2; ++k) dst[m][k] = *(const LAS bf16x8*)(lds + PG8_SA(b, h) + aoff + m * 2048 + k * 1024); } while (0)
#define PG8_LDB(dst, b, h) do { _Pragma("unroll") for (int n = 0; n < 2; ++n) _Pragma("unroll") for (int k = 0; k < 2; ++k) dst[n][k] = *(const LAS bf16x8*)(lds + PG8_SB(b, h) + boff + n * 2048 + k * 1024); } while (0)
#define PG8_MMA(ai, bj, At, Bt) do { __builtin_amdgcn_s_setprio(1); _Pragma("unroll") for (int m = 0; m < 4; ++m) _Pragma("unroll") for (int n = 0; n < 2; ++n) _Pragma("unroll") for (int k = 0; k < 2; ++k) \
        acc[ai][bj][m][n] = __builtin_amdgcn_mfma_f32_16x16x32_bf16(Bt[n][k], At[m][k], acc[ai][bj][m][n], 0, 0, 0); __builtin_amdgcn_s_setprio(0); } while (0)
#define PG8_LDA8(dst, b, h) do { _Pragma("unroll") for (int m = 0; m < 4; ++m) { dst[m].lo = *(const LAS v4i_t*)(lds + PG8_SA(b, h) + aoff + m * 2048); dst[m].hi = *(const LAS v4i_t*)(lds + PG8_SA(b, h) + aoff + m * 2048 + 1024); } } while (0)
#define PG8_LDB8(dst, b, h) do { _Pragma("unroll") for (int n = 0; n < 2; ++n) { dst[n].lo = *(const LAS v4i_t*)(lds + PG8_SB(b, h) + boff + n * 2048); dst[n].hi = *(const LAS v4i_t*)(lds + PG8_SB(b, h) + boff + n * 2048 + 1024); } } while (0)
#define PG8_MMA8(ai, bj, At, Bt) do { __builtin_amdgcn_s_setprio(1); _Pragma("unroll") for (int m = 0; m < 4; ++m) _Pragma("unroll") for (int n = 0; n < 2; ++n) \
        acc[ai][bj][m][n] = __builtin_amdgcn_mfma_scale_f32_16x16x128_f8f6f4(Bt[n], At[m], acc[ai][bj][m][n], 0, 0, 0, sw, 0, sa); __builtin_amdgcn_s_setprio(0); } while (0)
#define PG8_MMAI(ai, bj, At, Bt) do { __builtin_amdgcn_s_setprio(1); _Pragma("unroll") for (int m = 0; m < 4; ++m) _Pragma("unroll") for (int n = 0; n < 2; ++n) _Pragma("unroll") for (int k = 0; k < 2; ++k) \
        acci[ai][bj][m][n] = __builtin_amdgcn_mfma_i32_16x16x64_i8(__builtin_bit_cast(v4i_t, Bt[n][k]), __builtin_bit_cast(v4i_t, At[m][k]), acci[ai][bj][m][n], 0, 0, 0); __builtin_amdgcn_s_setprio(0); } while (0)
#define PG8_WAIT_V(n) asm volatile("s_waitcnt vmcnt(" #n ")" ::: "memory")
#define PG8_WAIT_L(n) asm volatile("s_waitcnt lgkmcnt(" #n ")" ::: "memory")
#define PG8_BAR __builtin_amdgcn_s_barrier()
#define PG8_SCHED __builtin_amdgcn_sched_barrier(0)
    Unit cur, nxt; int ui = 0;
    if (!S.next(0, cur)) return;
    if constexpr (GATHER) {
#pragma unroll
        for (int h = 0; h < 2; ++h)
#pragma unroll
            for (int i = 0; i < 2; ++i) { int R, C; stage_rc(tid * 16 + i * 8192, R, C); const int lr = h * HALF + R; const int tok = lr < cur.nrows ? cur.rows[lr] : 0; vA[h][i] = (unsigned)tok * (unsigned)(K * 2) + (unsigned)(C * 2); }
    }
    f32x4 acc[2][2][4][2];
#pragma unroll
    for (int a = 0; a < 2; ++a)
#pragma unroll
        for (int b = 0; b < 2; ++b)
#pragma unroll
            for (int m = 0; m < 4; ++m)
#pragma unroll
                for (int n = 0; n < 2; ++n) acc[a][b][m][n] = (f32x4){0.f, 0.f, 0.f, 0.f};
    v4i_t acci[2][2][4][2];
#pragma unroll
    for (int a = 0; a < 2; ++a)
#pragma unroll
        for (int b = 0; b < 2; ++b)
#pragma unroll
            for (int m = 0; m < 4; ++m)
#pragma unroll
                for (int n = 0; n < 2; ++n) acci[a][b][m][n] = (v4i_t){0, 0, 0, 0};
    bf16x8 At[4][2], B0[2][2], B1[2][2]; v8i_t A8[4], B08[2], B18[2];
    auto rA = PG8_RSRC(cur.A), rB = PG8_RSRC(cur.B);
    const int ks = BK * 2, hs = (int)hstep;
    PG8_STAGEB(PG8_SB(0, 0), rB, 0); PG8_STAGEB(PG8_SB(0, 1), rB, hs); PG8_STAGEA(PG8_SA(0, 0), rA, 0, 0); PG8_STAGEA(PG8_SA(0, 1), rA, 0, 1);
    if (wr == 1) PG8_BAR;
    PG8_WAIT_V(2); PG8_BAR;
    PG8_STAGEB(PG8_SB(1, 0), rB, ks); PG8_STAGEA(PG8_SA(1, 0), rA, ks, 0); PG8_STAGEB(PG8_SB(1, 1), rB, hs + ks);
    PG8_WAIT_V(6); PG8_BAR;
    for (;;) {
        const bool has_next = S.next(ui + 1, nxt);
        auto rAn = rA, rBn = rB; if (has_next) { rAn = PG8_RSRC(nxt.A); rBn = PG8_RSRC(nxt.B); }
        for (int t = 0; t < nt; t += 2) {
            const bool last = (t == nt - 2);
            const int o1 = (t + 1) * ks, o2 = last ? 0 : (t + 2) * ks, o3 = o2 + ks;
            const auto rA2 = last ? rAn : rA; const auto rB2 = last ? rBn : rB;
            if constexpr (FP8) {
            PG8_LDB8(B08, 0, 0); PG8_LDB8(B18, 0, 1); PG8_SCHED; PG8_LDA8(A8, 0, 0); PG8_STAGEA(PG8_SA(1, 1), rA, o1, 1);
            PG8_WAIT_V(8); PG8_WAIT_L(0); PG8_BAR; PG8_MMA8(0, 0, A8, B08); PG8_MMA8(0, 1, A8, B18); PG8_BAR; PG8_SCHED;
            if constexpr (GATHER) { if (last && has_next) {
#pragma unroll
                for (int h = 0; h < 2; ++h)
#pragma unroll
                    for (int i = 0; i < 2; ++i) { int R, C; stage_rc(tid * 16 + i * 8192, R, C); const int lr = h * HALF + R; const int tok = lr < nxt.nrows ? nxt.rows[lr] : 0; vA[h][i] = (unsigned)tok * (unsigned)(K * 2) + (unsigned)(C * 2); } } }
            PG8_LDA8(A8, 0, 1); PG8_STAGEB(PG8_SB(0, 0), rB2, o2); PG8_STAGEB(PG8_SB(0, 1), rB2, o2 + hs); PG8_STAGEA(PG8_SA(0, 0), rA2, o2, 0);
            PG8_WAIT_V(8); PG8_WAIT_L(0); PG8_BAR; PG8_MMA8(1, 0, A8, B08); PG8_MMA8(1, 1, A8, B18); PG8_BAR; PG8_SCHED;
            PG8_LDB8(B08, 1, 0); PG8_LDB8(B18, 1, 1); PG8_SCHED; PG8_LDA8(A8, 1, 0); PG8_STAGEA(PG8_SA(0, 1), rA2, o2, 1);
            PG8_WAIT_V(8); PG8_WAIT_L(0); PG8_BAR; PG8_MMA8(0, 0, A8, B08); PG8_MMA8(0, 1, A8, B18); PG8_BAR; PG8_SCHED;
            PG8_LDA8(A8, 1, 1); PG8_STAGEB(PG8_SB(1, 0), rB2, o3); PG8_STAGEB(PG8_SB(1, 1), rB2, o3 + hs); PG8_STAGEA(PG8_SA(1, 0), rA2, o3, 0);
            PG8_WAIT_V(8); PG8_WAIT_L(0); PG8_BAR; PG8_MMA8(1, 0, A8, B08); PG8_MMA8(1, 1, A8, B18); PG8_BAR; PG8_SCHED;
            } else {
            PG8_LDB(B0, 0, 0); PG8_LDB(B1, 0, 1); PG8_SCHED; PG8_LDA(At, 0, 0); PG8_STAGEA(PG8_SA(1, 1), rA, o1, 1);
            PG8_WAIT_V(8); PG8_WAIT_L(0); PG8_BAR; if constexpr (I8) { PG8_MMAI(0, 0, At, B0); PG8_MMAI(0, 1, At, B1); } else { PG8_MMA(0, 0, At, B0); PG8_MMA(0, 1, At, B1); } PG8_BAR; PG8_SCHED;
            if constexpr (GATHER) { if (last && has_next) {
#pragma unroll
                for (int h = 0; h < 2; ++h)
#pragma unroll
                    for (int i = 0; i < 2; ++i) { int R, C; stage_rc(tid * 16 + i * 8192, R, C); const int lr = h * HALF + R; const int tok = lr < nxt.nrows ? nxt.rows[lr] : 0; vA[h][i] = (unsigned)tok * (unsigned)(K * 2) + (unsigned)(C * 2); } } }
            PG8_LDA(At, 0, 1); PG8_STAGEB(PG8_SB(0, 0), rB2, o2); PG8_STAGEB(PG8_SB(0, 1), rB2, o2 + hs); PG8_STAGEA(PG8_SA(0, 0), rA2, o2, 0);
            PG8_WAIT_V(8); PG8_WAIT_L(0); PG8_BAR; if constexpr (I8) { PG8_MMAI(1, 0, At, B0); PG8_MMAI(1, 1, At, B1); } else { PG8_MMA(1, 0, At, B0); PG8_MMA(1, 1, At, B1); } PG8_BAR; PG8_SCHED;
            PG8_LDB(B0, 1, 0); PG8_LDB(B1, 1, 1); PG8_SCHED; PG8_LDA(At, 1, 0); PG8_STAGEA(PG8_SA(0, 1), rA2, o2, 1);
            PG8_WAIT_V(8); PG8_WAIT_L(0); PG8_BAR; if constexpr (I8) { PG8_MMAI(0, 0, At, B0); PG8_MMAI(0, 1, At, B1); } else { PG8_MMA(0, 0, At, B0); PG8_MMA(0, 1, At, B1); } PG8_BAR; PG8_SCHED;
            PG8_LDA(At, 1, 1); PG8_STAGEB(PG8_SB(1, 0), rB2, o3); PG8_STAGEB(PG8_SB(1, 1), rB2, o3 + hs); PG8_STAGEA(PG8_SA(1, 0), rA2, o3, 0);
            PG8_WAIT_V(8); PG8_WAIT_L(0); PG8_BAR; if constexpr (I8) { PG8_MMAI(1, 0, At, B0); PG8_MMAI(1, 1, At, B1); } else { PG8_MMA(1, 0, At, B0); PG8_MMA(1, 1, At, B1); } PG8_BAR; PG8_SCHED;
            }
        }
        if constexpr (ALIGN_EPI) { if (wr == 0) PG8_BAR; }
        if constexpr (I8) {
#pragma unroll
            for (int a = 0; a < 2; ++a)
#pragma unroll
                for (int b = 0; b < 2; ++b)
#pragma unroll
                    for (int m = 0; m < 4; ++m)
#pragma unroll
                        for (int n = 0; n < 2; ++n) { const v4i_t q = acci[a][b][m][n]; acc[a][b][m][n] = (f32x4){(float)q[0], (float)q[1], (float)q[2], (float)q[3]}; acci[a][b][m][n] = (v4i_t){0, 0, 0, 0}; } }
        E(acc, cur, wr, wc, fr, fq);
        if (!has_next) break;
#pragma unroll
        for (int a = 0; a < 2; ++a)
#pragma unroll
            for (int b = 0; b < 2; ++b)
#pragma unroll
                for (int m = 0; m < 4; ++m)
#pragma unroll
                    for (int n = 0; n < 2; ++n) acc[a][b][m][n] = (f32x4){0.f, 0.f, 0.f, 0.f};
        cur = nxt; rA = rAn; rB = rBn; ++ui;
        if constexpr (ALIGN_EPI) { if (wr == 1) PG8_BAR; }
    }
    PG8_WAIT_V(0);
    if constexpr (!ALIGN_EPI) { if (wr == 0) PG8_BAR; }
    PG8_BAR;
#undef PG8_SA
#undef PG8_SB
#undef PG8_STAGEV
#undef PG8_STAGEB
#undef PG8_STAGEA
#undef PG8_RSRC
#undef PG8_LDA
#undef PG8_LDB
#undef PG8_MMA
#undef PG8_LDA8
#undef PG8_LDB8
#undef PG8_MMA8
#undef PG8_MMAI
#undef PG8_WAIT_V
#undef PG8_WAIT_L
#undef PG8_BAR
#undef PG8_SCHED
}
}

#define XB_TMO      128
#define XB_XCNT(j)  (256  + 64 * (j))
#define XB_XSUB(j)  (1280 + 64 * (j))
#define XB_XGEN(j)  (2304 + 64 * (j))
#define XB_TOP      3328
#define XB_TOPGEN   3392
#define XCD_BAR_WORDS 3456
#define XB_SPIN_CAP (1u << 20)
__device__ __forceinline__ unsigned xb_ld(unsigned* p)              { return __hip_atomic_load(p, __ATOMIC_RELAXED, __HIP_MEMORY_SCOPE_AGENT); }
__device__ __forceinline__ unsigned xb_add(unsigned* p, unsigned v) { return __hip_atomic_fetch_add(p, v, __ATOMIC_RELAXED, __HIP_MEMORY_SCOPE_AGENT); }
__device__ __forceinline__ unsigned xb_xcc_id() { return (unsigned)__builtin_amdgcn_s_getreg((3 << 11) | 20) & 0xFu; }
#define XB_SPIN(cond, bar) do { unsigned _sp = 0; while (cond) { __builtin_amdgcn_s_sleep(1); \
    if ((++_sp & 255u) == 0u) { if (xb_ld(&(bar)[XB_TMO])) break; if (_sp > XB_SPIN_CAP) { atomicAdd(&(bar)[XB_TMO], 1u); break; } } } } while (0)
struct XcdBarrier { unsigned* bar; unsigned x; volatile LAS unsigned* st; };
__device__ __forceinline__ XcdBarrier xcd_barrier_post(unsigned* bar, volatile LAS unsigned* st, int tid) {
    XcdBarrier b; b.bar = bar; b.x = xb_xcc_id(); b.st = st;
    if (tid == 0) (void)xb_add(&bar[XB_XCNT(b.x)], 1u);
    return b;
}
__device__ __forceinline__ void xcd_barrier_complete(unsigned* bar, unsigned x, unsigned& nloc, unsigned& nx) {
    const unsigned G = gridDim.x * gridDim.y * gridDim.z;
    unsigned sum, cnt, mine, sp = 0u;
    for (;;) {
        sum = 0u; cnt = 0u; mine = 0u;
#pragma unroll
        for (unsigned j = 0; j < 16; ++j) { const unsigned c = xb_ld(&bar[XB_XCNT(j)]); sum += c; cnt += (c > 0u) ? 1u : 0u; mine = (j == x) ? c : mine; }
        if (sum == G) break;
        __builtin_amdgcn_s_sleep(1);
        if ((++sp & 255u) == 0u) { if (xb_ld(&bar[XB_TMO])) break; if (sp > XB_SPIN_CAP) { atomicAdd(&bar[XB_TMO], 1u); break; } }
    }
    nloc = mine > 0u ? mine : 1u; nx = cnt > 0u ? cnt : 1u;
}
__device__ __forceinline__ void xcd_barrier(const XcdBarrier& b, int tid) {
    asm volatile("s_waitcnt vmcnt(0)" ::: "memory");
    __syncthreads();
    if (tid == 0) {
        unsigned* bar = b.bar;
        __builtin_amdgcn_s_waitcnt(0);
        unsigned nloc = b.st[0], nx = b.st[1];
        if (nloc == 0u) { xcd_barrier_complete(bar, b.x, nloc, nx); b.st[0] = nloc; b.st[1] = nx; }
        const unsigned old = xb_add(&bar[XB_XSUB(b.x)], 1u);
        const unsigned gen = old / nloc;
        if (old + 1u == (gen + 1u) * nloc) {
            __builtin_amdgcn_fence(__ATOMIC_RELEASE, "agent");
            asm volatile("s_waitcnt vmcnt(0)" ::: "memory");
            const unsigned og = xb_add(&bar[XB_TOP], 1u);
            const unsigned tg = og / nx;
            if (og + 1u == (tg + 1u) * nx) xb_add(&bar[XB_TOPGEN], 1u);
            else XB_SPIN(xb_ld(&bar[XB_TOPGEN]) == tg, bar);
            __builtin_amdgcn_fence(__ATOMIC_ACQUIRE, "agent");
            xb_add(&bar[XB_XGEN(b.x)], 1u);
            asm volatile("s_waitcnt vmcnt(0)" ::: "memory");
        } else {
            XB_SPIN(xb_ld(&bar[XB_XGEN(b.x)]) == gen, bar);
            __builtin_amdgcn_fence(__ATOMIC_ACQUIRE, "agent");
            asm volatile("s_waitcnt vmcnt(0)" ::: "memory");
        }
    }
    __syncthreads();
}

__device__ __forceinline__ void split_arrive(unsigned* ctr, int tid) {
    asm volatile("s_waitcnt vmcnt(0)" ::: "memory");
    __syncthreads();
    if (tid == 0) { __builtin_amdgcn_fence(__ATOMIC_RELEASE, "agent"); asm volatile("s_waitcnt vmcnt(0)" ::: "memory"); (void)xb_add(ctr, 1u); }
}
__device__ __forceinline__ void split_wait(unsigned* ctr, unsigned* bar, unsigned G, int tid) {
    asm volatile("s_waitcnt vmcnt(0)" ::: "memory");
    __syncthreads();
    if (tid == 0) { XB_SPIN(xb_ld(ctr) < G, bar); __builtin_amdgcn_fence(__ATOMIC_ACQUIRE, "agent"); asm volatile("s_waitcnt vmcnt(0)" ::: "memory"); }
    __syncthreads();
}

struct Frame {
    LAS unsigned char* lds;
    int tid, lane, wave, G, gw, NGW;
    unsigned char* ws; float* out; unsigned* ctl;
    const __attribute__((address_space(4))) void* const* kin;
    __device__ __forceinline__ const float* x() const { return (const float*)kin[0]; }
    __device__ __forceinline__ const int* pos() const { return (const int*)kin[1]; }
    __device__ __forceinline__ const float* mixw() const { return (const float*)kin[2]; }
    __device__ __forceinline__ const float* w_in() const { return (const float*)kin[3]; }
    __device__ __forceinline__ const float* qnw() const { return (const float*)kin[4]; }
    __device__ __forceinline__ const float* knw() const { return (const float*)kin[5]; }
    __device__ __forceinline__ const float* iknw() const { return (const float*)kin[6]; }
    __device__ __forceinline__ const float* convw() const { return (const float*)kin[7]; }
    __device__ __forceinline__ const float* alog() const { return (const float*)kin[8]; }
    __device__ __forceinline__ const float* dtb() const { return (const float*)kin[9]; }
    __device__ __forceinline__ const float* gnw() const { return (const float*)kin[10]; }
    __device__ __forceinline__ const float* wpa() const { return (const float*)kin[11]; }
    __device__ __forceinline__ const float* wpg() const { return (const float*)kin[12]; }
    __device__ __forceinline__ const float* wout() const { return (const float*)kin[13]; }
    __device__ __forceinline__ const float* ffnw() const { return (const float*)kin[14]; }
    __device__ __forceinline__ const float* wrg() const { return (const float*)kin[15]; }
    __device__ __forceinline__ const float* brg() const { return (const float*)kin[16]; }
    __device__ __forceinline__ const float* wre() const { return (const float*)kin[17]; }
    __device__ __forceinline__ const float* bre() const { return (const float*)kin[18]; }
    __device__ __forceinline__ const float* wg() const { return (const float*)kin[19]; }
    __device__ __forceinline__ const float* wu() const { return (const float*)kin[20]; }
    __device__ __forceinline__ const float* wd() const { return (const float*)kin[21]; }
};
#define WSP(type, off) ((type*)(F.ws + (off)))

struct RmIn { __device__ __forceinline__ int operator()(int n) const {
    if (n < 4096) return n;
    if (n < 4160) return 20480 + (n - 4096);
    if (n < 4176) return 20544 + (n - 4160);
    if (n < 12368) return 4096 + (n - 4176);
    if (n < 12384) return 20560 + (n - 12368);
    if (n < 12400) return 20576 + (n - 12384);
    return 12288 + (n - 12400); } };
struct TDesc { const float* W; bf16* WT; unsigned char* W8; int K, N, kind, off, k0, n0; float ws8; };
__device__ __forceinline__ int t_row(const TDesc& d, int n) { return d.kind == 0 ? ~RmIn{}(n) : d.kind == 1 ? ~n : d.kind == 2 ? ~(d.off + 256 * (n >> 7) + (n & 127)) : d.off + n; }
__device__ __forceinline__ void t_load(const TDesc& d, f32x4 (&raw)[8], int lane) {
    const int nn = d.n0 + 4 * (lane & 7);
#pragma unroll
    for (int j = 0; j < 8; ++j) { const float* p = d.W + (size_t)(d.k0 + (lane >> 3) + 8 * j) * d.N + nn;
        if (nn + 3 < d.N) raw[j] = *(const f32x4*)p; else { raw[j] = (f32x4){0.f, 0.f, 0.f, 0.f}; if (nn < d.N) raw[j].x = p[0]; if (nn + 1 < d.N) raw[j].y = p[1]; if (nn + 2 < d.N) raw[j].z = p[2]; } }
}
__device__ __forceinline__ void t_store(const TDesc& d, LAS float* scr, int lane) {
    const int c = lane & 7;
#pragma unroll
    for (int j = 0; j < 4; ++j) { const int n = (lane >> 3) + 8 * j; const LAS float* s = scr + (8 * c) * 33 + n;
        if (d.n0 + n < d.N) { const int row = t_row(d, d.n0 + n);
            if (row >= 0) { u32x4 o; o.x = cvt_pk_bf16(s[0 * 33], s[1 * 33]); o.y = cvt_pk_bf16(s[2 * 33], s[3 * 33]); o.z = cvt_pk_bf16(s[4 * 33], s[5 * 33]); o.w = cvt_pk_bf16(s[6 * 33], s[7 * 33]);
                *(u32x4*)(d.WT + (size_t)row * d.K + d.k0 + 8 * c) = o; }
            else if (d.kind == 0) { const float ws8 = d.ws8; *(u32x2*)(d.W8 + (size_t)(~row) * d.K + d.k0 + 8 * c) = (u32x2){q4_i8(s[0 * 33], s[1 * 33], s[2 * 33], s[3 * 33], ws8), q4_i8(s[4 * 33], s[5 * 33], s[6 * 33], s[7 * 33], ws8)}; }
            else { unsigned lo = 0u, hi = 0u; const float ws8 = d.ws8;
                lo = cvt2_fp8(s[0 * 33] * ws8, s[1 * 33] * ws8, lo, false); lo = cvt2_fp8(s[2 * 33] * ws8, s[3 * 33] * ws8, lo, true);
                hi = cvt2_fp8(s[4 * 33] * ws8, s[5 * 33] * ws8, hi, false); hi = cvt2_fp8(s[6 * 33] * ws8, s[7 * 33] * ws8, hi, true);
                *(u32x2*)(d.W8 + (size_t)(~row) * d.K + d.k0 + 8 * c) = (u32x2){lo, hi}; } } }
}
__device__ __forceinline__ void p_amax(Frame& F) {
    const f32x4* w = (const f32x4*)F.w_in(); const size_t n4 = (size_t)4096 * NIN / 4; float am = 0.f;
    for (size_t i = (size_t)F.gw * 64 + F.lane; i < n4; i += (size_t)F.NGW * 64) { const f32x4 v = w[n4 - 1 - i];
        am = fmaxf(am, fmaxf(fmaxf(fabsf(v.x), fabsf(v.y)), fmaxf(fabsf(v.z), fabsf(v.w)))); }
#pragma unroll
    for (int o = 1; o < 64; o <<= 1) am = fmaxf(am, __shfl_xor(am, o));
    if (F.lane == 0) __hip_atomic_fetch_max(F.ctl + CW_AMAX, __float_as_uint(am), __ATOMIC_RELAXED, __HIP_MEMORY_SCOPE_AGENT);
}
constexpr int CV_I_IN = 64 * 644, CV_I_PA = 32 * 128, CV_I_OUT = 64 * 128, CV_I_G = 64 * 16, CV_I_D = 8 * 128;
constexpr int CV_NITEMS = CV_I_IN + 2 * CV_I_PA + CV_I_OUT + 32 * (2 * CV_I_G + CV_I_D);
constexpr int CV_MID = 18432;
constexpr int CV_LATE = 36864;
__device__ __forceinline__ void convert_items(Frame& F, int first, int last, int w, int nw) {
    LAS float* scr = (LAS float*)(F.lds + F.wave * 16384);
    const int lane = opaque(F.lane);
    unsigned char* WIN8 = WSP(unsigned char, WS_WIN8); bf16* WPA = WSP(bf16, WS_WPA); bf16* WPG = WSP(bf16, WS_WPG); bf16* WOUT = WSP(bf16, WS_WOUT); bf16* WGU = WSP(bf16, WS_WGU); bf16* WD = WSP(bf16, WS_WD);
    constexpr int I_IN = CV_I_IN, I_PA = CV_I_PA, I_OUT = CV_I_OUT, I_G = CV_I_G, I_D = CV_I_D;
    const float winv = 127.f / fmaxf(__uint_as_float(__hip_atomic_load(F.ctl + CW_AMAX, __ATOMIC_RELAXED, __HIP_MEMORY_SCOPE_AGENT)), 1e-30f);
    auto decode = [&](int it) -> TDesc { TDesc d; int r = it; d.WT = nullptr; d.W8 = nullptr; d.off = 0; d.ws8 = 64.f;
        if (r < I_IN) { d.W = F.w_in(); d.K = 4096; d.N = NIN; d.kind = 0; d.W8 = WIN8; d.ws8 = winv; }
        else if ((r -= I_IN) < I_PA) { d.W = F.wpa(); d.K = 2048; d.N = 4096; d.kind = 1; d.W8 = (unsigned char*)WPA; d.ws8 = 32.f; }
        else if ((r -= I_PA) < I_PA) { d.W = F.wpg(); d.K = 2048; d.N = 4096; d.kind = 1; d.W8 = (unsigned char*)WPG; d.ws8 = 32.f; }
        else if ((r -= I_PA) < I_OUT) { d.W = F.wout(); d.K = 4096; d.N = 4096; d.kind = 1; d.W8 = (unsigned char*)WOUT; }
        else { r -= I_OUT; const int e = r / (2 * I_G + I_D); r -= e * (2 * I_G + I_D);
            if (r < I_G) { d.W = F.wg() + (size_t)e * 4096 * 512; d.K = 4096; d.N = 512; d.kind = 2; d.off = e * 1024; d.W8 = (unsigned char*)WGU; }
            else if ((r -= I_G) < I_G) { d.W = F.wu() + (size_t)e * 4096 * 512; d.K = 4096; d.N = 512; d.kind = 2; d.off = e * 1024 + 128; d.W8 = (unsigned char*)WGU; }
            else { r -= I_G; d.W = F.wd() + (size_t)e * 512 * 4096; d.K = 512; d.N = 4096; d.kind = 3; d.off = e * 4096; d.WT = WD; } }
        const int nblk = (d.N + 31) / 32; d.k0 = 64 * (r / nblk); d.n0 = 32 * (r % nblk); return d; };
    {
        const int it0 = first + w;
        f32x4 raw[8]; TDesc cur = decode(it0 < last ? it0 : first);
        if (it0 < last) t_load(cur, raw, lane);
        for (int it = it0; it < last; it += nw) {
#pragma unroll
            for (int j = 0; j < 8; ++j) { LAS float* q = scr + ((lane >> 3) + 8 * j) * 33 + 4 * (lane & 7); q[0] = raw[j].x; q[1] = raw[j].y; q[2] = raw[j].z; q[3] = raw[j].w; }
            TDesc nxt = cur; const bool more = it + nw < last;
            if (more) { nxt = decode(it + nw); t_load(nxt, raw, lane); }
            LDS_WAIT(); asm volatile("" ::: "memory");
            t_store(cur, scr, lane);
            LDS_WAIT(); asm volatile("" ::: "memory");
            cur = nxt;
        }
    }
}
__device__ __forceinline__ void p0_prologue(Frame& F) {
    const int gw = F.gw, NGW = F.NGW, lane = opaque(F.lane);
    unsigned char* WIN8 = WSP(unsigned char, WS_WIN8);
    convert_items(F, 0, CV_NITEMS - CV_LATE - (F.G == 256 ? CV_MID : 0), gw, NGW);
    for (int i = gw * 64 + lane; i < 144 * 256; i += NGW * 64) *((u32x4*)(WIN8 + (size_t)NIN * 4096) + i) = (u32x4){0u, 0u, 0u, 0u};
    for (int m = gw; m < T; m += NGW) {
        const f32x4* xr = (const f32x4*)(F.x() + (size_t)m * DM) + lane; f32x4 v[16]; float s = 0.f;
#pragma unroll
        for (int j = 0; j < 16; ++j) { v[j] = xr[64 * j]; s += (v[j].x * v[j].x + v[j].y * v[j].y) + (v[j].z * v[j].z + v[j].w * v[j].w); }
        const float rs = rsqrtf(wave_sum(s) * (1.f / DM) + EPS); float am = 0.f;
#pragma unroll
        for (int j = 0; j < 16; ++j) { const f32x4 w = ((const f32x4*)F.mixw())[64 * j + lane]; v[j].x *= rs * w.x; v[j].y *= rs * w.y; v[j].z *= rs * w.z; v[j].w *= rs * w.w;
            am = fmaxf(am, fmaxf(fmaxf(fabsf(v[j].x), fabsf(v[j].y)), fmaxf(fabsf(v[j].z), fabsf(v[j].w)))); }
#pragma unroll
        for (int o = 1; o < 64; o <<= 1) am = fmaxf(am, __shfl_xor(am, o));
        am = fmaxf(am, 1e-30f); const float inv = 127.f / am;
        if (lane == 0) WSP(float, WS_SA)[m] = am * (1.f / 127.f);
        unsigned* q8 = (unsigned*)(WSP(unsigned char, WS_XN8) + (size_t)m * DM) + lane;
#pragma unroll
        for (int j = 0; j < 16; ++j) q8[64 * j] = q4_i8(v[j].x, v[j].y, v[j].z, v[j].w, inv);
    }
    { float* c128 = WSP(float, WS_R128C); float* s128 = WSP(float, WS_R128S); float* c64 = WSP(float, WS_R64C); float* s64 = WSP(float, WS_R64S);
      for (int i = gw * 64 + lane; i < T * 96; i += NGW * 64) { const int t = i / 96, j = i % 96; const bool big = j < 64; const int jj = big ? j : j - 64; const float d = big ? 128.f : 64.f;
          const float inv = exp2f(-(2.f * (float)jj / d) * 13.287712379549449f);
          const float ang = (float)F.pos()[t] * inv;
          const double rev = (double)ang * 0.15915494309189535; const float fr = (float)(rev - floor(rev));
          const float cs = __builtin_amdgcn_cosf(fr), sn = __builtin_amdgcn_sinf(fr);
          if (big) { c128[t * 64 + jj] = cs; s128[t * 64 + jj] = sn; } else { c64[t * 32 + jj] = cs; s64[t * 32 + jj] = sn; } } }
    { bf16* WRF = WSP(bf16, WS_WRF);
      for (int i = gw * 64 + lane; i < 2 * 256 * 64; i += NGW * 64) { const int ln = i & 63, s = (i >> 6) & 255, ct = i >> 14; const int col = ln & 31, hh = ln >> 5;
          float v[8];
#pragma unroll
          for (int j = 0; j < 8; ++j) { const int k = 16 * s + 8 * hh + j; float w = 0.f; if (ct == 0) w = F.wre()[((size_t)(col >> 3) * 4096 + k) * 8 + (col & 7)]; else if (col < 4) w = F.wrg()[(size_t)k * 4 + col]; v[j] = w * F.ffnw()[k]; }
          unsigned hi[4], lo[4];
#pragma unroll
          for (int j = 0; j < 4; ++j) { hi[j] = cvt_pk_bf16(v[2 * j], v[2 * j + 1]); lo[j] = cvt_pk_bf16(v[2 * j] - bflo(hi[j]), v[2 * j + 1] - bfhi(hi[j])); }
          *(u32x4*)(WRF + ((size_t)((ct * 2 + 0) * 256 + s) * 64 + ln) * 8) = (u32x4){hi[0], hi[1], hi[2], hi[3]};
          *(u32x4*)(WRF + ((size_t)((ct * 2 + 1) * 256 + s) * 64 + ln) * 8) = (u32x4){lo[0], lo[1], lo[2], lo[3]}; } }
}

struct EpiProj {
    bf16* P; float* Sm; const float* SA; float sw;
    __device__ __forceinline__ void operator()(const f32x4 (&acc)[2][2][4][2], const pg8::Unit& u, int wr, int wc, int fr, int fq) const {
        int zz; asm volatile("v_mov_b32 %0, 0" : "=v"(zz)); const int row0 = u.pm * 256 + wr * 64 + fr + zz;
        float sc[2][4];
#pragma unroll
        for (int ai = 0; ai < 2; ++ai)
#pragma unroll
            for (int m = 0; m < 4; ++m) sc[ai][m] = SA[row0 + ai * 128 + m * 16] * sw;
        if (u.pn != SMALL_PN) {
            const int col0 = u.pn * 256 + wc * 32 + 8 * fq;
#pragma unroll
            for (int ai = 0; ai < 2; ++ai)
#pragma unroll
                for (int m = 0; m < 4; ++m) { const int row = row0 + ai * 128 + m * 16; bf16* rowp = P + (size_t)row * LDP + col0;
#pragma unroll
                    for (int bj = 0; bj < 2; ++bj) { const f32x4 v0 = acc[ai][bj][m][0] * sc[ai][m], v1 = acc[ai][bj][m][1] * sc[ai][m];
                        u32x4 w; w.x = cvt_pk_bf16(v0[0], v0[1]); w.y = cvt_pk_bf16(v0[2], v0[3]); w.z = cvt_pk_bf16(v1[0], v1[1]); w.w = cvt_pk_bf16(v1[2], v1[3]);
                        *(u32x4*)(rowp + bj * 128) = w; } }
        } else {
            const int col0 = wc * 32 + 8 * fq;
#pragma unroll
            for (int ai = 0; ai < 2; ++ai)
#pragma unroll
                for (int m = 0; m < 4; ++m) { const int row = row0 + ai * 128 + m * 16; float* rowp = Sm + (size_t)row * LDSM + col0;
#pragma unroll
                    for (int bj = 0; bj < 2; ++bj) { *(f32x4*)(rowp + bj * 128) = acc[ai][bj][m][0] * sc[ai][m]; *(f32x4*)(rowp + bj * 128 + 4) = acc[ai][bj][m][1] * sc[ai][m]; } }
        }
    }
};
template <bool ADD> struct EpiGate {
    bf16* O; const bf16* P; int gcol; unsigned char* O8;
    __device__ __forceinline__ void operator()(const f32x4 (&acc)[2][2][4][2], const pg8::Unit& u, int wr, int wc, int fr, int fq) const {
        int zz; asm volatile("v_mov_b32 %0, 0" : "=v"(zz)); const int row0 = u.pm * 256 + wr * 64 + fr + zz, col0 = u.pn * 256 + wc * 32 + 8 * fq;
#pragma unroll
        for (int hq = 0; hq < 4; ++hq) { const int ai = hq >> 1, mb = (hq & 1) * 2;
            u32x4 g[2][2], pv[2][2];
#pragma unroll
            for (int mm = 0; mm < 2; ++mm)
#pragma unroll
                for (int bj = 0; bj < 2; ++bj) { const size_t row = (size_t)(row0 + ai * 128 + (mb + mm) * 16); g[mm][bj] = *(const u32x4*)(P + row * LDP + gcol + col0 + bj * 128);
                    if constexpr (ADD) pv[mm][bj] = *(const u32x4*)(O + row * DM + col0 + bj * 128); }
#pragma unroll
            for (int mm = 0; mm < 2; ++mm) { const int m = mb + mm; const size_t row = (size_t)(row0 + ai * 128 + m * 16);
#pragma unroll
                for (int bj = 0; bj < 2; ++bj) { const u32x4 gg = g[mm][bj];
                    const f32x4 v0 = acc[ai][bj][m][0], v1 = acc[ai][bj][m][1];
                    float r[8] = {v0[0] * sigmoidf_(bflo(gg.x)), v0[1] * sigmoidf_(bfhi(gg.x)), v0[2] * sigmoidf_(bflo(gg.y)), v0[3] * sigmoidf_(bfhi(gg.y)),
                                  v1[0] * sigmoidf_(bflo(gg.z)), v1[1] * sigmoidf_(bfhi(gg.z)), v1[2] * sigmoidf_(bflo(gg.w)), v1[3] * sigmoidf_(bfhi(gg.w))};
                    if constexpr (ADD) { const u32x4 p = pv[mm][bj]; r[0] += bflo(p.x); r[1] += bfhi(p.x); r[2] += bflo(p.y); r[3] += bfhi(p.y); r[4] += bflo(p.z); r[5] += bfhi(p.z); r[6] += bflo(p.w); r[7] += bfhi(p.w);
                        unsigned w0 = 0u, w1 = 0u;
                        w0 = cvt2_fp8(r[0] * 32.f, r[1] * 32.f, w0, false); w0 = cvt2_fp8(r[2] * 32.f, r[3] * 32.f, w0, true);
                        w1 = cvt2_fp8(r[4] * 32.f, r[5] * 32.f, w1, false); w1 = cvt2_fp8(r[6] * 32.f, r[7] * 32.f, w1, true);
                        *(u32x2*)(O8 + row * DM + col0 + bj * 128) = (u32x2){w0, w1}; }
                    else { u32x4 w; w.x = cvt_pk_bf16(r[0], r[1]); w.y = cvt_pk_bf16(r[2], r[3]); w.z = cvt_pk_bf16(r[4], r[5]); w.w = cvt_pk_bf16(r[6], r[7]);
                        *(u32x4*)(O + row * DM + col0 + bj * 128) = w; } } }
        }
    }
};
struct EpiRes {
    bf16* O; const float* R;
    __device__ __forceinline__ void operator()(const f32x4 (&acc)[2][2][4][2], const pg8::Unit& u, int wr, int wc, int fr, int fq) const {
        int zz; asm volatile("v_mov_b32 %0, 0" : "=v"(zz)); const int row0 = u.pm * 256 + wr * 64 + fr + zz, col0 = u.pn * 256 + wc * 32 + 8 * fq;
#pragma unroll
        for (int ai = 0; ai < 2; ++ai) {
            f32x4 rv[4][2][2];
#pragma unroll
            for (int m = 0; m < 4; ++m)
#pragma unroll
                for (int bj = 0; bj < 2; ++bj) { const size_t off = (size_t)(row0 + ai * 128 + m * 16) * DM + col0 + bj * 128; rv[m][bj][0] = *(const f32x4*)(R + off); rv[m][bj][1] = *(const f32x4*)(R + off + 4); }
#pragma unroll
            for (int m = 0; m < 4; ++m)
#pragma unroll
                for (int bj = 0; bj < 2; ++bj) { const size_t off = (size_t)(row0 + ai * 128 + m * 16) * DM + col0 + bj * 128;
                    const f32x4 v0 = rv[m][bj][0] + acc[ai][bj][m][0], v1 = rv[m][bj][1] + acc[ai][bj][m][1];
                    *(u32x4*)(O + off) = (u32x4){cvt_pk_bf16(v0[0], v0[1]), cvt_pk_bf16(v0[2], v0[3]), cvt_pk_bf16(v1[0], v1[1]), cvt_pk_bf16(v1[2], v1[3])}; }
        }
    }
};

template <int K>
__device__ __forceinline__ f32x16 mma32(f32x16 acc, const LAS bf16* A, int lda, const LAS bf16* Bt, int ldb, int r, int hh) {
    const LAS bf16* ap = A + r * lda + 8 * hh; const LAS bf16* bp = Bt + r * ldb + 8 * hh;
#pragma unroll
    for (int k0 = 0; k0 < K; k0 += 16) { const bf16x8 a = *(const LAS bf16x8*)(ap + k0); const bf16x8 b = *(const LAS bf16x8*)(bp + k0); acc = __builtin_amdgcn_mfma_f32_32x32x16_bf16(a, b, acc, 0, 0, 0); }
    return acc;
}
__device__ __forceinline__ u32x4 pack8(const f32x16& a, int b0) { u32x4 w; w.x = cvt_pk_bf16(a[b0 + 0], a[b0 + 1]); w.y = cvt_pk_bf16(a[b0 + 2], a[b0 + 3]); w.z = cvt_pk_bf16(a[b0 + 4], a[b0 + 5]); w.w = cvt_pk_bf16(a[b0 + 6], a[b0 + 7]); return w; }
__device__ __forceinline__ void unpack8(f32x16& a, int b0, const u32x4 w) { a[b0 + 0] = bflo(w.x); a[b0 + 1] = bfhi(w.x); a[b0 + 2] = bflo(w.y); a[b0 + 3] = bfhi(w.y); a[b0 + 4] = bflo(w.z); a[b0 + 5] = bfhi(w.z); a[b0 + 6] = bflo(w.w); a[b0 + 7] = bfhi(w.w); }

__device__ __forceinline__ void p2_post_token(Frame& F, int tok) {
    const int lane = opaque(F.lane); const int b = tok / SEQ, s = tok % SEQ;
    const bf16* P = WSP(bf16, WS_PROJ) + (size_t)tok * LDP;
    const float* rc = WSP(float, WS_R128C) + (size_t)tok * 64; const float* rs = WSP(float, WS_R128S) + (size_t)tok * 64;
#pragma unroll
    for (int pass = 0; pass < 2; ++pass) {
        if (pass == 1 && lane >= 16) break;
        const int head = lane >> 2, sub = lane & 3;
        const bf16* src = P + (pass ? C_AK : C_AQ) + head * 128 + 16 * sub;
        const float* nw = pass ? F.knw() : F.qnw();
        const u32x4 a0 = *(const u32x4*)src, a1 = *(const u32x4*)(src + 8), b0 = *(const u32x4*)(src + 64), b1 = *(const u32x4*)(src + 72);
        float x1[16], x2[16];
        { const unsigned wa[8] = {a0.x, a0.y, a0.z, a0.w, a1.x, a1.y, a1.z, a1.w}, wb[8] = {b0.x, b0.y, b0.z, b0.w, b1.x, b1.y, b1.z, b1.w};
#pragma unroll
          for (int j = 0; j < 8; ++j) { x1[2 * j] = bflo(wa[j]); x1[2 * j + 1] = bfhi(wa[j]); x2[2 * j] = bflo(wb[j]); x2[2 * j + 1] = bfhi(wb[j]); } }
        float ss = 0.f;
#pragma unroll
        for (int e = 0; e < 16; ++e) ss += x1[e] * x1[e] + x2[e] * x2[e];
        ss += __shfl_xor(ss, 1); ss += __shfl_xor(ss, 2);
        const float rinv = rsqrtf(ss * (1.f / 128.f) + EPS);
        unsigned o1[8], o2[8];
#pragma unroll
        for (int e = 0; e < 16; e += 2) {
            float r1[2], r2[2];
#pragma unroll
            for (int q = 0; q < 2; ++q) { const int d = 16 * sub + e + q; const float c = rc[d], sn = rs[d]; const float y1 = x1[e + q] * rinv * nw[d], y2 = x2[e + q] * rinv * nw[d + 64];
                r1[q] = y1 * c - y2 * sn; r2[q] = y2 * c + y1 * sn; }
            o1[e >> 1] = cvt_pk_bf16(r1[0], r1[1]); o2[e >> 1] = cvt_pk_bf16(r2[0], r2[1]);
        }
        bf16* dst = pass ? (WSP(bf16, WS_KB) + ((size_t)(b * 4 + head) * SEQ + s) * 128 + 16 * sub) : (WSP(bf16, WS_QB) + ((size_t)(b * 16 + head) * SEQ + s) * 128 + 16 * sub);
        *(u32x4*)dst = (u32x4){o1[0], o1[1], o1[2], o1[3]}; *(u32x4*)(dst + 8) = (u32x4){o1[4], o1[5], o1[6], o1[7]};
        *(u32x4*)(dst + 64) = (u32x4){o2[0], o2[1], o2[2], o2[3]}; *(u32x4*)(dst + 72) = (u32x4){o2[4], o2[5], o2[6], o2[7]};
    }
    if (lane < 8) {
        const float* sm = WSP(float, WS_SMALL) + (size_t)tok * LDSM + SM_IK;
        const f32x4 a = *(const f32x4*)(sm + 4 * lane), c = *(const f32x4*)(sm + 32 + 4 * lane);
        float ss = (a.x * a.x + a.y * a.y) + (a.z * a.z + a.w * a.w) + (c.x * c.x + c.y * c.y) + (c.z * c.z + c.w * c.w);
        ss += __shfl_xor(ss, 1); ss += __shfl_xor(ss, 2); ss += __shfl_xor(ss, 4);
        const float rinv = rsqrtf(ss * (1.f / 64.f) + EPS);
        const float* r64c = WSP(float, WS_R64C) + (size_t)tok * 32 + 4 * lane; const float* r64s = WSP(float, WS_R64S) + (size_t)tok * 32 + 4 * lane;
        float r1[4], r2[4];
#pragma unroll
        for (int e = 0; e < 4; ++e) { const float y1 = a[e] * rinv * F.iknw()[4 * lane + e], y2 = c[e] * rinv * F.iknw()[32 + 4 * lane + e]; const float cs = r64c[e], sn = r64s[e]; r1[e] = y1 * cs - y2 * sn; r2[e] = y2 * cs + y1 * sn; }
        const int tile = s >> 5, cc = s & 31, p = lane >> 1;
        bf16* base = WSP(bf16, WS_IKF);
        { const int ks = p >> 1, hf = p & 1; *(u32x2*)(base + ((size_t)((b * 128 + tile) * 4 + ks) * 64 + hf * 32 + cc) * 8 + 4 * (lane & 1)) = (u32x2){cvt_pk_bf16(r1[0], r1[1]), cvt_pk_bf16(r1[2], r1[3])}; }
        { const int ks = (p >> 1) + 2, hf = p & 1; *(u32x2*)(base + ((size_t)((b * 128 + tile) * 4 + ks) * 64 + hf * 32 + cc) * 8 + 4 * (lane & 1)) = (u32x2){cvt_pk_bf16(r2[0], r2[1]), cvt_pk_bf16(r2[2], r2[3])}; }
    }
}

constexpr int G_QH = 0, G_KH = 17408, G_VBT = 35840, G_KBT = 54272, G_KDT = 72704, G_L = 91136, G_TM = 109568, G_IN = 118784, G_SM = 128000;
constexpr int G_WT = G_KH, G_UT = G_L;
constexpr int G_CW = 135168;
__device__ __forceinline__ void gdn_chunk(Frame& F, int cid, const int gm = 9) {
    const int lane = opaque(F.lane), wid = F.wave, tid = wid * 64 + lane, r = lane & 31, hh = lane >> 5;
    const int b = cid >> 10, h = (cid >> 6) & 15, n = cid & 63, t0 = n * 64, row0 = b * SEQ + t0;
    LAS bf16* Qh = (LAS bf16*)(F.lds + G_QH); LAS bf16* Kh = (LAS bf16*)(F.lds + G_KH); LAS bf16* VbT = (LAS bf16*)(F.lds + G_VBT); LAS bf16* KbT = (LAS bf16*)(F.lds + G_KBT);
    LAS bf16* KdT = (LAS bf16*)(F.lds + G_KDT); LAS float* Lf = (LAS float*)(F.lds + G_L); LAS bf16* Tm = (LAS bf16*)(F.lds + G_TM); LAS bf16* In = (LAS bf16*)(F.lds + G_IN);
    LAS bf16* WT = (LAS bf16*)(F.lds + G_WT); LAS bf16* UT = (LAS bf16*)(F.lds + G_UT);
    LAS bf16* Vh = (LAS bf16*)(F.lds + G_L);
    LAS bf16* T11t = (LAS bf16*)(F.lds + G_KH); LAS bf16* Xt = T11t + 32 * 40;
    LAS float* sm_gc = (LAS float*)(F.lds + G_SM); LAS float* sm_beta = sm_gc + 64; LAS float* sm_eg = sm_gc + 128; LAS float* sm_ed = sm_gc + 192;
    const bf16* PROJ = WSP(bf16, WS_PROJ); const float* SMALL = WSP(float, WS_SMALL);
    const int rr = tid >> 3, c0 = 16 * (tid & 7);
    u32x4 raw[3][4][2];
#pragma unroll
    for (int tz = 0; tz < 3; ++tz)
#pragma unroll
        for (int m = 0; m < 4; ++m) { const int trow = t0 + rr - 3 + m; const int tr = trow < 0 ? 0 : trow;
            const bf16* src = PROJ + (size_t)(b * SEQ + tr) * LDP + (tz == 0 ? C_GQ : tz == 1 ? C_GK : C_GV) + h * 128 + c0;
            raw[tz][m][0] = *(const u32x4*)src; raw[tz][m][1] = *(const u32x4*)(src + 8); }
    if (wid == 0) {
        const float a = SMALL[(size_t)(row0 + lane) * LDSM + SM_GA + h], bb = SMALL[(size_t)(row0 + lane) * LDSM + SM_GB + h];
        const float xx = a + F.dtb()[h]; const float sp = xx > 20.f ? xx : log1pf(__expf(xx));
        float gc = -__expf(F.alog()[h]) * sp;
        gc = wave_prefix_dpp_f(gc);
        const float Gl = __int_as_float(__builtin_amdgcn_readlane(__float_as_int(gc), 63));
        sm_gc[lane] = gc; sm_beta[lane] = sigmoidf_(bb); sm_eg[lane] = __expf(gc); sm_ed[lane] = __expf(Gl - gc);
        if (lane == 0) WSP(float, WS_GG)[cid] = __expf(Gl);
    }
    __syncthreads();
    {
        const LAS float* CW = (const LAS float*)(F.lds + G_CW);
#pragma unroll
        for (int tz = 0; tz < 3; ++tz) {
            float y[16];
#pragma unroll
            for (int e = 0; e < 16; ++e) y[e] = 0.f;
#pragma unroll
            for (int m = 0; m < 4; ++m) {
                const float on = (t0 + rr - 3 + m) >= 0 ? 1.f : 0.f;
                const LAS float* cw = CW + (tz * 4 + m) * 128 + c0;
                const f32x4 w0 = *(const LAS f32x4*)cw * on, w1 = *(const LAS f32x4*)(cw + 4) * on, w2 = *(const LAS f32x4*)(cw + 8) * on, w3 = *(const LAS f32x4*)(cw + 12) * on;
                const u32x4 a0 = raw[tz][m][0], a1 = raw[tz][m][1];
                y[0] += w0.x * bflo(a0.x); y[1] += w0.y * bfhi(a0.x); y[2] += w0.z * bflo(a0.y); y[3] += w0.w * bfhi(a0.y);
                y[4] += w1.x * bflo(a0.z); y[5] += w1.y * bfhi(a0.z); y[6] += w1.z * bflo(a0.w); y[7] += w1.w * bfhi(a0.w);
                y[8] += w2.x * bflo(a1.x); y[9] += w2.y * bfhi(a1.x); y[10] += w2.z * bflo(a1.y); y[11] += w2.w * bfhi(a1.y);
                y[12] += w3.x * bflo(a1.z); y[13] += w3.y * bfhi(a1.z); y[14] += w3.z * bflo(a1.w); y[15] += w3.w * bfhi(a1.w);
            }
            float ss = 0.f;
#pragma unroll
            for (int e = 0; e < 16; ++e) { y[e] = y[e] * sigmoidf_(y[e]); ss += y[e] * y[e]; }
            if (tz < 2) { ss += __shfl_xor(ss, 1); ss += __shfl_xor(ss, 2); ss += __shfl_xor(ss, 4); const float rinv = rsqrtf(ss + EPS) * (tz == 0 ? 0.08838834764831845f : 1.f);
#pragma unroll
                for (int e = 0; e < 16; ++e) y[e] *= rinv; }
            LAS bf16* d = (tz == 0 ? Qh : tz == 1 ? Kh : Vh) + rr * 136 + c0;
            *(LAS u32x4*)d = (u32x4){cvt_pk_bf16(y[0], y[1]), cvt_pk_bf16(y[2], y[3]), cvt_pk_bf16(y[4], y[5]), cvt_pk_bf16(y[6], y[7])};
            *(LAS u32x4*)(d + 8) = (u32x4){cvt_pk_bf16(y[8], y[9]), cvt_pk_bf16(y[10], y[11]), cvt_pk_bf16(y[12], y[13]), cvt_pk_bf16(y[14], y[15])};
        }
    }
    __syncthreads();
    if (gm == 1) return;
    {
        const int i = lane, c0 = 16 * wid; const float beta = sm_beta[i], eg = sm_eg[i], ed = sm_ed[i];
        const u32x4 k0 = *(const LAS u32x4*)(Kh + i * 136 + c0), k1 = *(const LAS u32x4*)(Kh + i * 136 + c0 + 8), v0 = *(const LAS u32x4*)(Vh + i * 136 + c0), v1 = *(const LAS u32x4*)(Vh + i * 136 + c0 + 8);
        const unsigned kw[8] = {k0.x, k0.y, k0.z, k0.w, k1.x, k1.y, k1.z, k1.w}, vw[8] = {v0.x, v0.y, v0.z, v0.w, v1.x, v1.y, v1.z, v1.w};
#pragma unroll
        for (int q = 0; q < 8; ++q) { const float ka = bflo(kw[q]), kb = bfhi(kw[q]), va = bflo(vw[q]), vb = bfhi(vw[q]);
            KbT[(c0 + 2 * q) * 72 + i] = f2bf(ka * beta * eg); KbT[(c0 + 2 * q + 1) * 72 + i] = f2bf(kb * beta * eg);
            KdT[(c0 + 2 * q) * 72 + i] = f2bf(ka * ed); KdT[(c0 + 2 * q + 1) * 72 + i] = f2bf(kb * ed);
            VbT[(c0 + 2 * q) * 72 + i] = f2bf(va * beta); VbT[(c0 + 2 * q + 1) * 72 + i] = f2bf(vb * beta); }
    }
    __syncthreads();
    if (gm == 2) return;
    if (wid < 6) {
        const int which = wid / 3, ti = wid % 3, a = ti ? 1 : 0, bt = ti == 2 ? 1 : 0;
        f32x16 acc = {};
        acc = mma32<128>(acc, (which ? Qh : Kh) + 32 * a * 136, 136, Kh + 32 * bt * 136, 136, r, hh);
        const int j = 32 * bt + r; const float gcj = sm_gc[j];
#pragma unroll
        for (int i = 0; i < 16; ++i) { const int ii = 32 * a + crow(i, hh); const float dec = __expf(sm_gc[ii] - gcj);
            if (which == 0) Lf[ii * 72 + j] = (ii > j) ? sm_beta[ii] * acc[i] * dec : 0.f;
            else In[ii * 72 + j] = f2bf((ii >= j) ? acc[i] * dec : 0.f); }
    } else if (wid == 6) {
#pragma unroll
        for (int i = 0; i < 16; ++i) In[(2 * i + hh) * 72 + 32 + r] = 0;
    }
    __syncthreads();
    if (gm == 3) return;
    if (wid == 0) {
        const int hb = lane >> 5, cc = lane & 31;
        int zoff; asm volatile("v_mov_b32 %0, 0" : "=v"(zoff));
        const LAS float* Ld = Lf + (32 * hb) * 72 + 32 * hb + zoff;
        float x[32];
#pragma unroll
        for (int i = 0; i < 32; ++i) {
            float v = (i == cc) ? 1.f : 0.f;
#pragma unroll
            for (int j4 = 0; j4 < i; j4 += 4) { const f32x4 l4 = *(const LAS f32x4*)(Ld + i * 72 + j4);
                v -= l4.x * x[j4]; if (j4 + 1 < i) v -= l4.y * x[j4 + 1]; if (j4 + 2 < i) v -= l4.z * x[j4 + 2]; if (j4 + 3 < i) v -= l4.w * x[j4 + 3]; }
            x[i] = v; Tm[(32 * hb + i) * 72 + 32 * hb + cc] = f2bf(v);
            if (hb == 0) Tm[i * 72 + 32 + cc] = 0;
        }
        if (hb == 0) {
#pragma unroll
            for (int q = 0; q < 4; ++q) *(LAS u32x4*)(T11t + cc * 40 + 8 * q) = (u32x4){cvt_pk_bf16(x[8 * q], x[8 * q + 1]), cvt_pk_bf16(x[8 * q + 2], x[8 * q + 3]), cvt_pk_bf16(x[8 * q + 4], x[8 * q + 5]), cvt_pk_bf16(x[8 * q + 6], x[8 * q + 7])}; }
        f32x16 X = {};
#pragma unroll
        for (int ks = 0; ks < 2; ++ks) { const LAS float* lp = Lf + (32 + r) * 72 + 16 * ks + 8 * hh; const f32x4 l0 = *(const LAS f32x4*)lp, l1 = *(const LAS f32x4*)(lp + 4);
            const u32x4 aw = {cvt_pk_bf16(l0.x, l0.y), cvt_pk_bf16(l0.z, l0.w), cvt_pk_bf16(l1.x, l1.y), cvt_pk_bf16(l1.z, l1.w)};
            const bf16x8 bb = *(const LAS bf16x8*)(T11t + r * 40 + 16 * ks + 8 * hh);
            X = __builtin_amdgcn_mfma_f32_32x32x16_bf16(*(const bf16x8*)&aw, bb, X, 0, 0, 0); }
#pragma unroll
        for (int g = 0; g < 4; ++g) *(LAS u32x2*)(Xt + r * 40 + 8 * g + 4 * hh) = (u32x2){cvt_pk_bf16(X[4 * g], X[4 * g + 1]), cvt_pk_bf16(X[4 * g + 2], X[4 * g + 3])};
        f32x16 Y = {};
#pragma unroll
        for (int ks = 0; ks < 2; ++ks) { const bf16x8 aa = *(const LAS bf16x8*)(Tm + (32 + r) * 72 + 32 + 16 * ks + 8 * hh); const bf16x8 bb = *(const LAS bf16x8*)(Xt + r * 40 + 16 * ks + 8 * hh);
            Y = __builtin_amdgcn_mfma_f32_32x32x16_bf16(aa, bb, Y, 0, 0, 0); }
#pragma unroll
        for (int i = 0; i < 16; ++i) Tm[(32 + crow(i, hh)) * 72 + r] = f2bf(-Y[i]);
    }
    __syncthreads();
    if (gm == 4) return;
#ifdef DBG_G1
    {
        u32x4* GQd = WSP(u32x4, WS_GQ) + (size_t)cid * 1024; u32x4* GOd = WSP(u32x4, WS_GO) + (size_t)cid * 1024;
        const int row = tid >> 3, c8 = (tid & 7) * 8;
        GQd[tid] = *(const LAS u32x4*)((LAS bf16*)(F.lds + DBG_G1_A) + row * 72 + c8); GOd[tid] = *(const LAS u32x4*)((LAS bf16*)(F.lds + DBG_G1_B) + row * 72 + c8);
        GQd[512 + tid] = (u32x4){0u, 0u, 0u, 0u}; GOd[512 + tid] = (u32x4){0u, 0u, 0u, 0u};
        __syncthreads(); return;
    }
#endif
#pragma unroll
    for (int q = 0; q < 2; ++q) { const int idx = 2 * wid + q, which = idx >> 3, a = (idx >> 2) & 1, bt = idx & 3;
        f32x16 acc = {};
        acc = mma32<64>(acc, Tm + 32 * a * 72, 72, (which ? KbT : VbT) + 32 * bt * 72, 72, r, hh);
        LAS bf16* dst = (which ? WT : UT) + (32 * bt + r) * 72 + 32 * a + 4 * hh;
#pragma unroll
        for (int g = 0; g < 4; ++g) *(LAS u32x2*)(dst + 8 * g) = (u32x2){cvt_pk_bf16(acc[4 * g], acc[4 * g + 1]), cvt_pk_bf16(acc[4 * g + 2], acc[4 * g + 3])};
    }
    __syncthreads();
    if (gm == 5) return;
    {
        u32x4* GP = (u32x4*)F.out + (size_t)cid * 2048;
        u32x4* GB = (u32x4*)((unsigned char*)F.out + 128 * MiB) + (size_t)cid * 2048;
        u32x4* GQ = WSP(u32x4, WS_GQ) + (size_t)cid * 1024;
        u32x4* GO = WSP(u32x4, WS_GO) + (size_t)cid * 1024;
#pragma unroll
        for (int q = 0; q < 2; ++q) { const int idx = 2 * wid + q, a = idx >> 2, bt = idx & 3;
            { f32x16 acc = {}; acc = mma32<64>(acc, WT + 32 * a * 72, 72, KdT + 32 * bt * 72, 72, r, hh);
#pragma unroll
              for (int i = 0; i < 16; ++i) acc[i] = -acc[i];
              GP[(bt * 8 + 2 * a) * 64 + lane] = pack8(acc, 0); GP[(bt * 8 + 2 * a + 1) * 64 + lane] = pack8(acc, 8); }
            { f32x16 acc = {}; acc = mma32<64>(acc, KdT + 32 * a * 72, 72, UT + 32 * bt * 72, 72, r, hh);
              GB[((bt * 4 + a) * 2) * 64 + lane] = pack8(acc, 0); GB[((bt * 4 + a) * 2 + 1) * 64 + lane] = pack8(acc, 8); }
        }
        { const int a = wid >> 1, bt = wid & 1;
          f32x16 acc = {}; acc = mma32<64>(acc, WT + 32 * a * 72, 72, In + 32 * bt * 72, 72, r, hh);
          const int ii = 32 * bt + r; const float eg = sm_eg[ii];
#pragma unroll
          for (int g = 0; g < 4; ++g) { const u32x2 qv = *(const LAS u32x2*)(Qh + ii * 136 + 32 * a + 8 * g + 4 * hh);
              acc[4 * g] = bflo(qv.x) * eg - acc[4 * g]; acc[4 * g + 1] = bfhi(qv.x) * eg - acc[4 * g + 1]; acc[4 * g + 2] = bflo(qv.y) * eg - acc[4 * g + 2]; acc[4 * g + 3] = bfhi(qv.y) * eg - acc[4 * g + 3]; }
          GQ[(bt * 8 + 2 * a) * 64 + lane] = pack8(acc, 0); GQ[(bt * 8 + 2 * a + 1) * 64 + lane] = pack8(acc, 8); }
        { const int a = wid >> 2, bt = wid & 3;
          f32x16 acc = {}; acc = mma32<64>(acc, In + 32 * a * 72, 72, UT + 32 * bt * 72, 72, r, hh);
          GO[((bt * 2 + a) * 2) * 64 + lane] = pack8(acc, 0); GO[((bt * 2 + a) * 2 + 1) * 64 + lane] = pack8(acc, 8); }
    }
    LDS_BARRIER();
}

__device__ __forceinline__ void gdn_scan_wg(Frame& F, int bh, int half) {
    const int lane = opaque(F.lane), wid = F.wave, r = lane & 31, hh = lane >> 5, grp = wid >> 2, a = wid & 3, slice = 2 * half + grp; const int b = bh >> 4, h = bh & 15;
    LAS u32x4* SB = (LAS u32x4*)F.lds + grp * 1024;
    const float* GG = WSP(float, WS_GG); bf16* OSC = WSP(bf16, WS_OSC);
    const u32x4* GPb = (const u32x4*)F.out + (size_t)bh * 64 * 2048 + (a * 8) * 64 + lane;
    const u32x4* GBb = (const u32x4*)((unsigned char*)F.out + 128 * MiB) + (size_t)bh * 64 * 2048 + slice * 512 + (a * 2) * 64 + lane;
    const u32x4* GQb = WSP(u32x4, WS_GQ) + (size_t)bh * 64 * 1024 + ((a & 1) * 8) * 64 + lane;
    const u32x4* GOb = WSP(u32x4, WS_GO) + (size_t)bh * 64 * 1024 + slice * 256 + ((a & 1) * 2) * 64 + lane;
    f32x16 S = {};
    u32x4 Pv[8], Bv[2], Qv[8], Ov[2]; float gam;
#pragma unroll
    for (int s = 0; s < 8; ++s) Pv[s] = GPb[s * 64];
    Bv[0] = GBb[0]; Bv[1] = GBb[64]; gam = GG[bh * 64];
    if (a < 2) {
#pragma unroll
        for (int s = 0; s < 8; ++s) Qv[s] = GQb[s * 64];
        Ov[0] = GOb[0]; Ov[1] = GOb[64]; }
    for (int n = 0; n < 64; ++n) {
        LAS u32x4* sb = SB + (n & 1) * 512;
        sb[(2 * a) * 64 + lane] = pack8(S, 0); sb[(2 * a + 1) * 64 + lane] = pack8(S, 8);
        asm volatile("s_waitcnt lgkmcnt(0)" ::: "memory"); __builtin_amdgcn_s_barrier(); asm volatile("" ::: "memory");
        u32x4 sf[8];
#pragma unroll
        for (int s = 0; s < 8; ++s) sf[s] = sb[s * 64 + lane];
        f32x16 c; unpack8(c, 0, Bv[0]); unpack8(c, 8, Bv[1]);
#pragma unroll
        for (int i = 0; i < 16; ++i) c[i] += gam * S[i];
#pragma unroll
        for (int s = 0; s < 8; ++s) c = __builtin_amdgcn_mfma_f32_32x32x16_bf16(*(const bf16x8*)&Pv[s], *(const bf16x8*)&sf[s], c, 0, 0, 0);
        S = c;
        if (n + 1 < 64) { const size_t o1 = (size_t)(n + 1) * 2048;
#pragma unroll
            for (int s = 0; s < 8; ++s) Pv[s] = GPb[o1 + s * 64];
            Bv[0] = GBb[o1]; Bv[1] = GBb[o1 + 64]; gam = GG[bh * 64 + n + 1]; }
        if (a < 2) {
            f32x16 o; unpack8(o, 0, Ov[0]); unpack8(o, 8, Ov[1]);
#pragma unroll
            for (int s = 0; s < 8; ++s) o = __builtin_amdgcn_mfma_f32_32x32x16_bf16(*(const bf16x8*)&Qv[s], *(const bf16x8*)&sf[s], o, 0, 0, 0);
            if (n + 1 < 64) { const size_t o2 = (size_t)(n + 1) * 1024;
#pragma unroll
                for (int s = 0; s < 8; ++s) Qv[s] = GQb[o2 + s * 64];
                Ov[0] = GOb[o2]; Ov[1] = GOb[o2 + 64]; }
            bf16* op = OSC + (size_t)(b * SEQ + n * 64 + 32 * a) * 2048 + h * 128 + 32 * slice + r;
#pragma unroll
            for (int i = 0; i < 16; ++i) op[(size_t)crow(i, hh) * 2048] = f2bf(o[i]);
        }
    }
    __syncthreads();
}

__device__ __forceinline__ void ya_to_fp8_token(Frame& F, int tok) {
    const int lane = opaque(F.lane);
    const bf16* src = WSP(bf16, WS_YA) + (size_t)tok * 2048 + 32 * lane;
    unsigned char* dst = WSP(unsigned char, WS_YA8) + (size_t)tok * 2048 + 32 * lane;
    unsigned o[8];
#pragma unroll
    for (int q = 0; q < 4; ++q) { const u32x4 a = *(const u32x4*)(src + 8 * q);
        unsigned w0 = 0u, w1 = 0u;
        w0 = cvt2_fp8(bflo(a.x) * 32.f, bfhi(a.x) * 32.f, w0, false); w0 = cvt2_fp8(bflo(a.y) * 32.f, bfhi(a.y) * 32.f, w0, true);
        w1 = cvt2_fp8(bflo(a.z) * 32.f, bfhi(a.z) * 32.f, w1, false); w1 = cvt2_fp8(bflo(a.w) * 32.f, bfhi(a.w) * 32.f, w1, true);
        o[2 * q] = w0; o[2 * q + 1] = w1; }
    *(u32x4*)dst = (u32x4){o[0], o[1], o[2], o[3]}; *(u32x4*)(dst + 16) = (u32x4){o[4], o[5], o[6], o[7]};
}
__device__ __forceinline__ void gdn_norm_token(Frame& F, int tok) {
    const int lane = opaque(F.lane), head = lane >> 2, sub = lane & 3;
    bf16* o = WSP(bf16, WS_OSC) + (size_t)tok * 2048 + head * 128 + 32 * sub;
    const bf16* z = WSP(bf16, WS_PROJ) + (size_t)tok * LDP + C_GZ + head * 128 + 32 * sub;
    float v[32], zz[32]; float ss = 0.f;
#pragma unroll
    for (int q = 0; q < 4; ++q) { const u32x4 a = *(const u32x4*)(o + 8 * q), c = *(const u32x4*)(z + 8 * q); const unsigned wa[4] = {a.x, a.y, a.z, a.w}, wc[4] = {c.x, c.y, c.z, c.w};
#pragma unroll
        for (int j = 0; j < 4; ++j) { v[8 * q + 2 * j] = bflo(wa[j]); v[8 * q + 2 * j + 1] = bfhi(wa[j]); zz[8 * q + 2 * j] = bflo(wc[j]); zz[8 * q + 2 * j + 1] = bfhi(wc[j]); } }
#pragma unroll
    for (int e = 0; e < 32; ++e) ss += v[e] * v[e];
    ss += __shfl_xor(ss, 1); ss += __shfl_xor(ss, 2);
    const float rinv = rsqrtf(ss * (1.f / 128.f) + EPS);
#pragma unroll
    for (int q = 0; q < 4; ++q) { unsigned w[4];
#pragma unroll
        for (int j = 0; j < 4; ++j) { const int e = 8 * q + 2 * j; const float y0 = v[e] * rinv * F.gnw()[32 * sub + e] * (zz[e] * sigmoidf_(zz[e])), y1 = v[e + 1] * rinv * F.gnw()[32 * sub + e + 1] * (zz[e + 1] * sigmoidf_(zz[e + 1])); w[j] = cvt2_fp8(y0 * 8.f, y1 * 8.f, 0u, false) & 0xffffu; }
        *(u32x2*)((unsigned char*)F.out + (size_t)tok * 2048 + head * 128 + 32 * sub + 8 * q) = (u32x2){w[0] | (w[1] << 16), w[2] | (w[3] << 16)}; }
}

__device__ __forceinline__ unsigned lt1(unsigned cand, unsigned key) { unsigned d; asm("v_sub_u32 %0, %1, %2 clamp\n\tv_min_u32 %0, 1, %0" : "=v"(d) : "v"(cand), "v"(key)); return d; }
__device__ __forceinline__ float relu1(float x) { const int b = __float_as_int(x); return __int_as_float(b > 0 ? b : 0); }
__device__ __forceinline__ unsigned lt1pk(unsigned cand2, unsigned key2, unsigned one2) { unsigned d; asm("v_pk_sub_u16 %0, %1, %2 clamp\n\tv_pk_min_u16 %0, %0, %3" : "=&v"(d) : "v"(cand2), "v"(key2), "v"(one2)); return d; }
__device__ __forceinline__ int wave_sum_dpp(int v) {
    v += __builtin_amdgcn_update_dpp(0, v, 0x111, 0xf, 0xf, true);
    v += __builtin_amdgcn_update_dpp(0, v, 0x112, 0xf, 0xf, true);
    v += __builtin_amdgcn_update_dpp(0, v, 0x114, 0xf, 0xf, true);
    v += __builtin_amdgcn_update_dpp(0, v, 0x118, 0xf, 0xf, true);
    v += __builtin_amdgcn_update_dpp(0, v, 0x142, 0xa, 0xf, true);
    v += __builtin_amdgcn_update_dpp(0, v, 0x143, 0xc, 0xf, true);
    return __builtin_amdgcn_readlane(v, 63);
}
__device__ __forceinline__ unsigned mono_key(float f) { const unsigned u = __float_as_uint(f); return (u & 0x80000000u) ? ~u : (u | 0x80000000u); }
__device__ __forceinline__ void idx_unit(Frame& F, int b, int t0, const int mode = 3) {
    const int lane = opaque(F.lane), wid = F.wave, r = lane & 31, hh = lane >> 5;
    LAS unsigned* SC = (LAS unsigned*)F.lds;
    const bf16* PROJ = WSP(bf16, WS_PROJ); const float* SMALL = WSP(float, WS_SMALL);
    bf16x8 af[4][4]; float w[4][16];
#pragma unroll
    for (int rt = 0; rt < 4; ++rt) {
        const int tq = t0 + 2 * rt + ((r >> 2) & 1), head = (r & 3) + 4 * (r >> 3); const size_t tok = (size_t)b * SEQ + tq;
        const bf16* src = PROJ + tok * LDP + C_IQ + head * 64 + 8 * hh;
        u32x4 raw[4];
#pragma unroll
        for (int ks = 0; ks < 4; ++ks) raw[ks] = *(const u32x4*)(src + 16 * ks);
        const float* rc = WSP(float, WS_R64C) + tok * 32 + 8 * hh; const float* rs = WSP(float, WS_R64S) + tok * 32 + 8 * hh;
#pragma unroll
        for (int ks = 0; ks < 2; ++ks) {
            const f32x4 c0 = *(const f32x4*)(rc + 16 * ks), c1 = *(const f32x4*)(rc + 16 * ks + 4), s0 = *(const f32x4*)(rs + 16 * ks), s1 = *(const f32x4*)(rs + 16 * ks + 4);
            const float cs[8] = {c0.x, c0.y, c0.z, c0.w, c1.x, c1.y, c1.z, c1.w}, sn[8] = {s0.x, s0.y, s0.z, s0.w, s1.x, s1.y, s1.z, s1.w};
            const unsigned wa[4] = {raw[ks].x, raw[ks].y, raw[ks].z, raw[ks].w}, wb[4] = {raw[ks + 2].x, raw[ks + 2].y, raw[ks + 2].z, raw[ks + 2].w};
            unsigned o1[4], o2[4];
#pragma unroll
            for (int j = 0; j < 4; ++j) { const float x1a = bflo(wa[j]), x1b = bfhi(wa[j]), x2a = bflo(wb[j]), x2b = bfhi(wb[j]);
                o1[j] = cvt_pk_bf16(x1a * cs[2 * j] - x2a * sn[2 * j], x1b * cs[2 * j + 1] - x2b * sn[2 * j + 1]);
                o2[j] = cvt_pk_bf16(x2a * cs[2 * j] + x1a * sn[2 * j], x2b * cs[2 * j + 1] + x1b * sn[2 * j + 1]); }
            const u32x4 v1 = {o1[0], o1[1], o1[2], o1[3]}, v2 = {o2[0], o2[1], o2[2], o2[3]};
            af[rt][ks] = *(const bf16x8*)&v1; af[rt][ks + 2] = *(const bf16x8*)&v2;
        }
        const float* wp = SMALL + ((size_t)b * SEQ + t0 + 2 * rt + hh) * LDSM + SM_IW;
#pragma unroll
        for (int q = 0; q < 4; ++q) { const f32x4 v = *(const f32x4*)(wp + 4 * q); w[rt][4 * q] = v.x * 0.03125f; w[rt][4 * q + 1] = v.y * 0.03125f; w[rt][4 * q + 2] = v.z * 0.03125f; w[rt][4 * q + 3] = v.w * 0.03125f; }
    }
    const int ntiles = (t0 + 8 + 31) >> 5;
    if (mode & 1) {
    const u32x4* IKF = WSP(u32x4, WS_IKF) + (size_t)b * 128 * 4 * 64;
    if (wid < ntiles) {
        u32x4 bfr[4], bnx[4];
#pragma unroll
        for (int ks = 0; ks < 4; ++ks) bfr[ks] = IKF[(size_t)(wid * 4 + ks) * 64 + lane];
        auto mm = [&](const u32x4 (&bf)[4], int rt) { f32x16 acc = {};
#pragma unroll
            for (int ks = 0; ks < 4; ++ks) acc = __builtin_amdgcn_mfma_f32_32x32x16_bf16(af[rt][ks], *(const bf16x8*)&bf[ks], acc, 0, 0, 0);
            return acc; };
        auto fin = [&](int rt, const f32x16& acc, int skey) {
            float s0 = 0.f, s1 = 0.f, s2 = 0.f, s3 = 0.f;
#pragma unroll
            for (int i = 0; i < 16; i += 4) { s0 += w[rt][i] * relu1(acc[i]); s1 += w[rt][i + 1] * relu1(acc[i + 1]); s2 += w[rt][i + 2] * relu1(acc[i + 2]); s3 += w[rt][i + 3] * relu1(acc[i + 3]); }
            const float sc = (s0 + s1) + (s2 + s3);
            const int ql = 2 * rt + hh;
            SC[ql * 4096 + ((skey & ~63) | ((skey + 4 * (skey >> 6)) & 63))] = (skey <= t0 + ql) ? mono_key(sc) : 0u; };
        f32x16 a0 = mm(bfr, 0), a1;
        for (int j = wid; j < ntiles; j += 8) {
            const bool more = j + 8 < ntiles;
            if (more) {
#pragma unroll
                for (int ks = 0; ks < 4; ++ks) bnx[ks] = IKF[(size_t)((j + 8) * 4 + ks) * 64 + lane]; }
            const int skey = 32 * j + r;
            a1 = mm(bfr, 1); fin(0, a0, skey);
            a0 = mm(bfr, 2); fin(1, a1, skey);
            a1 = mm(bfr, 3); fin(2, a0, skey);
            if (more) {
#pragma unroll
                for (int ks = 0; ks < 4; ++ks) bfr[ks] = bnx[ks];
                a0 = mm(bfr, 0); }
            fin(3, a1, skey);
        }
    }
    }
    __syncthreads();
    if (mode & 2) {
        const int tq = t0 + wid, lim = ntiles * 32;
        unsigned key[64];
        const LAS unsigned* scb = SC + wid * 4096 + 64 * lane;
#pragma unroll
        for (int q = 0; q < 16; ++q) { const int jj = (4 * q + 4 * lane) & 63;
            u32x4 v = *(const LAS u32x4*)(scb + jj);
            if (64 * lane + 4 * q >= lim) v = (u32x4){0u, 0u, 0u, 0u};
            key[4 * q] = v.x; key[4 * q + 1] = v.y; key[4 * q + 2] = v.z; key[4 * q + 3] = v.w; }
        unsigned theta = 1u;
        if (tq + 1 > 256) {
            unsigned one2; asm volatile("v_mov_b32 %0, 0x10001" : "=v"(one2));
            unsigned hp[32];
#pragma unroll
            for (int i = 0; i < 32; ++i) hp[i] = (key[2 * i] >> 16) | (key[2 * i + 1] & 0xffff0000u);
            unsigned th = 0u; bool exact = false;
            for (int bit = 15; bit >= 0; --bit) {
                const unsigned cand = th | (1u << bit), cand2 = cand * 0x10001u; unsigned c0 = 0, c1 = 0, c2 = 0, c3 = 0;
#pragma unroll
                for (int i = 0; i < 32; i += 4) { c0 += lt1pk(cand2, hp[i], one2); c1 += lt1pk(cand2, hp[i + 1], one2); c2 += lt1pk(cand2, hp[i + 2], one2); c3 += lt1pk(cand2, hp[i + 3], one2); }
                const unsigned tot = (c0 + c1) + (c2 + c3);
                const int cnt = 4096 - wave_sum_dpp((int)((tot & 0xffffu) + (tot >> 16)));
                if (cnt >= 256) { th = cand; if (cnt == 256) { exact = true; break; } }
            }
            theta = th << 16;
            if (!exact) {
            int ngt = 0;
            if (th != 0xffffu) { const unsigned cand2 = (th + 1u) * 0x10001u; unsigned c0 = 0, c1 = 0, c2 = 0, c3 = 0;
#pragma unroll
                for (int i = 0; i < 32; i += 4) { c0 += lt1pk(cand2, hp[i], one2); c1 += lt1pk(cand2, hp[i + 1], one2); c2 += lt1pk(cand2, hp[i + 2], one2); c3 += lt1pk(cand2, hp[i + 3], one2); }
                const unsigned tot = (c0 + c1) + (c2 + c3);
                ngt = 4096 - wave_sum_dpp((int)((tot & 0xffffu) + (tot >> 16))); }
            const unsigned th2 = th * 0x10001u;
#pragma unroll
            for (int i = 0; i < 32; ++i) {
                const unsigned x = hp[i] ^ th2; unsigned ne; asm("v_pk_min_u16 %0, %1, %2" : "=v"(ne) : "v"(x), "v"(one2));
                const unsigned eq = one2 - ne, msk = __umul24(eq, 0xffffu);
                hp[i] = ((key[2 * i] & 0xffffu) | (key[2 * i + 1] << 16)) & msk; }
            unsigned tl = 0u;
            for (int bit = 15; bit >= 0; --bit) {
                const unsigned cand = tl | (1u << bit), cand2 = cand * 0x10001u; unsigned c0 = 0, c1 = 0, c2 = 0, c3 = 0;
#pragma unroll
                for (int i = 0; i < 32; i += 4) { c0 += lt1pk(cand2, hp[i], one2); c1 += lt1pk(cand2, hp[i + 1], one2); c2 += lt1pk(cand2, hp[i + 2], one2); c3 += lt1pk(cand2, hp[i + 3], one2); }
                const unsigned tot = (c0 + c1) + (c2 + c3);
                const int cnt = ngt + 4096 - wave_sum_dpp((int)((tot & 0xffffu) + (tot >> 16)));
                if (cnt >= 256) { tl = cand; if (cnt == 256) break; }
            }
            theta = (th << 16) | tl;
            }
        }
        unsigned lo = 0u, hi32 = 0u;
#pragma unroll
        for (int j = 31; j >= 0; --j) { lo = (lo << 1) | ((key[j] >= theta) ? 1u : 0u); hi32 = (hi32 << 1) | ((key[32 + j] >= theta) ? 1u : 0u); }
        if (mode == 3 || (lo == 0x12345u && hi32 == 0x54321u)) *(u32x2*)(WSP(unsigned long long, WS_MASK) + ((size_t)b * SEQ + tq) * 64 + lane) = (u32x2){lo, hi32};
    }
    LDS_BARRIER();
}

__device__ __forceinline__ void router_tile(Frame& F, int tile) {
    const int lane = opaque(F.lane), wid = F.wave, r = lane & 31, hh = lane >> 5;
    const int tok = tile * 32 + r;
    const bf16* xr = WSP(bf16, WS_X1B) + (size_t)tok * DM + 512 * wid + 8 * hh;
    unsigned char* h2 = WSP(unsigned char, WS_H2) + (size_t)tok * DM + 512 * wid + 8 * hh;
    const float* nw = F.ffnw() + 512 * wid + 8 * hh;
    const u32x4* WRF = WSP(u32x4, WS_WRF) + (size_t)(32 * wid) * 64 + lane;
    f32x16 a0 = {}, a1 = {}; float ss = 0.f;
#pragma unroll 4
    for (int s = 0; s < 32; ++s) {
        const u32x4 hi = *(const u32x4*)(xr + 16 * s);
        const f32x4 v0 = {bflo(hi.x), bfhi(hi.x), bflo(hi.y), bfhi(hi.y)}, v1 = {bflo(hi.z), bfhi(hi.z), bflo(hi.w), bfhi(hi.w)};
        const f32x4 n0 = *(const f32x4*)(nw + 16 * s), n1 = *(const f32x4*)(nw + 16 * s + 4);
        ss += (v0.x * v0.x + v0.y * v0.y) + (v0.z * v0.z + v0.w * v0.w) + (v1.x * v1.x + v1.y * v1.y) + (v1.z * v1.z + v1.w * v1.w);
        { unsigned w0 = 0u, w1 = 0u;
          w0 = cvt2_fp8(v0.x * n0.x, v0.y * n0.y, w0, false); w0 = cvt2_fp8(v0.z * n0.z, v0.w * n0.w, w0, true); w1 = cvt2_fp8(v1.x * n1.x, v1.y * n1.y, w1, false); w1 = cvt2_fp8(v1.z * n1.z, v1.w * n1.w, w1, true);
          *(u32x2*)(h2 + 16 * s) = (u32x2){w0, w1}; }
        const u32x4 b0h = WRF[(size_t)(0 * 256 + s) * 64], b0l = WRF[(size_t)(1 * 256 + s) * 64], b1h = WRF[(size_t)(2 * 256 + s) * 64], b1l = WRF[(size_t)(3 * 256 + s) * 64];
        a0 = __builtin_amdgcn_mfma_f32_32x32x16_bf16(*(const bf16x8*)&hi, *(const bf16x8*)&b0h, a0, 0, 0, 0);
        a0 = __builtin_amdgcn_mfma_f32_32x32x16_bf16(*(const bf16x8*)&hi, *(const bf16x8*)&b0l, a0, 0, 0, 0);
        a1 = __builtin_amdgcn_mfma_f32_32x32x16_bf16(*(const bf16x8*)&hi, *(const bf16x8*)&b1h, a1, 0, 0, 0);
        a1 = __builtin_amdgcn_mfma_f32_32x32x16_bf16(*(const bf16x8*)&hi, *(const bf16x8*)&b1l, a1, 0, 0, 0);
    }
    ss += __shfl_xor(ss, 32);
    LAS float* PART = (LAS float*)F.lds;
    LAS float* SS = PART + 10240;
    if (hh == 0) SS[wid * 32 + r] = ss;
#pragma unroll
    for (int i = 0; i < 16; ++i) { const int tr = crow(i, hh); PART[(wid * 32 + tr) * 40 + r] = a0[i]; if (r < 4) PART[(wid * 32 + tr) * 40 + 32 + r] = a1[i]; }
    __syncthreads();
    if (wid == 0 && lane < 32) {
        float sq = 0.f;
#pragma unroll
        for (int w = 0; w < 8; ++w) sq += SS[w * 32 + lane];
        const float rstd = rsqrtf(sq * (1.f / DM) + EPS);
        WSP(float, WS_RSTD)[tile * 32 + lane] = rstd;
        float g4[4]; float mg = -3.4e38f; int gi = 0;
#pragma unroll
        for (int j = 0; j < 4; ++j) { float v = 0.f;
#pragma unroll
            for (int w = 0; w < 8; ++w) v += PART[(w * 32 + lane) * 40 + 32 + j];
            g4[j] = v * rstd + F.brg()[j]; if (g4[j] > mg) { mg = g4[j]; gi = j; } }
        float sg = 0.f;
#pragma unroll
        for (int j = 0; j < 4; ++j) sg += __expf(g4[j] - mg);
        const float pgrp = 1.f / sg;
        float e8[8]; float m0 = -3.4e38f; int i0 = 0;
#pragma unroll
        for (int j = 0; j < 8; ++j) { float v = 0.f;
#pragma unroll
            for (int w = 0; w < 8; ++w) v += PART[(w * 32 + lane) * 40 + gi * 8 + j];
            e8[j] = v * rstd + F.bre()[gi * 8 + j]; if (e8[j] > m0) { m0 = e8[j]; i0 = j; } }
        float m1 = -3.4e38f; int i1 = 0;
#pragma unroll
        for (int j = 0; j < 8; ++j) if (j != i0 && e8[j] > m1) { m1 = e8[j]; i1 = j; }
        const float p1 = __expf(m1 - m0), den = 1.f + p1;
        const float w0 = pgrp / den, w1 = pgrp * p1 / den;
        int* LIST = WSP(int, WS_LIST); float* LWT = WSP(float, WS_LWT); unsigned* cnt = F.ctl + CW_CNT;
        const int tk = tile * 32 + lane;
        const int sg0 = (gi * 8 + i0) * 2, sg1 = (gi * 8 + i1) * 2 + 1;
        const unsigned p0 = __hip_atomic_fetch_add(cnt + 64 * sg0, 1u, __ATOMIC_RELAXED, __HIP_MEMORY_SCOPE_AGENT);
        LIST[sg0 * 16384 + p0] = tk; LWT[sg0 * 16384 + p0] = w0;
        const unsigned q0 = __hip_atomic_fetch_add(cnt + 64 * sg1, 1u, __ATOMIC_RELAXED, __HIP_MEMORY_SCOPE_AGENT);
        LIST[sg1 * 16384 + q0] = tk; LWT[sg1 * 16384 + q0] = w1;
    }
    LDS_BARRIER();
}

__device__ __forceinline__ void moe_tables(Frame& F) {
    LAS int* segc = (LAS int*)(F.lds + LT_SEGC); LAS int* segt = (LAS int*)(F.lds + LT_SEGT); LAS int* rtseg = (LAS int*)(F.lds + LT_RTSEG); LAS int* rk = (LAS int*)(F.lds + LT_RK); LAS int* nrk = (LAS int*)(F.lds + LT_NRK);
    if (F.tid < 64) segc[F.tid] = (int)__hip_atomic_load(F.ctl + CW_CNT + 64 * F.tid, __ATOMIC_RELAXED, __HIP_MEMORY_SCOPE_AGENT);
    __syncthreads();
    if (F.tid == 0) { int acc = 0, n0 = 0, n1 = 0;
        for (int s = 0; s < 64; ++s) { segt[s] = acc; const int nt = (segc[s] + 255) >> 8; for (int q = 0; q < nt; ++q) { rtseg[acc + q] = s; if (s & 1) rk[160 + n1++] = acc + q; else rk[n0++] = acc + q; } acc += nt; }
        segt[64] = acc; nrk[0] = n0; nrk[1] = n1; }
    __syncthreads();
}
struct MoeGUOrder {
    const LAS int* segc; const LAS int* segt; const LAS int* rtseg; int G, c; const char* A; const char* W; const int* LIST;
    __device__ __forceinline__ bool next(int i, pg8::Unit& u) const {
        const int L = i * G + c, nrt = __builtin_amdgcn_readfirstlane(segt[64]); if (L >= nrt * 4) return false;
        const int g = L >> 2, ct = L & 3, sgm = __builtin_amdgcn_readfirstlane(rtseg[g]), rt = g - __builtin_amdgcn_readfirstlane(segt[sgm]), e = sgm >> 1;
        u.pm = g; u.pn = ct; u.A = A; u.B = W + ((size_t)e * 1024 + 256 * ct) * 4096;         u.rows = LIST + sgm * 16384 + rt * 256; u.nrows = __builtin_amdgcn_readfirstlane(segc[sgm]) - rt * 256; u.aux0 = sgm; u.aux1 = rt; return true;
    }
};
struct MoeDownOrder {
    const LAS int* segc; const LAS int* segt; const LAS int* rtseg; const LAS int* rk; int nr, G, c; const char* HE; const char* W;
    __device__ __forceinline__ bool next(int i, pg8::Unit& u) const {
        const int L = i * G + c; if (L >= nr * 16) return false;
        const int g = __builtin_amdgcn_readfirstlane(rk[L >> 4]), ct = L & 15, sgm = __builtin_amdgcn_readfirstlane(rtseg[g]), rt = g - __builtin_amdgcn_readfirstlane(segt[sgm]), e = sgm >> 1;
        u.pm = g; u.pn = ct; u.A = HE + (size_t)g * 256 * 512 * 2; u.B = W + ((size_t)e * 4096 + 256 * ct) * 512 * 2; u.rows = nullptr; u.nrows = __builtin_amdgcn_readfirstlane(segc[sgm]) - rt * 256; u.aux0 = sgm; u.aux1 = rt; return true;
    }
};
struct EpiGU {
    bf16* HE; const int* LIST; const float* RSTD;
    __device__ __forceinline__ void operator()(const f32x4 (&acc)[2][2][4][2], const pg8::Unit& u, int wr, int wc, int fr, int fq) const {
        const int col0 = u.pn * 128 + wc * 32 + 8 * fq;
        int zz; asm volatile("v_mov_b32 %0, 0" : "=v"(zz));
        float rsv[2][4];
#pragma unroll
        for (int ai = 0; ai < 2; ++ai)
#pragma unroll
            for (int m = 0; m < 4; ++m) { const int lr = ai * 128 + wr * 64 + m * 16 + fr + zz; const int tok = lr < u.nrows ? u.rows[lr] : 0; rsv[ai][m] = RSTD[tok]; }
#pragma unroll
        for (int ai = 0; ai < 2; ++ai)
#pragma unroll
            for (int m = 0; m < 4; ++m) { const int lr = ai * 128 + wr * 64 + m * 16 + fr + zz;
                if (lr < u.nrows) { const float rs = rsv[ai][m];
                    const f32x4 g0 = acc[ai][0][m][0] * rs, g1 = acc[ai][0][m][1] * rs, u0 = acc[ai][1][m][0] * rs, u1 = acc[ai][1][m][1] * rs;
                    u32x4 w; w.x = cvt_pk_bf16(g0[0] * sigmoidf_(g0[0]) * u0[0], g0[1] * sigmoidf_(g0[1]) * u0[1]); w.y = cvt_pk_bf16(g0[2] * sigmoidf_(g0[2]) * u0[2], g0[3] * sigmoidf_(g0[3]) * u0[3]);
                    w.z = cvt_pk_bf16(g1[0] * sigmoidf_(g1[0]) * u1[0], g1[1] * sigmoidf_(g1[1]) * u1[1]); w.w = cvt_pk_bf16(g1[2] * sigmoidf_(g1[2]) * u1[2], g1[3] * sigmoidf_(g1[3]) * u1[3]);
                    *(u32x4*)(HE + ((size_t)u.pm * 256 + lr) * 512 + col0) = w; } }
    }
};
template <int ROUND> struct EpiDown {
    float* O; const int* LIST; const float* LWT; bf16* PART; const bf16* X1;
    __device__ __forceinline__ void operator()(const f32x4 (&acc)[2][2][4][2], const pg8::Unit& u, int wr, int wc, int fr, int fq) const {
        const int col0 = u.pn * 256 + wc * 32 + 8 * fq; const int lbase = u.aux0 * 16384 + u.aux1 * 256;
        int zz; asm volatile("v_mov_b32 %0, 0" : "=v"(zz));
        int tk[2][4]; float wt[2][4];
#pragma unroll
        for (int ai = 0; ai < 2; ++ai)
#pragma unroll
            for (int m = 0; m < 4; ++m) { const int lr = ai * 128 + wr * 64 + m * 16 + fr + zz; const bool ok = lr < u.nrows; tk[ai][m] = ok ? LIST[lbase + lr] : -1; wt[ai][m] = ok ? LWT[lbase + lr] : 0.f; }
        if constexpr (ROUND == 0) {
#pragma unroll
            for (int ai = 0; ai < 2; ++ai)
#pragma unroll
                for (int m = 0; m < 4; ++m) if (tk[ai][m] >= 0) { bf16* pp = PART + (size_t)tk[ai][m] * DM + col0;
#pragma unroll
                    for (int bj = 0; bj < 2; ++bj) { const f32x4 v0 = acc[ai][bj][m][0] * wt[ai][m], v1 = acc[ai][bj][m][1] * wt[ai][m];
                        *(u32x4*)(pp + bj * 128) = (u32x4){cvt_pk_bf16(v0[0], v0[1]), cvt_pk_bf16(v0[2], v0[3]), cvt_pk_bf16(v1[0], v1[1]), cvt_pk_bf16(v1[2], v1[3])}; } }
        } else {
#pragma unroll
        for (int ai = 0; ai < 2; ++ai)
#pragma unroll
        for (int mh = 0; mh < 2; ++mh) {
            u32x4 rv[2][2], pv[2][2];
#pragma unroll
            for (int m2 = 0; m2 < 2; ++m2) { const int m = mh * 2 + m2; const size_t ro = (size_t)(tk[ai][m] < 0 ? 0 : tk[ai][m]) * DM + col0; const bf16* op = X1 + ro; const bf16* pp = PART + ro;
#pragma unroll
                for (int bj = 0; bj < 2; ++bj) { rv[m2][bj] = *(const u32x4*)(op + bj * 128); pv[m2][bj] = *(const u32x4*)(pp + bj * 128); } }
#pragma unroll
            for (int m2 = 0; m2 < 2; ++m2) { const int m = mh * 2 + m2; if (tk[ai][m] >= 0) { float* op = O + (size_t)tk[ai][m] * DM + col0;
#pragma unroll
                for (int bj = 0; bj < 2; ++bj) { const u32x4 p = pv[m2][bj], x = rv[m2][bj];
                    const f32x4 p0 = {__uint_as_float(p.x << 16), __uint_as_float(p.x & 0xffff0000u), __uint_as_float(p.y << 16), __uint_as_float(p.y & 0xffff0000u)};
                    const f32x4 p1 = {__uint_as_float(p.z << 16), __uint_as_float(p.z & 0xffff0000u), __uint_as_float(p.w << 16), __uint_as_float(p.w & 0xffff0000u)};
                    const f32x4 x0 = {__uint_as_float(x.x << 16), __uint_as_float(x.x & 0xffff0000u), __uint_as_float(x.y << 16), __uint_as_float(x.y & 0xffff0000u)};
                    const f32x4 x1 = {__uint_as_float(x.z << 16), __uint_as_float(x.z & 0xffff0000u), __uint_as_float(x.w << 16), __uint_as_float(x.w & 0xffff0000u)};
                    *(f32x4*)(op + bj * 128) = (x0 + p0) + acc[ai][bj][m][0] * wt[ai][m]; *(f32x4*)(op + bj * 128 + 4) = (x1 + p1) + acc[ai][bj][m][1] * wt[ai][m]; } } }
        }
        }
    }
};

namespace att {
constexpr int D = 128, NW = 8, QBLK = 32, KVBLK = 64, QB = 256, H = 16, HKV = 4;
constexpr int SHM_V = KVBLK * D * 2, SHM_K = KVBLK * D * 2;
constexpr int ATT_LDS = 2 * SHM_V + 2 * SHM_K + NW * 64 * 4;
constexpr float SCALE = 0.08838834764831845f, THR = 8.f;
constexpr int LDV = LDP, LDO = 2048;
#define KSWZ(row, colB) ((row) * 256 + ((colB) ^ (((row) & 7) << 4)))
#define SBAR() __builtin_amdgcn_sched_barrier(0)
typedef short s16x4 __attribute__((ext_vector_type(4)));
__device__ __forceinline__ int v_st(int k, int c) { const int kk = (k & ~0xC) | ((k & 4) << 1) | ((k & 8) >> 1); return ((kk >> 3) * 4 + (c >> 5)) * 512 + ((kk & 7) * 32 + (c & 31)) * 2; }
__device__ __forceinline__ int v_rd_base(int lane) { return ((lane & 3) << 3) | (((lane >> 2) & 3) << 6) | (((lane >> 4) & 1) << 5) | (((lane >> 5) & 1) << 8); }
constexpr int v_rd_off(int d0, int ks, int half) { return d0 * 512 + ks * 4096 + half * 2048; }
__device__ __forceinline__ bf16x8 load8(const bf16* p) { return *reinterpret_cast<const bf16x8*>(p); }

__device__ __forceinline__ void partialSM(f32x16& p0, f32x16& p1, float& m_reg, float& mn, float& alpha) {
    float pmax = p0[0];
#pragma unroll
    for (int r = 1; r < 16; ++r) pmax = fmaxf(pmax, p0[r]);
#pragma unroll
    for (int r = 0; r < 16; ++r) pmax = fmaxf(pmax, p1[r]);
    { auto rr = __builtin_amdgcn_permlane32_swap(__float_as_uint(pmax), __float_as_uint(pmax), false, false);
      pmax = fmaxf(__uint_as_float(rr[0]), __uint_as_float(rr[1])); }
    constexpr float C2 = 1.4426950408889634f * SCALE;
    if (__builtin_expect(__all((pmax - m_reg) * SCALE <= THR), 1)) { mn = m_reg; alpha = 1.f; }
    else { mn = fmaxf(m_reg, pmax); alpha = __builtin_amdgcn_exp2f((m_reg - mn) * C2); m_reg = mn; }
    const float mnL = -mn * C2;
#pragma unroll
    for (int r = 0; r < 16; ++r) p0[r] = fmaf(p0[r], C2, mnL);
#pragma unroll
    for (int r = 0; r < 16; ++r) p1[r] = fmaf(p1[r], C2, mnL);
#pragma unroll
    for (int r = 0; r < 16; ++r) p0[r] = __builtin_amdgcn_exp2f(p0[r]);
}
__device__ __forceinline__ void finishSM(f32x16& p0, f32x16& p1, float alpha, float& l_reg, unsigned mlo, unsigned mhi, bf16x8& pa0, bf16x8& pa1, bf16x8& pa2, bf16x8& pa3) {
#pragma unroll
    for (int r = 0; r < 16; ++r) p1[r] = __builtin_amdgcn_exp2f(p1[r]);
#pragma unroll
    for (int r = 0; r < 16; ++r) { const int c = (r & 3) + 8 * (r >> 2);
        p0[r] = __uint_as_float(__float_as_uint(p0[r]) & (unsigned)__builtin_amdgcn_sbfe((int)mlo, c, 1));
        p1[r] = __uint_as_float(__float_as_uint(p1[r]) & (unsigned)__builtin_amdgcn_sbfe((int)mhi, c, 1)); }
    float ps = 0;
#pragma unroll
    for (int r = 0; r < 16; ++r) ps += p0[r];
#pragma unroll
    for (int r = 0; r < 16; ++r) ps += p1[r];
    { auto rr = __builtin_amdgcn_permlane32_swap(__float_as_uint(ps), __float_as_uint(ps), false, false);
      ps = __uint_as_float(rr[0]) + __uint_as_float(rr[1]); }
    l_reg = l_reg * alpha + ps;
#define PK4(P, B_, OUT) do { unsigned a0 = cvt_pk_bf16(P[B_+0], P[B_+1]), a1 = cvt_pk_bf16(P[B_+2], P[B_+3]);                          \
        unsigned b0 = cvt_pk_bf16(P[B_+4], P[B_+5]), b1 = cvt_pk_bf16(P[B_+6], P[B_+7]);                                             \
        auto r0 = __builtin_amdgcn_permlane32_swap(a0, b0, false, false); auto r1 = __builtin_amdgcn_permlane32_swap(a1, b1, false, false); \
        u32x4 w = {r0[0], r1[0], r0[1], r1[1]}; OUT = *reinterpret_cast<bf16x8*>(&w); } while (0)
    PK4(p0, 0, pa0); PK4(p0, 8, pa1); PK4(p1, 0, pa2); PK4(p1, 8, pa3);
#undef PK4
}
template <int KB>
__device__ __forceinline__ void qkt(f32x16& p0, f32x16& p1, const char* K_lds, int r32, int hi, const bf16x8* qr) {
    p0 = f32x16{}; p1 = f32x16{};
    const char* kb[4];
#pragma unroll
    for (int dd = 0; dd < 4; ++dd) kb[dd] = K_lds + KB * SHM_K + KSWZ(r32, (dd * 16 + hi * 8) * 2);
#pragma unroll
    for (int d0 = 0; d0 < 8; ++d0) { const char* a = kb[d0 & 3] + (d0 >> 2) * 128;
        bf16x8 b0 = *reinterpret_cast<const bf16x8*>(a);
        bf16x8 b1 = *reinterpret_cast<const bf16x8*>(a + 32 * 256);
        p0 = __builtin_amdgcn_mfma_f32_32x32x16_bf16(b0, qr[d0], p0, 0, 0, 0);
        p1 = __builtin_amdgcn_mfma_f32_32x32x16_bf16(b1, qr[d0], p1, 0, 0, 0); }
}
template <int VB>
__device__ __forceinline__ void pv_tile(f32x16* o, int vb0, bf16x8 pa0, bf16x8 pa1, bf16x8 pa2, bf16x8 pa3) {
#define TRRD(dst, off) asm volatile("ds_read_b64_tr_b16 %0, %1 offset:%2" : "=&v"(dst) : "v"(vb0), "i"(off) : "memory")
#define PV_D0(d0) do { s16x4 l0, l1, l2, l3, h0, h1, h2, h3; constexpr int b_ = VB * SHM_V + v_rd_off(d0, 0, 0); \
        TRRD(l0, b_); TRRD(h0, b_ + 2048); TRRD(l1, b_ + 4096); TRRD(h1, b_ + 6144); TRRD(l2, b_ + 8192); TRRD(h2, b_ + 10240); TRRD(l3, b_ + 12288); TRRD(h3, b_ + 14336); \
        asm volatile("s_waitcnt lgkmcnt(0)" ::: "memory"); SBAR();   \
        o[d0] = __builtin_amdgcn_mfma_f32_32x32x16_bf16(pa0, (bf16x8){l0[0], l0[1], l0[2], l0[3], h0[0], h0[1], h0[2], h0[3]}, o[d0], 0, 0, 0);   \
        o[d0] = __builtin_amdgcn_mfma_f32_32x32x16_bf16(pa1, (bf16x8){l1[0], l1[1], l1[2], l1[3], h1[0], h1[1], h1[2], h1[3]}, o[d0], 0, 0, 0);   \
        o[d0] = __builtin_amdgcn_mfma_f32_32x32x16_bf16(pa2, (bf16x8){l2[0], l2[1], l2[2], l2[3], h2[0], h2[1], h2[2], h2[3]}, o[d0], 0, 0, 0);   \
        o[d0] = __builtin_amdgcn_mfma_f32_32x32x16_bf16(pa3, (bf16x8){l3[0], l3[1], l3[2], l3[3], h3[0], h3[1], h3[2], h3[3]}, o[d0], 0, 0, 0); } while (0)
    PV_D0(0); PV_D0(1); PV_D0(2); PV_D0(3);
#undef PV_D0
#undef TRRD
}
struct BlockRef { const bf16* Q; const bf16* K; const bf16* V; bf16* O; const unsigned long long* M; int P0; };
struct Seam { bf16x8 qr[8]; bf16x8 st_v0, st_v1, st_k0, st_k1; };
#define ROWK(p, k0, rr) ((const bf16*)((const char*)(p) + (size_t)(k0) * (D * 2) + (unsigned)(((rr) * D + sc) * 2)))
#define ROWV(p, k0, rr) ((const bf16*)((const char*)(p) + (size_t)(k0) * (LDV * 2) + (unsigned)(((rr) * LDV + sc) * 2)))
#define VMW() asm volatile("s_waitcnt vmcnt(0)" ::: "memory")
#define VMWN(n) asm volatile("s_waitcnt vmcnt(%0)" :: "i"(n) : "memory")
#define SLOAD_H(Kp, Vp, k0) do { S.st_v0 = load8(ROWV(Vp, k0, sr)); S.st_v1 = load8(ROWV(Vp, k0, 32 + sr));              \
                         S.st_k0 = load8(ROWK(Kp, k0, sr)); S.st_k1 = load8(ROWK(Kp, k0, 32 + sr)); } while (0)
#define SWRITE_HK(bf) do { *(bf16x8*)(K_lds + (bf) * SHM_K + kws) = S.st_k0; *(bf16x8*)(K_lds + (bf) * SHM_K + kws + 32 * 256) = S.st_k1; } while (0)
#define SWRITE_HV(bf) do { *(bf16x8*)(V_lds + (bf) * SHM_V + vst0) = S.st_v0; *(bf16x8*)(V_lds + (bf) * SHM_V + vst1) = S.st_v1; } while (0)
#define SWRITE_H(bf) do { SWRITE_HV(bf); SWRITE_HK(bf); } while (0)
__device__ __forceinline__ void prime(const BlockRef& cur, char* lds, Seam& S, const int tid) {
    const int wid = __builtin_amdgcn_readfirstlane(tid >> 6), lane = tid & 63, r32 = lane & 31, hi = lane >> 5;
    const int sr = tid >> 4, sc = (tid & 15) * 8, kws = KSWZ(sr, sc * 2); char* K_lds = lds + 2 * SHM_V;
#pragma unroll
    for (int d0 = 0; d0 < 8; ++d0) S.qr[d0] = load8(cur.Q + (size_t)(wid * QBLK + r32) * D + d0 * 16 + hi * 8);
    SLOAD_H(cur.K, cur.V, 0); VMW(); SWRITE_HK(0);
    __syncthreads();
}
__device__ __forceinline__ void block(const BlockRef& cur, const BlockRef& nxt, char* lds, Seam& S, const int tid) {
    const int wid = __builtin_amdgcn_readfirstlane(tid >> 6), lane = tid & 63, r32 = lane & 31, hi = lane >> 5;
    const int NT = (cur.P0 + QB - 1) / KVBLK + 1;
    char* V_lds = lds; char* K_lds = lds + 2 * SHM_V;
    float* ws = (float*)(lds + 2 * SHM_V + 2 * SHM_K) + wid * 64; float* li_l = ws, * al_l = ws + 32;
    float m_reg = -1e30f, l_reg = 0; f32x16 o[4] = {};
    const int sr = tid >> 4, sc = (tid & 15) * 8, vst0 = v_st(sr, sc), vst1 = v_st(32 + sr, sc), kws = KSWZ(sr, sc * 2);
    const int vb0 = (int)(uintptr_t)V_lds + v_rd_base(lane);
    const bf16* Kh = cur.K; const bf16* Vh = cur.V;
    const int mrow = (wid * QBLK + r32) * 64;
    const int msh = 4 * hi;
#define RESC(a) do { if (__any((a) < 1.f)) { if (hi == 0) al_l[r32] = (a); asm volatile("s_waitcnt lgkmcnt(0)" ::: "memory");              \
                     for (int d_ = 0; d_ < 4; ++d_) for (int r = 0; r < 16; ++r) o[d_][r] *= al_l[crow(r, hi)]; } } while (0)
#define KBASE(t) ((t) * KVBLK)
#define LDM(ML, MH, t) do { const u32x2 mw_ = *(const u32x2*)(cur.M + mrow + (t)); ML = mw_.x >> msh; MH = mw_.y >> msh; } while (0)
#define SEAM_K0() do { VMWN(8); SWRITE_HK(0); SBAR(); } while (0)
    f32x16 pA0, pA1, pB0, pB1; float mnA, mnB, alA, alB; bf16x8 pa0, pa1, pa2, pa3; unsigned ml, mh;
    SWRITE_HV(0); SBAR();
    if (NT > 1) SLOAD_H(Kh, Vh, KBASE(1));
    SBAR(); qkt<0>(pA0, pA1, K_lds, r32, hi, S.qr);
    partialSM(pA0, pA1, m_reg, mnA, alA);
    if (NT > 1) { VMW(); SWRITE_H(1); }
    __syncthreads();
#define HALF_STEP(PX0, PX1, mnX, alX, PY0, PY1, alY, t, KB, VB, SB) do {                                                      \
        LDM(ml, mh, (t) - 1);                                                                                                 \
        SBAR(); qkt<KB>(PX0, PX1, K_lds, r32, hi, S.qr);                                                                      \
        finishSM(PY0, PY1, alY, l_reg, ml, mh, pa0, pa1, pa2, pa3); SBAR();                                                   \
        if ((t) + 1 < NT) { SLOAD_H(Kh, Vh, KBASE((t) + 1)); SBAR(); }                                                        \
        pv_tile<VB>(o, vb0, pa0, pa1, pa2, pa3); partialSM(PX0, PX1, m_reg, mnX, alX);                                        \
        __syncthreads();                                                                                                      \
        if ((t) + 1 < NT) { VMW(); SWRITE_H(SB); }                                                                            \
        RESC(alX); __syncthreads(); } while (0)
    for (int t = 1; t + 1 < NT; t += 2) {
        HALF_STEP(pB0, pB1, mnB, alB, pA0, pA1, alA, t, 1, 0, 0);
        HALF_STEP(pA0, pA1, mnA, alA, pB0, pB1, alB, t + 1, 0, 1, 1);
    }
    LDM(ml, mh, NT - 2);
    SBAR(); qkt<1>(pB0, pB1, K_lds, r32, hi, S.qr); SBAR();
    SLOAD_H(nxt.K, nxt.V, 0); SBAR();
#pragma unroll
    for (int d0 = 0; d0 < 8; ++d0) S.qr[d0] = load8(nxt.Q + (size_t)(wid * QBLK + r32) * D + d0 * 16 + hi * 8);
    SBAR();
    finishSM(pA0, pA1, alA, l_reg, ml, mh, pa0, pa1, pa2, pa3); SBAR();
    pv_tile<0>(o, vb0, pa0, pa1, pa2, pa3);
    partialSM(pB0, pB1, m_reg, mnB, alB); __syncthreads(); RESC(alB);
    SBAR(); SEAM_K0();
    LDM(ml, mh, NT - 1);
    finishSM(pB0, pB1, alB, l_reg, ml, mh, pa0, pa1, pa2, pa3); SBAR(); pv_tile<1>(o, vb0, pa0, pa1, pa2, pa3);
    if (hi == 0) li_l[r32] = l_reg; asm volatile("s_waitcnt lgkmcnt(0)" ::: "memory");
    float rli[16];
#pragma unroll
    for (int r = 0; r < 16; ++r) rli[r] = __builtin_amdgcn_rcpf(li_l[crow(r, hi)]);
    bf16* Ow = cur.O + (size_t)(wid * QBLK) * LDO;
#pragma unroll
    for (int r = 0; r < 16; ++r) { const int orow = crow(r, hi);
#pragma unroll
        for (int d0 = 0; d0 < 4; ++d0) { const float v = o[d0][r] * rli[r];
            const float vn = __shfl_xor(v, 1);
            if ((r32 & 1) == 0) *(unsigned*)(Ow + (size_t)orow * LDO + d0 * 32 + r32) = cvt_pk_bf16(v, vn); } }
    __syncthreads();
#undef RESC
#undef KBASE
#undef LDM
#undef SEAM_K0
#undef HALF_STEP
}
#undef ROWK
#undef ROWV
#undef VMW
#undef VMWN
#undef SLOAD_H
#undef SWRITE_HK
#undef SWRITE_HV
#undef SWRITE_H
struct Item { int bh, qb0, qb1; };
__device__ __forceinline__ Item decode(int L) {
    constexpr int nx = 8, G = H / HKV; Item it;
    const int xcd = L & 7, k = L >> 3, per = G * nx, gi = k / per, rr = k - gi * per;
    it.bh = (gi * 8 + xcd) * G + rr / nx; const int x = rr % nx;
    it.qb0 = x; it.qb1 = 15 - x; return it;
}
__device__ __forceinline__ BlockRef mkref(const Item& it, int pass, const bf16* Q, const bf16* K, const bf16* V, bf16* O, const unsigned long long* M) {
    const int qb = pass ? it.qb1 : it.qb0, b = it.bh / H, h = it.bh % H, kvh = h / (H / HKV);
    BlockRef r;
    r.Q = Q + ((size_t)it.bh * SEQ + (size_t)qb * QB) * D;
    r.K = K + (size_t)(b * HKV + kvh) * SEQ * D;
    r.V = V + (size_t)b * SEQ * LDV + kvh * D;
    r.O = O + ((size_t)b * SEQ + (size_t)qb * QB) * LDO + h * D;
    r.M = M + ((size_t)b * SEQ + (size_t)qb * QB) * 64;
    r.P0 = qb * QB; return r;
}
__device__ __forceinline__ void phase(char* lds, const bf16* Q, const bf16* K, const bf16* V, bf16* O, const unsigned long long* M, int G, int c, const int tid) {
    constexpr int total = 8 * NB * H;
    int L = c; if (L >= total) return;
    Item it = decode(L); int pass = 0;
    BlockRef cur = mkref(it, 0, Q, K, V, O, M);
    Seam S;
    prime(cur, lds, S, tid);
    for (;;) {
        const bool more_pass = pass == 0, more_item = L + G < total, last = !more_pass && !more_item;
        Item itn = it; int passn = pass + 1, Ln = L;
        if (!more_pass) { passn = 0; Ln = more_item ? L + G : L; itn = decode(Ln); }
        const BlockRef nxt = last ? cur : mkref(itn, passn, Q, K, V, O, M);
        block(cur, nxt, lds, S, tid);
        if (last) break;
        cur = nxt; it = itn; pass = passn; L = Ln;
    }
}
#undef KSWZ
#undef SBAR
}

struct Args { const void* in[22]; float* out; unsigned char* ws; int ph_lo, ph_hi; };
__global__ void __launch_bounds__(512, 2) mega_fwd(Args args) {
    extern __shared__ __attribute__((aligned(16))) unsigned char lds[];
    Frame F;
    F.lds = (LAS unsigned char*)lds;
#define F_REFRESH() do { int l_; asm volatile("v_mbcnt_lo_u32_b32 %0, -1, 0\n\tv_mbcnt_hi_u32_b32 %0, -1, %0" : "=v"(l_)); F.lane = l_; F.wave = wave_id; F.tid = wave_id * 64 + l_; F.gw = (int)blockIdx.x * 8 + wave_id; } while (0)
    const int wave_id = __builtin_amdgcn_readfirstlane((int)threadIdx.x >> 6);
    F.G = gridDim.x; F.NGW = F.G * 8; F_REFRESH();
    F.ws = args.ws; F.out = args.out; F.ctl = (unsigned*)(args.ws + WS_CTL);
    F.kin = (const __attribute__((address_space(4))) void* const*)__builtin_amdgcn_kernarg_segment_ptr();
    for (int u = F.tid; u < (LDS_BYTES - LDSCTL_OFF) / 4; u += 512) ((LAS unsigned*)(F.lds + LDSCTL_OFF))[u] = 0u;
    __syncthreads();
    const int lo = args.ph_lo, hi = args.ph_hi;
    XcdBarrier bar; bar.bar = F.ctl + CW_BAR; bar.x = 0; bar.st = nullptr;
    if (hi - lo > 1) bar = xcd_barrier_post(F.ctl + CW_BAR, (volatile LAS unsigned*)(F.lds + LDSCTL_OFF + 32), F.tid);
#ifndef PHMASK
#define PHMASK 0x1fff
#endif
#define IN(k) (((PHMASK >> (k)) & 1) && lo <= (k) && (k) < hi)
#ifndef REP_PH
#define REP_PH -1
#endif
#ifndef DBG_P1_MODE
#define DBG_P1_MODE 3
#endif
#ifndef DBG_G1_MODE
#define DBG_G1_MODE 9
#endif
#ifndef DBG_IDX_MODE
#define DBG_IDX_MODE 3
#endif
#define REPS(k) ((REP_PH) == (k) ? 2 : 1)
#define SEAM(k) do { if (IN(k) && IN((k) + 1)) { F_REFRESH(); xcd_barrier(bar, F.tid); } } while (0)
    const int G = F.G, c = (int)blockIdx.x;

    if (lo < 0) { F_REFRESH(); p_amax(F); if (hi > 0) { F_REFRESH(); xcd_barrier(bar, F.tid); } }
    if (IN(0)) { F_REFRESH(); for (int rp_ = 0; rp_ < REPS(0); ++rp_) { if (rp_) { xcd_barrier(bar, F.tid); F_REFRESH(); } p0_prologue(F); __syncthreads(); } }
    SEAM(0);
    if (IN(1)) { F_REFRESH(); for (int rp_ = 0; rp_ < REPS(1); ++rp_) { if (rp_) { xcd_barrier(bar, F.tid); F_REFRESH(); }
        {
            const float sw = fmaxf(__uint_as_float(__hip_atomic_load(F.ctl + CW_AMAX, __ATOMIC_RELAXED, __HIP_MEMORY_SCOPE_AGENT)), 1e-30f) * (1.f / 127.f);
            const bool stag = (G == 256) && rp_ == 0;
            const int grp = c & 7, cw = ((grp - 2) * 32 + (c >> 3)) * 8 + F.wave, ncw = 192 * 8;
            const int kpre = grp == 2 ? 3 : grp == 3 ? 4 : grp == 4 ? 6 : grp == 5 ? 7 : grp == 6 ? 8 : grp == 7 ? 10 : 0;
            const int cv0 = CV_NITEMS - CV_LATE - CV_MID, cvm = cv0 + kpre * ncw;
            if (stag && grp >= 2 && kpre > 0) { convert_items(F, cv0, cvm, cw, ncw); __syncthreads(); F_REFRESH(); }
            if (stag && grp == 1) { __builtin_amdgcn_s_sleep(127); __builtin_amdgcn_s_sleep(127); }
            pg8::StaggerOrder S; S.init(WSP(unsigned char, WS_XN8), WSP(unsigned char, WS_WIN8), T, NPAD, 2048, G, c);
            EpiProj E{WSP(bf16, WS_PROJ), WSP(float, WS_SMALL), WSP(float, WS_SA), sw};
            pg8::gemm_phase<EpiProj, pg8::StaggerOrder, true, false, 2>(F.lds, F.tid, 2048, S, E);
            if (stag && grp >= 2) { F_REFRESH(); convert_items(F, cvm, CV_NITEMS - CV_LATE, ((grp - 2) * 32 + (c >> 3)) * 8 + F.wave, ncw); }
        }
    }
    }
    SEAM(1);
    if (IN(2)) { F_REFRESH(); for (int rp_ = 0; rp_ < REPS(2); ++rp_) { if (rp_) { xcd_barrier(bar, F.tid); F_REFRESH(); }
        if (rp_ == 0 || DBG_G1_MODE == 0 || DBG_G1_MODE == 9) for (int tok = F.gw; tok < T; tok += F.NGW) p2_post_token(F, tok);
        if (rp_ == 0 && IN(3)) { split_arrive(F.ctl + CW_SPLIT, F.tid); F_REFRESH(); }
        if (rp_ == 0 || DBG_G1_MODE != 0) {
            const int nper = 4096 / G, bh = (c * nper) >> 6, hd = bh & 15;
            for (int i = F.tid; i < 3 * 4 * 128; i += 512) { const int tz = i / 512, m = (i >> 7) & 3, d = i & 127; ((LAS float*)(F.lds + G_CW))[i] = F.convw()[(size_t)m * 6144 + tz * 2048 + hd * 128 + d]; }
            __syncthreads();
            for (int i = 0; i < nper; ++i) gdn_chunk(F, c * nper + i, rp_ ? DBG_G1_MODE : 9);
        }
    }
    }
    if (IN(2) && IN(3)) { F_REFRESH(); split_wait(F.ctl + CW_SPLIT, F.ctl + CW_BAR, (unsigned)G, F.tid); }
    if (IN(3)) { F_REFRESH(); for (int rp_ = 0; rp_ < REPS(3); ++rp_) { if (rp_) { xcd_barrier(bar, F.tid); F_REFRESH(); }
        for (int i = 0; i * G < 2048; ++i) { const int idx = i * G + ((i & 1) ? G - 1 - c : c); if (idx < 2048) idx_unit(F, idx & 3, (idx >> 2) * 8, rp_ ? DBG_IDX_MODE : 3); }
    }
    }
    SEAM(3);
    if (IN(4)) { F_REFRESH(); for (int rp_ = 0; rp_ < REPS(4); ++rp_) { if (rp_) { xcd_barrier(bar, F.tid); F_REFRESH(); }
        att::phase((char*)lds, WSP(bf16, WS_QB), WSP(bf16, WS_KB), WSP(bf16, WS_PROJ) + C_AV, WSP(bf16, WS_YA), WSP(unsigned long long, WS_MASK), G, c, F.tid);
        __syncthreads();
    }
    }
    SEAM(4);
    if (IN(5)) { F_REFRESH(); for (int rp_ = 0; rp_ < REPS(5); ++rp_) { if (rp_) { xcd_barrier(bar, F.tid); F_REFRESH(); }
        if (c >= 128) { for (int tok = (c - 128) * 8 + F.wave; tok < T; tok += (G - 128) * 8) ya_to_fp8_token(F, tok);
            convert_items(F, CV_NITEMS - CV_LATE, CV_NITEMS, (c - 128) * 8 + F.wave, (G - 128) * 8); }
        if (c < 128) gdn_scan_wg(F, ((c >> 4) << 3) | (c & 7), (c >> 3) & 1);
    }
    }
    SEAM(5);
    if (IN(6)) { F_REFRESH(); for (int rp_ = 0; rp_ < REPS(6); ++rp_) { if (rp_) { xcd_barrier(bar, F.tid); F_REFRESH(); }
        if (rp_ == 0) for (int tok = F.gw; tok < T; tok += F.NGW) gdn_norm_token(F, tok);
        if (rp_ == 0 && IN(7)) { split_arrive(F.ctl + CW_SPLIT + 64, F.tid); F_REFRESH(); }
        pg8::StaticOrder S; S.init(WSP(unsigned char, WS_YA8), WSP(unsigned char, WS_WPA), T, 4096, 1024, G, c);
        EpiGate<false> E{WSP(bf16, WS_MIX), WSP(bf16, WS_PROJ), C_GTA, nullptr};
        pg8::gemm_phase<EpiGate<false>, pg8::StaticOrder, true, false, 1>(F.lds, F.tid, 1024, S, E, 0x7a7a7a7a, 0x7a7a7a7a);
    }
    }
    if (IN(6) && IN(7)) { F_REFRESH(); split_wait(F.ctl + CW_SPLIT + 64, F.ctl + CW_BAR, (unsigned)G, F.tid); }
    if (IN(7)) { F_REFRESH();
        pg8::StaticOrder S; S.init((const unsigned char*)F.out, WSP(unsigned char, WS_WPG), T, 4096, 1024, G, c);
        EpiGate<true> E{WSP(bf16, WS_MIX), WSP(bf16, WS_PROJ), C_GTG, WSP(unsigned char, WS_MIX8)};
        pg8::gemm_phase<EpiGate<true>, pg8::StaticOrder, true, false, 1>(F.lds, F.tid, 1024, S, E, 0x7a7a7a7a, 0x7c7c7c7c);
    }
    SEAM(7);
    if (IN(8)) { F_REFRESH(); for (int rp_ = 0; rp_ < REPS(8); ++rp_) { if (rp_) { xcd_barrier(bar, F.tid); F_REFRESH(); }
        pg8::StaticOrder S; S.init(WSP(unsigned char, WS_MIX8), WSP(unsigned char, WS_WOUT), T, 4096, 2048, G, c);
        EpiRes E{WSP(bf16, WS_X1B), F.x()};
        pg8::gemm_phase<EpiRes, pg8::StaticOrder, true, false, 1>(F.lds, F.tid, 2048, S, E, 0x79797979, 0x7a7a7a7a);
    }
    }
    SEAM(8);
    if (IN(9)) { F_REFRESH(); for (int rp_ = 0; rp_ < REPS(9); ++rp_) {
        if (rp_) { xcd_barrier(bar, F.tid); F_REFRESH(); if (c == 0 && F.tid < 64) __hip_atomic_store(F.ctl + CW_CNT + 64 * F.tid, 0u, __ATOMIC_RELAXED, __HIP_MEMORY_SCOPE_AGENT); xcd_barrier(bar, F.tid); F_REFRESH(); }
        for (int tile = c; tile < T / 32; tile += G) router_tile(F, tile);
    } }
    SEAM(9);
    if (IN(10)) { F_REFRESH(); for (int rp_ = 0; rp_ < REPS(10); ++rp_) { if (rp_) { xcd_barrier(bar, F.tid); F_REFRESH(); }
        moe_tables(F);
        MoeGUOrder S{(const LAS int*)(F.lds + LT_SEGC), (const LAS int*)(F.lds + LT_SEGT), (const LAS int*)(F.lds + LT_RTSEG), G, c, (const char*)WSP(bf16, WS_H2), (const char*)WSP(bf16, WS_WGU), WSP(int, WS_LIST)};
        EpiGU E{WSP(bf16, WS_HE), WSP(int, WS_LIST), WSP(float, WS_RSTD)};
        pg8::gemm_phase<EpiGU, MoeGUOrder, true, true, 1>(F.lds, F.tid, 2048, S, E, 0x79797979, 0x7f7f7f7f);
    }
    }
    SEAM(10);
#define DOWN_ROUND(k) do { if (IN(11 + (k))) { F_REFRESH(); \
            moe_tables(F); \
            MoeDownOrder S{(const LAS int*)(F.lds + LT_SEGC), (const LAS int*)(F.lds + LT_SEGT), (const LAS int*)(F.lds + LT_RTSEG), (const LAS int*)(F.lds + LT_RK) + 160 * (k), ((const LAS int*)(F.lds + LT_NRK))[k], G, c, (const char*)WSP(bf16, WS_HE), (const char*)WSP(bf16, WS_WD)}; \
            EpiDown<k> E{F.out, WSP(int, WS_LIST), WSP(float, WS_LWT), WSP(bf16, WS_DPART), WSP(bf16, WS_X1B)};        \
            pg8::gemm_phase<EpiDown<k>, MoeDownOrder, true, false>(F.lds, F.tid, 512, S, E); } } while (0)
    DOWN_ROUND(0);
    SEAM(11);
    DOWN_ROUND(1);
#undef DOWN_ROUND
#undef IN
#undef SEAM
}

#ifdef DBG_STOP
__global__ void dbg_dump(float* o, const unsigned short* A, int lda, const unsigned short* B, int ldb) {
    for (size_t i = (size_t)blockIdx.x * blockDim.x + threadIdx.x; i < (size_t)T * DM; i += (size_t)gridDim.x * blockDim.x) { const size_t t = i / DM, c = i % DM;
        const unsigned short v = c < 2048 ? A[t * lda + c] : B[t * ldb + (c - 2048)]; float f = __uint_as_float(((unsigned)v) << 16); if (!(f - f == 0.f)) f = 0.f; o[i] = f; } }
#endif
#ifdef DBG_SANITIZE
__global__ void dbg_sanitize(float* o, size_t n) { for (size_t i = (size_t)blockIdx.x * blockDim.x + threadIdx.x; i < n; i += (size_t)gridDim.x * blockDim.x) { const float v = o[i]; if (!(v - v == 0.f)) o[i] = 0.f; } }
#endif
extern "C" void kernel_launch(void* const* d_in, const int* in_sizes, int n_in, void* d_out, int out_size, void* d_ws, size_t ws_size, hipStream_t stream) {
    static int grid = 0;
    if (grid == 0) {
        if (n_in != 22 || out_size != T * DM || ws_size < WS_END) { fprintf(stderr, "kernel_launch: unexpected shapes (n_in %d out %d ws %zu, need %zu)\n", n_in, out_size, ws_size, (size_t)WS_END); grid = -1; return; }
        int dev = 0, cus = 0, per_cu = 0;
        if (hipGetDevice(&dev) != hipSuccess || hipDeviceGetAttribute(&cus, hipDeviceAttributeMultiprocessorCount, dev) != hipSuccess) { grid = -1; return; }
        if (hipFuncSetAttribute((const void*)mega_fwd, hipFuncAttributeMaxDynamicSharedMemorySize, LDS_BYTES) != hipSuccess) { fprintf(stderr, "kernel_launch: hipFuncSetAttribute failed\n"); grid = -1; return; }
        if (hipOccupancyMaxActiveBlocksPerMultiprocessor(&per_cu, (const void*)mega_fwd, 512, LDS_BYTES) != hipSuccess || per_cu < 1) fprintf(stderr, "kernel_launch: occupancy query reports %d\n", per_cu);
        (void)hipGetLastError();
        grid = cus;
    }
    if (grid < 0) return;
    (void)hipMemsetAsync((char*)d_ws + WS_CTL, 0, CTL_BYTES, stream);
    Args a{};
    for (int i = 0; i < 22; ++i) a.in[i] = d_in[i];
    a.out = (float*)d_out; a.ws = (unsigned char*)d_ws;
#if ONE_LAUNCH
    a.ph_lo = -1; a.ph_hi = NPH;
    hipLaunchKernelGGL(mega_fwd, dim3(grid), dim3(512), LDS_BYTES, stream, a);
#else
#ifdef DBG_STOP
    for (int k = 0; k < DBG_STOP; ++k) { a.ph_lo = k; a.ph_hi = k + 1; hipLaunchKernelGGL(mega_fwd, dim3(grid), dim3(512), LDS_BYTES, stream, a); }
    hipLaunchKernelGGL(dbg_dump, dim3(2048), dim3(256), 0, stream, (float*)d_out, (const unsigned short*)((char*)d_ws + DBG_A), DBG_LDA, (const unsigned short*)((char*)d_ws + DBG_B), DBG_LDB);
#else
    for (int k = -1; k < NPH; ++k) { a.ph_lo = k; a.ph_hi = k + 1; hipLaunchKernelGGL(mega_fwd, dim3(grid), dim3(512), LDS_BYTES, stream, a); }
#endif
#endif
#ifdef DBG_SANITIZE
    hipLaunchKernelGGL(dbg_sanitize, dim3(2048), dim3(256), 0, stream, (float*)d_out, (size_t)T * DM);
#endif
}
```
